# Optimizing an MI355X kernel written in HIP

```python
import jax, jax.numpy as jnp
from jax import lax
import numpy as np

D_MODEL = 1024
BATCH = 8
SEQ = 4096
DEPTH = 4

N_MIXERS = 3
HEAD_DIM = 64
N_HEADS = 12
MIX_WIDTH = N_HEADS * HEAD_DIM
N_MEM = 256
N_MEM_HEADS = 4
MEM_WIDTH = N_MEM_HEADS * HEAD_DIM
ROPE_DIM = HEAD_DIM // 4
ROPE_THETA = 500000.0
POS_OFFSET_RANGE = 8192
IDX_HEADS = 8
IDX_DIM = 64
TOPK_MAX = 256
QBLOCK_A = 64
DIL_PAIRS = ((128, 1), (512, 4), (2048, 16))
B_GROUP_HEADS = 4
B_V_DIM = MIX_WIDTH // B_GROUP_HEADS
MOBA_BLOCK = 256
MOBA_TOPK = 3
QBLOCK_C = 16
D_FF = -(-8 * D_MODEL // (3 * 256)) * 256
ALPHA = (2 * DEPTH) ** 0.25
BETA = (8 * DEPTH) ** -0.25
LN_EPS = 1e-5

WIDTH_A = 3 * MIX_WIDTH + IDX_HEADS * IDX_DIM + IDX_HEADS + IDX_DIM + MEM_WIDTH
WIDTH_BC = 3 * MIX_WIDTH + MEM_WIDTH

kernel_name = 'hybrid_dsa_dilated_moba_deepnorm'


def layer_norm(x, g, b):
    xf = x.astype(jnp.float32)
    mu = jnp.mean(xf, -1, keepdims=True)
    var = jnp.mean(jnp.square(xf - mu), -1, keepdims=True)
    return ((xf - mu) * lax.rsqrt(var + LN_EPS) * g + b).astype(x.dtype)


def split_cols(h, widths):
    cuts = [int(c) for c in np.cumsum(widths)[:-1]]
    return jnp.split(h, cuts, axis=-1)


def rope_tables(positions):
    half = ROPE_DIM // 2
    inv = ROPE_THETA ** (-jnp.arange(half, dtype=jnp.float32) / half)
    ang = positions.astype(jnp.float32)[..., None] * inv
    return jnp.cos(ang)[:, :, None, :], jnp.sin(ang)[:, :, None, :]


def apply_rope(x, cos, sin):
    half = ROPE_DIM // 2
    c, s = cos.astype(x.dtype), sin.astype(x.dtype)
    x1, x2, rest = x[..., :half], x[..., half:ROPE_DIM], x[..., ROPE_DIM:]
    return jnp.concatenate([x1 * c - x2 * s, x2 * c + x1 * s, rest], axis=-1)


def dsa_attention(q, k, v, q_idx, w_idx, k_idx):
    Bsz, S, H, dh = q.shape
    topk = min(TOPK_MAX, S // 4)
    key_pos = jnp.arange(S)
    scale = dh ** -0.5

    def block(i):
        t0 = i * QBLOCK_A
        qpos = t0 + jnp.arange(QBLOCK_A)
        qi = lax.dynamic_slice_in_dim(q_idx, t0, QBLOCK_A, axis=1)
        wi = lax.dynamic_slice_in_dim(w_idx, t0, QBLOCK_A, axis=1)
        dots = jnp.einsum('bqhd,bsd->bqhs', qi, k_idx).astype(jnp.float32)
        score = jnp.einsum('bqhs,bqh->bqs', jax.nn.relu(dots), wi.astype(jnp.float32))
        causal = key_pos[None, :] <= qpos[:, None]
        score = jnp.where(causal[None], score, -jnp.inf)
        _, sel = lax.top_k(score, topk)
        valid = sel <= qpos[None, :, None]
        ks = jax.vmap(lambda kb, ib: kb[ib])(k, sel)
        vs = jax.vmap(lambda vb, ib: vb[ib])(v, sel)
        qb = lax.dynamic_slice_in_dim(q, t0, QBLOCK_A, axis=1)
        logits = jnp.einsum('bqhd,bqkhd->bhqk', qb, ks).astype(jnp.float32) * scale
        logits = jnp.where(valid[:, None], logits, -jnp.inf)
        p = jax.nn.softmax(logits, axis=-1).astype(v.dtype)
        return jnp.einsum('bhqk,bqkhd->bqhd', p, vs)

    out = lax.map(block, jnp.arange(S // QBLOCK_A))
    return out.transpose(1, 0, 2, 3, 4).reshape(Bsz, S, H, dh)


def dilated_group(q, k, v, window, dilation):
    Bsz, S, G, dh = q.shape
    dv = v.shape[-1]
    n = window // dilation
    L = S // dilation
    nb = -(-L // n)
    Lp = nb * n

    def to_sub(a):
        a = a.reshape(Bsz, L, dilation, G, a.shape[-1]).transpose(0, 2, 1, 3, 4)
        a = jnp.pad(a, ((0, 0), (0, 0), (0, Lp - L), (0, 0), (0, 0)))
        return a.reshape(Bsz, dilation, nb, n, G, a.shape[-1])

    qs, ks, vs = to_sub(q), to_sub(k), to_sub(v)
    shift = ((0, 0), (0, 0), (1, 0), (0, 0), (0, 0), (0, 0))
    kk = jnp.concatenate([jnp.pad(ks[:, :, :-1], shift), ks], axis=3)
    vv = jnp.concatenate([jnp.pad(vs[:, :, :-1], shift), vs], axis=3)
    qi = jnp.arange(n)[:, None] + n
    ki = jnp.arange(2 * n)[None, :]
    dist = qi - ki
    ksub = jnp.arange(nb)[:, None, None] * n + ki[None] - n
    mask = ((dist >= 0) & (dist <= n))[None] & (ksub >= 0)
    logits = jnp.einsum('brnqgd,brnkgd->brngqk', qs, kk).astype(jnp.float32) * (dh ** -0.5)
    logits = jnp.where(mask[None, None, :, None], logits, -jnp.inf)
    lse = jax.nn.logsumexp(logits, axis=-1)
    p = jnp.exp(logits - lse[..., None]).astype(v.dtype)
    out = jnp.einsum('brngqk,brnkgd->brnqgd', p, vv)
    out = out.reshape(Bsz, dilation, Lp, G, dv)[:, :, :L]
    out = out.transpose(0, 2, 1, 3, 4).reshape(Bsz, S, G, dv)
    lse = lse.transpose(0, 1, 2, 4, 3).reshape(Bsz, dilation, Lp, G)[:, :, :L]
    lse = lse.transpose(0, 2, 1, 3).reshape(Bsz, S, G)
    return out, lse


def dilated_attention(q, k, v):
    outs, lses = [], []
    for g, (window, dilation) in enumerate(DIL_PAIRS):
        hs = slice(g * B_GROUP_HEADS, (g + 1) * B_GROUP_HEADS)
        o, l = dilated_group(q[:, :, hs], k[:, :, hs], v, window, dilation)
        outs.append(o)
        lses.append(l)
    wts = jax.nn.softmax(jnp.stack(lses, 0), axis=0).astype(v.dtype)
    return jnp.einsum('gbsh,gbshd->bshd', wts, jnp.stack(outs, 0))


def moba_attention(q, k, v):
    Bsz, S, H, dh = q.shape
    nblk = -(-S // MOBA_BLOCK)
    Sp = nblk * MOBA_BLOCK
    pad = lambda a: jnp.pad(a, ((0, 0), (0, Sp - S), (0, 0), (0, 0)))
    qp = pad(q)
    kbt = pad(k).reshape(Bsz, nblk, MOBA_BLOCK, H, dh).transpose(0, 3, 1, 2, 4)
    vbt = pad(v).reshape(Bsz, nblk, MOBA_BLOCK, H, dh).transpose(0, 3, 1, 2, 4)
    kmean = jnp.mean(kbt.astype(jnp.float32), axis=3)
    ksel = min(MOBA_TOPK, nblk)
    scale = dh ** -0.5
    bidx = jnp.arange(Bsz)[:, None, None, None]
    hidx = jnp.arange(H)[None, :, None, None]

    def block(i):
        t0 = i * QBLOCK_C
        own = t0 // MOBA_BLOCK
        qpos = t0 + jnp.arange(QBLOCK_C)
        qh = lax.dynamic_slice_in_dim(qp, t0, QBLOCK_C, axis=1).transpose(0, 2, 1, 3)
        gate = jnp.einsum('bhqd,bhnd->bhqn', qh.astype(jnp.float32), kmean)
        gate = jnp.where(jnp.arange(nblk) < own, gate, -jnp.inf)
        _, sel = lax.top_k(gate, ksel)
        valid = jnp.repeat(jnp.arange(ksel) < own, MOBA_BLOCK)
        kg = kbt[bidx, hidx, sel]
        vg = vbt[bidx, hidx, sel]
        ko = lax.dynamic_index_in_dim(kbt, own, axis=2, keepdims=False)
        vo = lax.dynamic_index_in_dim(vbt, own, axis=2, keepdims=False)
        kpos = own * MOBA_BLOCK + jnp.arange(MOBA_BLOCK)
        s_sel = jnp.einsum('bhqd,bhqnkd->bhqnk', qh, kg).astype(jnp.float32)
        s_sel = jnp.where(valid, s_sel.reshape(Bsz, H, QBLOCK_C, ksel * MOBA_BLOCK), -jnp.inf)
        s_own = jnp.einsum('bhqd,bhkd->bhqk', qh, ko).astype(jnp.float32)
        s_own = jnp.where(kpos[None, :] <= qpos[:, None], s_own, -jnp.inf)
        p = jax.nn.softmax(jnp.concatenate([s_sel, s_own], -1) * scale, axis=-1).astype(v.dtype)
        p_sel = p[..., :ksel * MOBA_BLOCK].reshape(Bsz, H, QBLOCK_C, ksel, MOBA_BLOCK)
        o = jnp.einsum('bhqnk,bhqnkd->bhqd', p_sel, vg) + jnp.einsum('bhqk,bhkd->bhqd', p[..., ksel * MOBA_BLOCK:], vo)
        return o.transpose(0, 2, 1, 3)

    out = lax.map(block, jnp.arange(Sp // QBLOCK_C))
    return out.transpose(1, 0, 2, 3, 4).reshape(Bsz, Sp, H, dh)[:, :S]


def memory_attention(q, mk, mv):
    logits = jnp.einsum('bshd,bnhd->bhsn', q, mk).astype(jnp.float32) * (HEAD_DIM ** -0.5)
    p = jax.nn.softmax(logits, axis=-1).astype(mv.dtype)
    return jnp.einsum('bhsn,bnhd->bshd', p, mv)


def swiglu(x, w_gate_up, w_down):
    g, u = jnp.split(x @ w_gate_up, 2, axis=-1)
    return (jax.nn.silu(g) * u) @ w_down


def setup_inputs(seed: int = 0) -> dict:
    key = jax.random.key(seed)
    ks = jax.random.split(key, 18)
    n_a, n_b, n_c = (DEPTH + 2) // 3, (DEPTH + 1) // 3, DEPTH // 3
    nrm = lambda k, shape, s: jax.random.normal(k, shape, jnp.float32) * s
    gain = lambda k, shape: 1.0 + nrm(k, shape, 0.02)
    offs = jax.random.randint(ks[2], (BATCH, 1), 0, POS_OFFSET_RANGE, dtype=jnp.int32)
    positions = offs + jnp.arange(SEQ, dtype=jnp.int32)[None, :]
    return {
        'x': nrm(ks[0], (BATCH, SEQ, D_MODEL), 1.0),
        'mem': nrm(ks[1], (BATCH, N_MEM, D_MODEL), 1.0),
        'positions': positions,
        'mem_ln_g': gain(ks[3], (D_MODEL,)),
        'mem_ln_b': nrm(ks[4], (D_MODEL,), 0.02),
        'w_in_a': nrm(ks[5], (n_a, D_MODEL, WIDTH_A), D_MODEL ** -0.5),
        'idx_kn_g': gain(ks[6], (n_a, IDX_DIM)),
        'idx_kn_b': nrm(ks[7], (n_a, IDX_DIM), 0.02),
        'w_in_b': nrm(ks[8], (n_b, D_MODEL, WIDTH_BC), D_MODEL ** -0.5),
        'w_in_c': nrm(ks[9], (n_c, D_MODEL, WIDTH_BC), D_MODEL ** -0.5),
        'w_mem_kv': nrm(ks[10], (DEPTH, D_MODEL, 2 * MEM_WIDTH), D_MODEL ** -0.5),
        'w_out': nrm(ks[11], (DEPTH, MIX_WIDTH + MEM_WIDTH, D_MODEL), BETA * (MIX_WIDTH + MEM_WIDTH) ** -0.5),
        'ln1_g': gain(ks[12], (DEPTH, D_MODEL)),
        'ln1_b': nrm(ks[13], (DEPTH, D_MODEL), 0.02),
        'w_gate_up': nrm(ks[14], (DEPTH, D_MODEL, 2 * D_FF), D_MODEL ** -0.5),
        'w_down': nrm(ks[15], (DEPTH, D_FF, D_MODEL), BETA * D_FF ** -0.5),
        'ln2_g': gain(ks[16], (DEPTH, D_MODEL)),
        'ln2_b': nrm(ks[17], (DEPTH, D_MODEL), 0.02),
    }


def reference(x, mem, positions, mem_ln_g, mem_ln_b, w_in_a, idx_kn_g, idx_kn_b, w_in_b, w_in_c,
              w_mem_kv, w_out, ln1_g, ln1_b, w_gate_up, w_down, ln2_g, ln2_b):
    Bsz, S, _ = x.shape
    cos, sin = rope_tables(positions)
    mem_n = layer_norm(mem, mem_ln_g, mem_ln_b)
    heads = lambda a, h, d: a.reshape(Bsz, S, h, d)
    for i in range(DEPTH):
        kind, j = i % N_MIXERS, i // N_MIXERS
        if kind == 0:
            q, k, v, qi, wi, ki, qm = split_cols(
                x @ w_in_a[j],
                (MIX_WIDTH, MIX_WIDTH, MIX_WIDTH, IDX_HEADS * IDX_DIM, IDX_HEADS, IDX_DIM, MEM_WIDTH))
            q = apply_rope(heads(q, N_HEADS, HEAD_DIM), cos, sin)
            k = apply_rope(heads(k, N_HEADS, HEAD_DIM), cos, sin)
            qi = apply_rope(heads(qi, IDX_HEADS, IDX_DIM), cos, sin)
            ki = apply_rope(layer_norm(ki, idx_kn_g[j], idx_kn_b[j])[:, :, None, :], cos, sin)[:, :, 0]
            wi = wi * (IDX_HEADS * IDX_DIM) ** -0.5
            mix = dsa_attention(q, k, heads(v, N_HEADS, HEAD_DIM), qi, wi, ki)
        elif kind == 1:
            q, k, v, qm = split_cols(x @ w_in_b[j], (MIX_WIDTH, MIX_WIDTH, MIX_WIDTH, MEM_WIDTH))
            q = apply_rope(heads(q, N_HEADS, HEAD_DIM), cos, sin)
            k = apply_rope(heads(k, N_HEADS, HEAD_DIM), cos, sin)
            mix = dilated_attention(q, k, heads(v, B_GROUP_HEADS, B_V_DIM))
        else:
            q, k, v, qm = split_cols(x @ w_in_c[j], (MIX_WIDTH, MIX_WIDTH, MIX_WIDTH, MEM_WIDTH))
            q = apply_rope(heads(q, N_HEADS, HEAD_DIM), cos, sin)
            k = apply_rope(heads(k, N_HEADS, HEAD_DIM), cos, sin)
            mix = moba_attention(q, k, heads(v, N_HEADS, HEAD_DIM))
        mk, mv = jnp.split(mem_n @ w_mem_kv[i], 2, axis=-1)
        mo = memory_attention(heads(qm, N_MEM_HEADS, HEAD_DIM),
                              mk.reshape(Bsz, N_MEM, N_MEM_HEADS, HEAD_DIM),
                              mv.reshape(Bsz, N_MEM, N_MEM_HEADS, HEAD_DIM))
        mixed = jnp.concatenate([mix.reshape(Bsz, S, MIX_WIDTH), mo.reshape(Bsz, S, MEM_WIDTH)], -1) @ w_out[i]
        x = layer_norm(ALPHA * x + mixed, ln1_g[i], ln1_b[i])
        x = layer_norm(ALPHA * x + swiglu(x, w_gate_up[i], w_down[i]), ln2_g[i], ln2_b[i])
    return x
```

```cpp
#include <hip/hip_runtime.h>
#include <hip/hip_cooperative_groups.h>
#include <cstdio>
namespace cg = cooperative_groups;

#ifndef SINGLE_LAUNCH
#define SINGLE_LAUNCH 0
#endif

#define DI __device__ __forceinline__
typedef unsigned short u16;
using bf16x8 = __attribute__((ext_vector_type(8))) __bf16;
using bf2 = __attribute__((ext_vector_type(2))) __bf16;
using f32x4 = __attribute__((ext_vector_type(4))) float;
using f32x16 = __attribute__((ext_vector_type(16))) float;
using u32x4 = __attribute__((ext_vector_type(4))) unsigned;

constexpr int NB = 8, S = 4096, DM = 1024, T = NB * S, DEPTH = 4;
constexpr int NMEM = 256, DFF = 2816;
constexpr int NPAD_A = 3200, NPAD_BC = 2560;
constexpr float ALPHA = 1.681792830507429f;
constexpr float LN_EPS = 1e-5f;

constexpr size_t SZ_WIN_A = (size_t)NPAD_A * 1024 * 2, SZ_WIN_BC = (size_t)NPAD_BC * 1024 * 2;
constexpr size_t OFF_WIN0 = 0;
constexpr size_t OFF_WIN1 = OFF_WIN0 + SZ_WIN_A;
constexpr size_t OFF_WIN2 = OFF_WIN1 + SZ_WIN_BC;
constexpr size_t OFF_WIN3 = OFF_WIN2 + SZ_WIN_BC;
constexpr size_t OFF_WMKV = OFF_WIN3 + SZ_WIN_A;
constexpr size_t SZ_WMKV = (size_t)512 * 1024 * 2;
constexpr size_t OFF_WOUT = OFF_WMKV + 4 * SZ_WMKV;
constexpr size_t SZ_WOUT = (size_t)1024 * 1024 * 2;
constexpr size_t OFF_WGU = OFF_WOUT + 4 * SZ_WOUT;
constexpr size_t SZ_WGU = (size_t)5632 * 1024 * 2;
constexpr size_t OFF_WDN = OFF_WGU + 4 * SZ_WGU;
constexpr size_t SZ_WDN = (size_t)1024 * 2816 * 2;
constexpr size_t OFF_XB = OFF_WDN + 4 * SZ_WDN;
constexpr size_t SZ_XB = (size_t)T * 1024 * 2;
constexpr size_t OFF_MIX = OFF_XB + SZ_XB;
constexpr size_t OFF_MEMN = OFF_MIX + SZ_XB;
constexpr size_t OFF_MK = OFF_MEMN + (size_t)2048 * 1024 * 2;
constexpr size_t SZ_MK = (size_t)8 * 4 * 256 * 64 * 2;
constexpr size_t OFF_MVT = OFF_MK + 4 * SZ_MK;
constexpr size_t OFF_COS = OFF_MVT + 4 * SZ_MK;
constexpr size_t OFF_SIN = OFF_COS + (size_t)T * 8 * 4;
constexpr size_t OFF_KMEAN = OFF_SIN + (size_t)T * 8 * 4;
constexpr size_t OFF_BIG = OFF_KMEAN + (size_t)8 * 12 * 16 * 64 * 4;
constexpr size_t SZ_QKV = (size_t)T * 768 * 2;
constexpr size_t BO_Q = 0, BO_K = SZ_QKV, BO_V = 2 * SZ_QKV;
constexpr size_t BO_QM_AC = 3 * SZ_QKV, BO_QM_B = 5 * SZ_QKV;
constexpr size_t SZ_QM = (size_t)T * 256 * 2;
constexpr size_t BO_QI = BO_QM_AC + SZ_QM;
constexpr size_t BO_KIRAW = BO_QI + (size_t)T * 512 * 2;
constexpr size_t BO_KIB = BO_KIRAW + (size_t)T * 64 * 4;
constexpr size_t BO_WI = BO_KIB + (size_t)T * 64 * 2;
constexpr size_t BO_BM = BO_WI + (size_t)T * 8 * 4;
constexpr size_t BO_H = 0;
constexpr size_t WS_NEED = OFF_BIG + 5 * SZ_QKV + SZ_QM;

struct Ctx { int tid, bid, nb; };

struct Params {
  const float* x; const float* mem; const int* pos; const float* mem_g; const float* mem_b;
  const float* w_in_a; const float* idx_g; const float* idx_b; const float* w_in_b; const float* w_in_c;
  const float* w_mkv; const float* w_out; const float* ln1g; const float* ln1b;
  const float* w_gu; const float* w_dn; const float* ln2g; const float* ln2b;
  float* out; char* ws;
  int ph_lo, ph_hi;
};

DI unsigned pk2(float a, float b) { bf2 v; v[0] = (__bf16)a; v[1] = (__bf16)b; return __builtin_bit_cast(unsigned, v); }
DI u16 f2bf(float a) { return __builtin_bit_cast(u16, (__bf16)a); }
DI float bf2f(u16 b) { return __uint_as_float(((unsigned)b) << 16); }
DI bf16x8 ld8(const u16* p) { return *reinterpret_cast<const bf16x8*>(p); }
DI f32x4 mfma16(bf16x8 a, bf16x8 b, f32x4 c) { return __builtin_amdgcn_mfma_f32_16x16x32_bf16(a, b, c, 0, 0, 0); }
DI f32x16 mfma32(bf16x8 a, bf16x8 b, f32x16 c) { return __builtin_amdgcn_mfma_f32_32x32x16_bf16(a, b, c, 0, 0, 0); }
DI float wave_sum(float v) { for (int o = 32; o > 0; o >>= 1) v += __shfl_xor(v, o); return v; }
DI size_t win_off(int layer) { return layer == 0 ? OFF_WIN0 : layer == 1 ? OFF_WIN1 : layer == 2 ? OFF_WIN2 : OFF_WIN3; }

DI int map_row(int kind, int c) {
  if (kind == 1) {
    if (c < 2304) return c;
    if (c < 2816) return c + 256;
    if (c < 2824) return c - 2816 + 3136;
    if (c < 2888) return c - 2824 + 3072;
    return c - 2888 + 2304;
  }
  if (kind == 2) {
    int isu = c >= DFF; int j = c - isu * DFF; int tile = j >> 6, w = j & 63;
    return tile * 128 + (w >> 5) * 64 + ((((w >> 4) & 1) * 2 + isu) << 4) + (w & 15);
  }
  return c;
}

DI void conv_job(const Ctx& cx, const float* __restrict__ src, int Ks, int Ns, u16* __restrict__ dst, int kind, float* tile) {
  const int nnt = (Ns + 63) >> 6, nkt = Ks >> 6, tid = cx.tid;
  for (int t = cx.bid; t < nnt * nkt; t += cx.nb) {
    const int kt = t / nnt, nt = t % nnt;
    __syncthreads();
#pragma unroll 4
    for (int i = 0; i < 16; ++i) {
      int kk = i * 4 + (tid >> 6), nn = tid & 63, n = nt * 64 + nn;
      tile[kk * 65 + nn] = n < Ns ? src[(size_t)(kt * 64 + kk) * Ns + n] : 0.f;
    }
    __syncthreads();
#pragma unroll 4
    for (int i = 0; i < 8; ++i) {
      int nn = (tid >> 5) + 8 * i, k2 = tid & 31, n = nt * 64 + nn;
      if (n < Ns) {
        int dr = map_row(kind, n);
        *reinterpret_cast<unsigned*>(dst + (size_t)dr * Ks + kt * 64 + 2 * k2) = pk2(tile[(2 * k2) * 65 + nn], tile[(2 * k2 + 1) * 65 + nn]);
      }
    }
  }
}

DI void phase0(const Ctx& cx, const Params& p, char* ws, char* smem) {
  float* tile = reinterpret_cast<float*>(smem);
  for (int l = 0; l < DEPTH; ++l) {
    const int kind = l % 3, j = l / 3;
    const float* win = kind == 0 ? p.w_in_a + (size_t)j * 1024 * 3144 : kind == 1 ? p.w_in_b : p.w_in_c;
    conv_job(cx, win, 1024, kind == 0 ? 3144 : 2560, (u16*)(ws + win_off(l)), kind == 0 ? 1 : 0, tile);
    conv_job(cx, p.w_mkv + (size_t)l * 1024 * 512, 1024, 512, (u16*)(ws + OFF_WMKV + l * SZ_WMKV), 0, tile);
    conv_job(cx, p.w_out + (size_t)l * 1024 * 1024, 1024, 1024, (u16*)(ws + OFF_WOUT + l * SZ_WOUT), 0, tile);
    conv_job(cx, p.w_gu + (size_t)l * 1024 * 5632, 1024, 5632, (u16*)(ws + OFF_WGU + l * SZ_WGU), 2, tile);
    conv_job(cx, p.w_dn + (size_t)l * 2816 * 1024, 2816, 1024, (u16*)(ws + OFF_WDN + l * SZ_WDN), 0, tile);
  }
  const int gtid = cx.bid * 256 + cx.tid, gn = cx.nb * 256;
  for (int l = 0; l < DEPTH; l += 3) {
    unsigned* d = reinterpret_cast<unsigned*>(ws + win_off(l) + (size_t)3144 * 1024 * 2);
    for (int i = gtid; i < 56 * 512; i += gn) d[i] = 0u;
  }
  {
    const float4* xs = reinterpret_cast<const float4*>(p.x);
    uint2* xd = reinterpret_cast<uint2*>(ws + OFF_XB);
    for (int i = gtid; i < T * 256; i += gn) { float4 v = xs[i]; xd[i] = make_uint2(pk2(v.x, v.y), pk2(v.z, v.w)); }
  }
  {
    float* cs = reinterpret_cast<float*>(ws + OFF_COS); float* sn = reinterpret_cast<float*>(ws + OFF_SIN);
    for (int i = gtid; i < T * 8; i += gn) {
      int t = i >> 3, f = i & 7;
      float inv = (float)pow(500000.0, -(double)f / 8.0);
      float ang = (float)p.pos[t] * inv;
      cs[i] = cosf(ang); sn[i] = sinf(ang);
    }
  }
  {
    const int lane = cx.tid & 63, gw = cx.bid * 4 + (cx.tid >> 6), nw = cx.nb * 4;
    u16* mn = reinterpret_cast<u16*>(ws + OFF_MEMN);
    for (int r = gw; r < NB * NMEM; r += nw) {
      const float4* src = reinterpret_cast<const float4*>(p.mem + (size_t)r * 1024);
      float4 v[4]; float s = 0.f;
      for (int i = 0; i < 4; ++i) { v[i] = src[i * 64 + lane]; s += v[i].x + v[i].y + v[i].z + v[i].w; }
      float mu = wave_sum(s) * (1.f / 1024.f);
      float q = 0.f;
      for (int i = 0; i < 4; ++i) { float a = v[i].x - mu, b = v[i].y - mu, c = v[i].z - mu, d = v[i].w - mu; q += a * a + b * b + c * c + d * d; }
      float rs = rsqrtf(wave_sum(q) * (1.f / 1024.f) + LN_EPS);
      for (int i = 0; i < 4; ++i) {
        int c = (i * 64 + lane) * 4;
        float4 g = *reinterpret_cast<const float4*>(p.mem_g + c), bb = *reinterpret_cast<const float4*>(p.mem_b + c);
        uint2 o = make_uint2(pk2((v[i].x - mu) * rs * g.x + bb.x, (v[i].y - mu) * rs * g.y + bb.y),
                             pk2((v[i].z - mu) * rs * g.z + bb.z, (v[i].w - mu) * rs * g.w + bb.w));
        *reinterpret_cast<uint2*>(mn + (size_t)r * 1024 + c) = o;
      }
    }
  }
}

template <class Epi>
DI void gemm_tile(const Ctx& cx, const u16* __restrict__ A, const u16* __restrict__ Bt, int K, int m0, int n0, char* smem, const Epi& epi) {
  u16* As = reinterpret_cast<u16*>(smem);
  u16* Bs = reinterpret_cast<u16*>(smem + 32768);
  const int tid = cx.tid, lane = tid & 63, wid = tid >> 6, wr = wid >> 1, wc = wid & 1;
  f32x4 acc[4][4];
#pragma unroll
  for (int i = 0; i < 4; ++i)
#pragma unroll
    for (int j = 0; j < 4; ++j) acc[i][j] = f32x4{0.f, 0.f, 0.f, 0.f};
  u32x4 ra[4], rb[4];
  const int srow = tid >> 3, sch = tid & 7;
  const u16* ag = A + (size_t)(m0 + srow) * K + sch * 8;
  const u16* bg = Bt + (size_t)(n0 + srow) * K + sch * 8;
  const int nk = K >> 6;
#define GLOAD(kt) { _Pragma("unroll") for (int i = 0; i < 4; ++i) { \
    ra[i] = *reinterpret_cast<const u32x4*>(ag + (size_t)(32 * i) * K + (kt) * 64); \
    rb[i] = *reinterpret_cast<const u32x4*>(bg + (size_t)(32 * i) * K + (kt) * 64); } }
#define SWRITE(buf) { _Pragma("unroll") for (int i = 0; i < 4; ++i) { int row = srow + 32 * i; int pc = sch ^ ((row >> 1) & 7); \
    *reinterpret_cast<u32x4*>(As + (buf) * 8192 + row * 64 + pc * 8) = ra[i]; \
    *reinterpret_cast<u32x4*>(Bs + (buf) * 8192 + row * 64 + pc * 8) = rb[i]; } }
  GLOAD(0); SWRITE(0);
  __syncthreads();
  for (int kt = 0; kt < nk; ++kt) {
    const int buf = kt & 1;
    if (kt + 1 < nk) GLOAD(kt + 1);
#pragma unroll
    for (int kk = 0; kk < 2; ++kk) {
      bf16x8 a[4], b[4];
      const int ch = kk * 4 + (lane >> 4);
#pragma unroll
      for (int mi = 0; mi < 4; ++mi) { int row = wr * 64 + mi * 16 + (lane & 15); a[mi] = ld8(As + buf * 8192 + row * 64 + ((ch ^ ((row >> 1) & 7)) << 3)); }
#pragma unroll
      for (int ni = 0; ni < 4; ++ni) { int row = wc * 64 + ni * 16 + (lane & 15); b[ni] = ld8(Bs + buf * 8192 + row * 64 + ((ch ^ ((row >> 1) & 7)) << 3)); }
#pragma unroll
      for (int mi = 0; mi < 4; ++mi)
#pragma unroll
        for (int ni = 0; ni < 4; ++ni) acc[mi][ni] = mfma16(a[mi], b[ni], acc[mi][ni]);
    }
    if (kt + 1 < nk) SWRITE(buf ^ 1);
    __syncthreads();
  }
#undef GLOAD
#undef SWRITE
  epi(acc, m0 + wr * 64, n0 + wc * 64, lane);
}

DI void tile_mn(int id, int NT, int& mt, int& nt) { int g = id / (8 * NT), rem = id % (8 * NT); nt = rem >> 3; mt = g * 8 + (rem & 7); }

struct EpiInProj {
  char* ws; int kind;
  DI void operator()(f32x4 (&acc)[4][4], int row0, int col0, int lane) const {
    char* big = ws + OFF_BIG;
    const float* cs = reinterpret_cast<const float*>(ws + OFF_COS);
    const float* sn = reinterpret_cast<const float*>(ws + OFF_SIN);
    const int cl = lane & 15, rq = (lane >> 4) * 4;
#pragma unroll
    for (int ni = 0; ni < 4; ++ni) {
      const int c0 = col0 + ni * 16;
      if (c0 < 1536 || (c0 >= 2304 && c0 < 3072)) {
        u16* dst; int h, d0; bool rope = true; int kindq;
        if (c0 < 768) { kindq = 0; h = c0 >> 6; d0 = c0 & 63; }
        else if (c0 < 1536) { kindq = 1; h = (c0 - 768) >> 6; d0 = c0 & 63; }
        else if (c0 < 2560) { kindq = 2; h = (c0 - 2304) >> 6; d0 = c0 & 63; rope = false; }
        else { kindq = 3; h = (c0 - 2560) >> 6; d0 = c0 & 63; }
        rope = rope && (d0 == 0);
#pragma unroll
        for (int mi = 0; mi < 4; ++mi)
#pragma unroll
          for (int j = 0; j < 4; ++j) {
            const int row = row0 + mi * 16 + rq + j;
            float v = acc[mi][ni][j];
            if (rope) {
              float pv = __shfl_xor(v, 8);
              float c = cs[row * 8 + (cl & 7)], s = sn[row * 8 + (cl & 7)];
              v = (cl < 8) ? v * c - pv * s : v * c + pv * s;
            }
            const int b = row >> 12, s_ = row & 4095;
            size_t off;
            if (kindq == 0) off = BO_Q + (((size_t)(b * 12 + h) * S + s_) * 64 + d0 + cl) * 2;
            else if (kindq == 1) off = BO_K + (((size_t)(b * 12 + h) * S + s_) * 64 + d0 + cl) * 2;
            else if (kindq == 2) off = (kind == 1 ? BO_QM_B : BO_QM_AC) + (((size_t)(b * 4 + h) * S + s_) * 64 + d0 + cl) * 2;
            else off = BO_QI + (((size_t)row * 8 + h) * 64 + d0 + cl) * 2;
            *reinterpret_cast<u16*>(big + off) = f2bf(v);
          }
      } else if (c0 < 2304) {
        const int cv = c0 - 1536;
#pragma unroll
        for (int mi = 0; mi < 4; ++mi) {
          const int row = row0 + mi * 16 + rq;
          const int b = row >> 12, s_ = row & 4095;
          const f32x4 a = acc[mi][ni];
          if (kind != 1) {
            const int h = cv >> 6, d = (cv & 63) + cl;
            u16* vt = reinterpret_cast<u16*>(big + BO_V) + ((size_t)(b * 12 + h) * 128 + (s_ >> 5)) * 2048 + d * 32 + (s_ & 31);
            *reinterpret_cast<uint2*>(vt) = make_uint2(pk2(a[0], a[1]), pk2(a[2], a[3]));
          } else {
            const int hh = cv / 192, dv = cv % 192 + cl;
            u16* v0 = reinterpret_cast<u16*>(big + BO_V) + ((size_t)(b * 4 + hh) * 128 + (s_ >> 5)) * 6144 + dv * 32 + (s_ & 31);
            *reinterpret_cast<uint2*>(v0) = make_uint2(pk2(a[0], a[1]), pk2(a[2], a[3]));
            u16* v1 = reinterpret_cast<u16*>(big + BO_V + SZ_QKV);
            u16* v2 = reinterpret_cast<u16*>(big + BO_V + 2 * SZ_QKV);
            const int j4 = s_ >> 2, j16 = s_ >> 4, r16 = s_ & 15;
#pragma unroll
            for (int j = 0; j < 4; ++j) {
              v1[(((size_t)(b * 4 + hh) * 4 + j) * 32 + (j4 >> 5)) * 6144 + dv * 32 + (j4 & 31)] = f2bf(a[j]);
              v2[(((size_t)(b * 4 + hh) * 16 + r16 + j) * 8 + (j16 >> 5)) * 6144 + dv * 32 + (j16 & 31)] = f2bf(a[j]);
            }
          }
        }
      } else if (c0 < 3136) {
#pragma unroll
        for (int mi = 0; mi < 4; ++mi)
#pragma unroll
          for (int j = 0; j < 4; ++j) {
            const int row = row0 + mi * 16 + rq + j;
            reinterpret_cast<float*>(big + BO_KIRAW)[(size_t)row * 64 + (c0 - 3072) + cl] = acc[mi][ni][j];
          }
      } else if (c0 < 3152) {
        if (cl < 8) {
#pragma unroll
          for (int mi = 0; mi < 4; ++mi)
#pragma unroll
            for (int j = 0; j < 4; ++j) {
              const int row = row0 + mi * 16 + rq + j;
              reinterpret_cast<float*>(big + BO_WI)[(size_t)row * 8 + cl] = acc[mi][ni][j] * 0.04419417382415922f;
            }
        }
      }
    }
  }
};

struct EpiMemKV {
  char* ws; int layer;
  DI void operator()(f32x4 (&acc)[4][4], int row0, int col0, int lane) const {
    const int cl = lane & 15, rq = (lane >> 4) * 4;
    u16* mk = reinterpret_cast<u16*>(ws + OFF_MK + layer * SZ_MK);
    u16* mvt = reinterpret_cast<u16*>(ws + OFF_MVT + layer * SZ_MK);
#pragma unroll
    for (int ni = 0; ni < 4; ++ni) {
      const int c0 = col0 + ni * 16;
#pragma unroll
      for (int mi = 0; mi < 4; ++mi) {
        const int row = row0 + mi * 16 + rq;
        const int b = row >> 8, n = row & 255;
        const f32x4 a = acc[mi][ni];
        if (c0 < 256) {
          const int h = c0 >> 6, d = (c0 & 63) + cl;
#pragma unroll
          for (int j = 0; j < 4; ++j) mk[((size_t)(b * 4 + h) * 256 + n + j) * 64 + d] = f2bf(a[j]);
        } else {
          const int cv = c0 - 256, h = cv >> 6, d = (cv & 63) + cl;
          *reinterpret_cast<uint2*>(mvt + ((size_t)(b * 4 + h) * 8 + (n >> 5)) * 2048 + d * 32 + (n & 31)) = make_uint2(pk2(a[0], a[1]), pk2(a[2], a[3]));
        }
      }
    }
  }
};

struct EpiResid {
  const float* xsrc; float* out;
  DI void operator()(f32x4 (&acc)[4][4], int row0, int col0, int lane) const {
    const int cl = lane & 15, rq = (lane >> 4) * 4;
#pragma unroll
    for (int mi = 0; mi < 4; ++mi)
#pragma unroll
      for (int ni = 0; ni < 4; ++ni)
#pragma unroll
        for (int j = 0; j < 4; ++j) {
          const size_t idx = (size_t)(row0 + mi * 16 + rq + j) * 1024 + col0 + ni * 16 + cl;
          out[idx] = ALPHA * xsrc[idx] + acc[mi][ni][j];
        }
  }
};

struct EpiSwiGLU {
  u16* h;
  DI void operator()(f32x4 (&acc)[4][4], int row0, int col0, int lane) const {
    const int cl = lane & 15, rq = (lane >> 4) * 4;
    const int hb = (col0 >> 7) * 64 + ((col0 >> 6) & 1) * 32;
#pragma unroll
    for (int mi = 0; mi < 4; ++mi)
#pragma unroll
      for (int pp = 0; pp < 2; ++pp)
#pragma unroll
        for (int j = 0; j < 4; ++j) {
          const float g = acc[mi][2 * pp][j], u = acc[mi][2 * pp + 1][j];
          const float v = g / (1.f + __expf(-g)) * u;
          h[(size_t)(row0 + mi * 16 + rq + j) * DFF + hb + pp * 16 + cl] = f2bf(v);
        }
  }
};

DI void ln_phase(const Ctx& cx, float* xio, const float* __restrict__ g, const float* __restrict__ b, u16* xb) {
  const int lane = cx.tid & 63, gw = cx.bid * 4 + (cx.tid >> 6), nw = cx.nb * 4;
  float4 gg[4], bb[4];
  for (int i = 0; i < 4; ++i) { gg[i] = *reinterpret_cast<const float4*>(g + (i * 64 + lane) * 4); bb[i] = *reinterpret_cast<const float4*>(b + (i * 64 + lane) * 4); }
  for (int r = gw; r < T; r += nw) {
    float4* row = reinterpret_cast<float4*>(xio + (size_t)r * 1024);
    float4 v[4]; float s = 0.f;
    for (int i = 0; i < 4; ++i) { v[i] = row[i * 64 + lane]; s += v[i].x + v[i].y + v[i].z + v[i].w; }
    const float mu = wave_sum(s) * (1.f / 1024.f);
    float q = 0.f;
    for (int i = 0; i < 4; ++i) { float a = v[i].x - mu, b2 = v[i].y - mu, c = v[i].z - mu, d = v[i].w - mu; q += a * a + b2 * b2 + c * c + d * d; }
    const float rs = rsqrtf(wave_sum(q) * (1.f / 1024.f) + LN_EPS);
    for (int i = 0; i < 4; ++i) {
      float4 o;
      o.x = (v[i].x - mu) * rs * gg[i].x + bb[i].x; o.y = (v[i].y - mu) * rs * gg[i].y + bb[i].y;
      o.z = (v[i].z - mu) * rs * gg[i].z + bb[i].z; o.w = (v[i].w - mu) * rs * gg[i].w + bb[i].w;
      row[i * 64 + lane] = o;
      *reinterpret_cast<uint2*>(xb + (size_t)r * 1024 + (i * 64 + lane) * 4) = make_uint2(pk2(o.x, o.y), pk2(o.z, o.w));
    }
  }
}

template <int NDT> struct AttState { f32x16 o[NDT]; float m, l; };
template <int NDT> DI void att_init(AttState<NDT>& st) {
#pragma unroll
  for (int d = 0; d < NDT; ++d)
#pragma unroll
    for (int r = 0; r < 16; ++r) st.o[d][r] = 0.f;
  st.m = -1e30f; st.l = 0.f;
}
DI int pi_swap(int i) { return (i & 0x13) | ((i & 4) << 1) | ((i & 8) >> 1); }

template <int NDT, class MaskF>
DI void att_tile(AttState<NDT>& st, const bf16x8 (&qf)[4], const u16* krow, const u16* vt, const MaskF& maskf) {
  f32x16 s;
#pragma unroll
  for (int r = 0; r < 16; ++r) s[r] = 0.f;
#pragma unroll
  for (int c = 0; c < 4; ++c) s = mfma32(ld8(krow + c * 16), qf[c], s);
  float mx = -1e30f;
#pragma unroll
  for (int r = 0; r < 16; ++r) { float v = maskf(r) ? s[r] * 0.125f : -1e30f; s[r] = v; mx = fmaxf(mx, v); }
  mx = fmaxf(mx, __shfl_xor(mx, 32));
  const float mnew = fmaxf(st.m, mx);
  const float alpha = __expf(st.m - mnew);
  float ps = 0.f;
#pragma unroll
  for (int r = 0; r < 16; ++r) { s[r] = __expf(s[r] - mnew); ps += s[r]; }
  st.l = st.l * alpha + ps; st.m = mnew;
  if (__any(alpha != 1.f)) {
#pragma unroll
    for (int d = 0; d < NDT; ++d)
#pragma unroll
      for (int r = 0; r < 16; ++r) st.o[d][r] *= alpha;
  }
  bf16x8 pf[2];
#pragma unroll
  for (int c = 0; c < 2; ++c) {
    u32x4 t;
#pragma unroll
    for (int j = 0; j < 4; ++j) t[j] = pk2(s[8 * c + 2 * j], s[8 * c + 2 * j + 1]);
    pf[c] = __builtin_bit_cast(bf16x8, t);
  }
#pragma unroll
  for (int d = 0; d < NDT; ++d)
#pragma unroll
    for (int c = 0; c < 2; ++c) st.o[d] = mfma32(ld8(vt + d * 1024 + c * 16), pf[c], st.o[d]);
}

template <int NDT> DI void att_store(AttState<NDT>& st, u16* orow, int hf) {
  const float lt = st.l + __shfl_xor(st.l, 32);
  const float inv = 1.f / lt;
#pragma unroll
  for (int d = 0; d < NDT; ++d)
#pragma unroll
    for (int g = 0; g < 4; ++g) {
      uint2 v = make_uint2(pk2(st.o[d][4 * g] * inv, st.o[d][4 * g + 1] * inv), pk2(st.o[d][4 * g + 2] * inv, st.o[d][4 * g + 3] * inv));
      *reinterpret_cast<uint2*>(orow + d * 32 + 8 * g + 4 * hf) = v;
    }
}

DI void load_q(bf16x8 (&qf)[4], const u16* qrow, int hf) {
#pragma unroll
  for (int c = 0; c < 4; ++c) qf[c] = ld8(qrow + c * 16 + 8 * hf);
}

DI void mem_att_unit(char* ws, int layer, int kind, int u, int lane) {
  const int qt = u & 127, bh = u >> 7, b = bh >> 2, hm = bh & 3;
  const int ql = lane & 31, hf = lane >> 5, tq = qt * 32 + ql;
  const u16* QM = reinterpret_cast<const u16*>(ws + OFF_BIG + (kind == 1 ? BO_QM_B : BO_QM_AC));
  const u16* MK = reinterpret_cast<const u16*>(ws + OFF_MK + layer * SZ_MK);
  const u16* MVT = reinterpret_cast<const u16*>(ws + OFF_MVT + layer * SZ_MK);
  bf16x8 qf[4]; load_q(qf, QM + ((size_t)bh * S + tq) * 64, hf);
  AttState<2> st; att_init(st);
  const int pk = pi_swap(ql);
  for (int kt = 0; kt < 8; ++kt) {
    const u16* krow = MK + ((size_t)bh * 256 + kt * 32 + pk) * 64 + 8 * hf;
    const u16* vt = MVT + ((size_t)bh * 8 + kt) * 2048 + ql * 32 + 8 * hf;
    att_tile<2>(st, qf, krow, vt, [](int) { return true; });
  }
  u16* mix = reinterpret_cast<u16*>(ws + OFF_MIX);
  att_store<2>(st, mix + (size_t)(b * S + tq) * 1024 + 768 + hm * 64, hf);
}

DI void dsa_att_unit(char* ws, int bh, int qt, int lane) {
  const int b = bh / 12, h = bh % 12;
  const int ql = lane & 31, hf = lane >> 5, tq = qt * 32 + ql;
  char* big = ws + OFF_BIG;
  const u16* Q = reinterpret_cast<const u16*>(big + BO_Q);
  const u16* K = reinterpret_cast<const u16*>(big + BO_K);
  const u16* VT = reinterpret_cast<const u16*>(big + BO_V);
  const unsigned* BM = reinterpret_cast<const unsigned*>(big + BO_BM) + (size_t)(b * S + tq) * 128;
  bf16x8 qf[4]; load_q(qf, Q + ((size_t)bh * S + tq) * 64, hf);
  AttState<2> st; att_init(st);
  const int pk = pi_swap(ql);
  for (int kt = 0; kt <= qt; ++kt) {
    const unsigned w = BM[kt] >> (8 * hf);
    if (!__any(w != 0u)) continue;
    const u16* krow = K + ((size_t)bh * S + kt * 32 + pk) * 64 + 8 * hf;
    const u16* vt = VT + ((size_t)bh * 128 + kt) * 2048 + ql * 32 + 8 * hf;
    att_tile<2>(st, qf, krow, vt, [w](int r) { return ((w >> (16 * (r >> 3) + (r & 7))) & 1u) != 0u; });
  }
  u16* mix = reinterpret_cast<u16*>(ws + OFF_MIX);
  att_store<2>(st, mix + (size_t)(b * S + tq) * 1024 + h * 64, hf);
}

DI void moba_att_unit(char* ws, int bh, int qt, int lane) {
  const int b = bh / 12, h = bh % 12;
  const int ql = lane & 31, hf = lane >> 5, tq = qt * 32 + ql;
  char* big = ws + OFF_BIG;
  const u16* Q = reinterpret_cast<const u16*>(big + BO_Q);
  const u16* K = reinterpret_cast<const u16*>(big + BO_K);
  const u16* VT = reinterpret_cast<const u16*>(big + BO_V);
  const float* KM = reinterpret_cast<const float*>(ws + OFF_KMEAN) + (size_t)bh * 16 * 64;
  const u16* qrow = Q + ((size_t)bh * S + tq) * 64;
  bf16x8 qf[4]; load_q(qf, qrow, hf);
  const int own = qt >> 3;
  unsigned selmask = 0u;
  {
    float b0 = -3e38f, b1 = -3e38f, b2 = -3e38f; int i0 = -1, i1 = -1, i2 = -1;
    for (int n = 0; n < own; ++n) {
      float g = 0.f;
      for (int d8 = 0; d8 < 8; ++d8) {
        const u32x4 qq = *reinterpret_cast<const u32x4*>(qrow + d8 * 8);
        const float4 ka = *reinterpret_cast<const float4*>(KM + n * 64 + d8 * 8);
        const float4 kb = *reinterpret_cast<const float4*>(KM + n * 64 + d8 * 8 + 4);
        g += __uint_as_float(qq[0] << 16) * ka.x + __uint_as_float(qq[0] & 0xffff0000u) * ka.y
           + __uint_as_float(qq[1] << 16) * ka.z + __uint_as_float(qq[1] & 0xffff0000u) * ka.w
           + __uint_as_float(qq[2] << 16) * kb.x + __uint_as_float(qq[2] & 0xffff0000u) * kb.y
           + __uint_as_float(qq[3] << 16) * kb.z + __uint_as_float(qq[3] & 0xffff0000u) * kb.w;
      }
      if (g > b0) { b2 = b1; i2 = i1; b1 = b0; i1 = i0; b0 = g; i0 = n; }
      else if (g > b1) { b2 = b1; i2 = i1; b1 = g; i1 = n; }
      else if (g > b2) { b2 = g; i2 = n; }
    }
    if (i0 >= 0) selmask |= 1u << i0;
    if (i1 >= 0) selmask |= 1u << i1;
    if (i2 >= 0) selmask |= 1u << i2;
  }
  AttState<2> st; att_init(st);
  const int pk = pi_swap(ql);
  for (int n = 0; n < own; ++n) {
    const bool mine = (selmask >> n) & 1u;
    if (!__any(mine)) continue;
    for (int kt = n * 8; kt < n * 8 + 8; ++kt) {
      const u16* krow = K + ((size_t)bh * S + kt * 32 + pk) * 64 + 8 * hf;
      const u16* vt = VT + ((size_t)bh * 128 + kt) * 2048 + ql * 32 + 8 * hf;
      att_tile<2>(st, qf, krow, vt, [mine](int) { return mine; });
    }
  }
  for (int kt = own * 8; kt <= qt; ++kt) {
    const u16* krow = K + ((size_t)bh * S + kt * 32 + pk) * 64 + 8 * hf;
    const u16* vt = VT + ((size_t)bh * 128 + kt) * 2048 + ql * 32 + 8 * hf;
    const int kb = kt * 32 + 8 * hf;
    att_tile<2>(st, qf, krow, vt, [kb, tq](int r) { return kb + 16 * (r >> 3) + (r & 7) <= tq; });
  }
  u16* mix = reinterpret_cast<u16*>(ws + OFF_MIX);
  att_store<2>(st, mix + (size_t)(b * S + tq) * 1024 + h * 64, hf);
}

DI void dil_att_unit(char* ws, int u, int lane) {
  const int r16 = u & 15, T0 = (u >> 4) & 7, bhh = u >> 7, b = bhh >> 2, hh = bhh & 3;
  const int ql = lane & 31, hf = lane >> 5;
  const int tq = T0 * 512 + 16 * ql + r16;
  char* big = ws + OFF_BIG;
  const u16* Q = reinterpret_cast<const u16*>(big + BO_Q);
  const u16* K = reinterpret_cast<const u16*>(big + BO_K);
  const u16* V0 = reinterpret_cast<const u16*>(big + BO_V);
  const u16* V1 = reinterpret_cast<const u16*>(big + BO_V + SZ_QKV);
  const u16* V2 = reinterpret_cast<const u16*>(big + BO_V + 2 * SZ_QKV);
  AttState<6> st; att_init(st);
  const int pk = pi_swap(ql);
  bf16x8 qf[4];
  {
    const int bh = b * 12 + hh;
    load_q(qf, Q + ((size_t)bh * S + tq) * 64, hf);
    const int tmin = T0 * 512 + r16, tmax = tmin + 496;
    int k0 = tmin - 128; k0 = k0 < 0 ? 0 : k0 >> 5;
    for (int kt = k0; kt <= (tmax >> 5); ++kt) {
      const u16* krow = K + ((size_t)bh * S + kt * 32 + pk) * 64 + 8 * hf;
      const u16* vt = V0 + ((size_t)(b * 4 + hh) * 128 + kt) * 6144 + ql * 32 + 8 * hf;
      const int kb = kt * 32 + 8 * hf;
      att_tile<6>(st, qf, krow, vt, [kb, tq](int r) { return (unsigned)(tq - (kb + 16 * (r >> 3) + (r & 7))) <= 128u; });
    }
  }
  {
    const int bh = b * 12 + 4 + hh;
    load_q(qf, Q + ((size_t)bh * S + tq) * 64, hf);
    const int r4 = r16 & 3, jq = tq >> 2;
    const int jmin = T0 * 128 + (r16 >> 2), jmax = jmin + 124;
    int k0 = jmin - 128; k0 = k0 < 0 ? 0 : k0 >> 5;
    for (int jt = k0; jt <= (jmax >> 5); ++jt) {
      const u16* krow = K + ((size_t)bh * S + (jt * 32 + pk) * 4 + r4) * 64 + 8 * hf;
      const u16* vt = V1 + (((size_t)(b * 4 + hh) * 4 + r4) * 32 + jt) * 6144 + ql * 32 + 8 * hf;
      const int kb = jt * 32 + 8 * hf;
      att_tile<6>(st, qf, krow, vt, [kb, jq](int r) { return (unsigned)(jq - (kb + 16 * (r >> 3) + (r & 7))) <= 128u; });
    }
  }
  {
    const int bh = b * 12 + 8 + hh;
    load_q(qf, Q + ((size_t)bh * S + tq) * 64, hf);
    const int jq = tq >> 4;
    int k0 = T0 * 32 - 128; k0 = k0 < 0 ? 0 : k0 >> 5;
    for (int jt = k0; jt <= T0; ++jt) {
      const u16* krow = K + ((size_t)bh * S + (jt * 32 + pk) * 16 + r16) * 64 + 8 * hf;
      const u16* vt = V2 + (((size_t)(b * 4 + hh) * 16 + r16) * 8 + jt) * 6144 + ql * 32 + 8 * hf;
      const int kb = jt * 32 + 8 * hf;
      att_tile<6>(st, qf, krow, vt, [kb, jq](int r) { return (unsigned)(jq - (kb + 16 * (r >> 3) + (r & 7))) <= 128u; });
    }
  }
  u16* mix = reinterpret_cast<u16*>(ws + OFF_MIX);
  att_store<6>(st, mix + (size_t)(b * S + tq) * 1024 + hh * 192, hf);
}

DI void ki_prep_phase(const Ctx& cx, char* ws, const float* g, const float* bta) {
  const int lane = cx.tid & 63, gw = cx.bid * 4 + (cx.tid >> 6), nw = cx.nb * 4;
  const float* raw = reinterpret_cast<const float*>(ws + OFF_BIG + BO_KIRAW);
  u16* kib = reinterpret_cast<u16*>(ws + OFF_BIG + BO_KIB);
  const float* cs = reinterpret_cast<const float*>(ws + OFF_COS);
  const float* sn = reinterpret_cast<const float*>(ws + OFF_SIN);
  const float gg = g[lane], bb = bta[lane];
  for (int r = gw; r < T; r += nw) {
    const float v = raw[(size_t)r * 64 + lane];
    const float mu = wave_sum(v) * (1.f / 64.f);
    const float d = v - mu;
    const float rs = rsqrtf(wave_sum(d * d) * (1.f / 64.f) + LN_EPS);
    float y = d * rs * gg + bb;
    const float py = __shfl_xor(y, 8);
    if (lane < 16) {
      const float c = cs[r * 8 + (lane & 7)], s = sn[r * 8 + (lane & 7)];
      y = lane < 8 ? y * c - py * s : y * c + py * s;
    }
    kib[(size_t)r * 64 + lane] = f2bf(y);
  }
}

DI unsigned sortable(float f) { unsigned u = __float_as_uint(f); return (u & 0x80000000u) ? ~u : (u | 0x80000000u); }

DI unsigned long long select256(const unsigned (&u)[64], int tmax, int lane) {
  unsigned th = 0u;
  for (int bit = 31; bit >= 0; --bit) {
    const unsigned c = th | (1u << bit);
    int n = 0;
#pragma unroll
    for (int r = 0; r < 64; ++r) if (r * 64 <= tmax) n += __popcll(__ballot(u[r] >= c));
    if (n >= 256) th = c;
  }
  int g = 0;
#pragma unroll
  for (int r = 0; r < 64; ++r) if (r * 64 <= tmax) g += __popcll(__ballot(u[r] > th));
  int need = th == 0u ? 0 : 256 - g;
  unsigned long long m = 0ull;
#pragma unroll
  for (int r = 0; r < 64; ++r) {
    if (r * 64 <= tmax) {
      const unsigned long long gt = __ballot(u[r] > th), eq = __ballot(u[r] == th);
      const int pre = __builtin_amdgcn_mbcnt_hi((unsigned)(eq >> 32), __builtin_amdgcn_mbcnt_lo((unsigned)eq, 0u));
      const unsigned long long tk = __ballot(u[r] == th && pre < need);
      need -= __popcll(tk);
      if (lane == r) m = gt | tk;
    }
  }
  return m;
}

DI void dsa_select_unit(char* ws, int b, int t0, int lane, unsigned* lds) {
  char* big = ws + OFF_BIG;
  const u16* QI = reinterpret_cast<const u16*>(big + BO_QI);
  const u16* KIB = reinterpret_cast<const u16*>(big + BO_KIB) + (size_t)b * S * 64;
  const float* WI = reinterpret_cast<const float*>(big + BO_WI);
  unsigned long long* BM = reinterpret_cast<unsigned long long*>(big + BO_BM);
  const int row = lane & 15, kq = lane >> 4;
  const u16* qip = QI + ((size_t)(b * S + t0 + (row >> 3)) * 8 + (row & 7)) * 64 + kq * 8;
  const bf16x8 qa0 = ld8(qip), qa1 = ld8(qip + 32);
  const float4 w = *reinterpret_cast<const float4*>(WI + (size_t)(b * S + t0 + (lane >> 5)) * 8 + ((lane >> 4) & 1) * 4);
  unsigned u[64];
  const int tmax = t0 + 1;
#pragma unroll
  for (int r = 0; r < 64; ++r) {
    if (r * 64 <= tmax) {
      float sv[4];
#pragma unroll
      for (int tt = 0; tt < 4; ++tt) {
        const u16* kp = KIB + (size_t)(r * 64 + tt * 16 + row) * 64 + kq * 8;
        f32x4 c = f32x4{0.f, 0.f, 0.f, 0.f};
        c = mfma16(qa0, ld8(kp), c);
        c = mfma16(qa1, ld8(kp + 32), c);
        float pp = w.x * fmaxf(c[0], 0.f) + w.y * fmaxf(c[1], 0.f) + w.z * fmaxf(c[2], 0.f) + w.w * fmaxf(c[3], 0.f);
        pp += __shfl_xor(pp, 16);
        sv[tt] = pp;
      }
      float ov[4];
#pragma unroll
      for (int tt = 0; tt < 4; ++tt) ov[tt] = __shfl_xor(sv[tt], 32);
      const float a = kq == 0 ? sv[0] : kq == 1 ? sv[1] : kq == 2 ? sv[2] : sv[3];
      const float o = kq == 0 ? ov[0] : kq == 1 ? ov[1] : kq == 2 ? ov[2] : ov[3];
      const float s0 = lane < 32 ? a : o, s1 = lane < 32 ? o : a;
      const int key = r * 64 + lane;
      u[r] = key <= t0 ? sortable(s0) : 0u;
      lds[r * 64 + lane] = key <= t0 + 1 ? sortable(s1) : 0u;
    } else { u[r] = 0u; }
  }
  const unsigned long long m0 = select256(u, tmax, lane);
  BM[(size_t)(b * S + t0) * 64 + lane] = m0;
#pragma unroll
  for (int r = 0; r < 64; ++r) u[r] = (r * 64 <= tmax) ? lds[r * 64 + lane] : 0u;
  const unsigned long long m1 = select256(u, tmax, lane);
  BM[(size_t)(b * S + t0 + 1) * 64 + lane] = m1;
}

DI void kmean_phase(const Ctx& cx, char* ws) {
  const int lane = cx.tid & 63, gw = cx.bid * 4 + (cx.tid >> 6), nw = cx.nb * 4;
  const u16* K = reinterpret_cast<const u16*>(ws + OFF_BIG + BO_K);
  float* KM = reinterpret_cast<float*>(ws + OFF_KMEAN);
  for (int u = gw; u < NB * 12 * 16; u += nw) {
    const int bh = u >> 4, blk = u & 15;
    const u16* kp = K + ((size_t)bh * S + blk * 256) * 64 + lane;
    float s = 0.f;
    for (int i = 0; i < 256; ++i) s += bf2f(kp[i * 64]);
    KM[(size_t)u * 64 + lane] = s * (1.f / 256.f);
  }
}

__global__ void __launch_bounds__(256, 2) fwd_kernel(Params p) {
  __shared__ __attribute__((aligned(16))) char smem[65536];
  cg::grid_group grid = cg::this_grid();
  bool first = true;
  for (int ph = p.ph_lo; ph < p.ph_hi; ++ph) {
    int layer = 0, slot = -1;
    if (ph > 0) { layer = (ph - 1) / 9; slot = (ph - 1) % 9; }
    const int kind = layer % 3, jl = layer / 3;
    if ((slot == 1 && kind == 1) || (slot == 2 && kind != 0)) continue;
    if (!first) grid.sync();
    first = false;
    char* ws = p.ws; float* outp = p.out;
    Ctx cx; cx.tid = threadIdx.x; cx.bid = blockIdx.x; cx.nb = gridDim.x;
    asm volatile("" : "+s"(ws), "+s"(outp), "+v"(cx.tid), "+s"(cx.bid), "+s"(cx.nb));
    const int lane = cx.tid & 63, wid = cx.tid >> 6;
    const int gw = cx.bid * 4 + wid, nw = cx.nb * 4;
    if (slot < 0) {
      phase0(cx, p, ws, smem);
    } else if (slot == 0) {
      const int NT = (kind == 0 ? NPAD_A : NPAD_BC) / 128;
      const int n_in = 256 * NT;
      const int n_tot = n_in + (layer == 0 ? 4 * 16 * 4 : 0);
      const u16* xb = reinterpret_cast<const u16*>(ws + OFF_XB);
      const u16* wt = reinterpret_cast<const u16*>(ws + win_off(layer));
      for (int id = cx.bid; id < n_tot; id += cx.nb) {
        if (id < n_in) {
          int mt, nt; tile_mn(id, NT, mt, nt);
          gemm_tile(cx, xb, wt, 1024, mt * 128, nt * 128, smem, EpiInProj{ws, kind});
        } else {
          const int r = id - n_in, l = r >> 6, mt = (r >> 2) & 15, nt = r & 3;
          gemm_tile(cx, reinterpret_cast<const u16*>(ws + OFF_MEMN), reinterpret_cast<const u16*>(ws + OFF_WMKV + l * SZ_WMKV), 1024, mt * 128, nt * 128, smem, EpiMemKV{ws, l});
        }
      }
    } else if (slot == 1) {
      if (kind == 0) ki_prep_phase(cx, ws, p.idx_g + jl * 64, p.idx_b + jl * 64);
      else kmean_phase(cx, ws);
    } else if (slot == 2) {
      for (int u = gw; u < NB * (S / 2); u += nw) {
        const int b = u & 7, pr = (S / 2 - 1) - (u >> 3);
        dsa_select_unit(ws, b, pr * 2, lane, reinterpret_cast<unsigned*>(smem) + wid * 4096);
      }
    } else if (slot == 3) {
      if (kind == 1) {
        for (int u = gw; u < NB * 4 * 8 * 16; u += nw) dil_att_unit(ws, u, lane);
      } else {
        for (int u = gw; u < NB * 12 * 128; u += nw) {
          const int qsub = u & 3, v = u >> 2, bh = v % 96, qtg = v / 96;
          const int qt = 127 - (qtg * 4 + qsub);
          if (kind == 0) dsa_att_unit(ws, bh, qt, lane); else moba_att_unit(ws, bh, qt, lane);
        }
      }
      for (int u = gw; u < NB * 4 * 128; u += nw) mem_att_unit(ws, layer, kind, u, lane);
    } else if (slot == 4) {
      const u16* a = reinterpret_cast<const u16*>(ws + OFF_MIX);
      const u16* wt = reinterpret_cast<const u16*>(ws + OFF_WOUT + layer * SZ_WOUT);
      const float* xsrc = layer == 0 ? p.x : outp;
      for (int id = cx.bid; id < 256 * 8; id += cx.nb) {
        int mt, nt; tile_mn(id, 8, mt, nt);
        gemm_tile(cx, a, wt, 1024, mt * 128, nt * 128, smem, EpiResid{xsrc, outp});
      }
    } else if (slot == 5) {
      ln_phase(cx, outp, p.ln1g + layer * 1024, p.ln1b + layer * 1024, reinterpret_cast<u16*>(ws + OFF_XB));
    } else if (slot == 6) {
      const u16* xb = reinterpret_cast<const u16*>(ws + OFF_XB);
      const u16* wt = reinterpret_cast<const u16*>(ws + OFF_WGU + layer * SZ_WGU);
      for (int id = cx.bid; id < 256 * 44; id += cx.nb) {
        int mt, nt; tile_mn(id, 44, mt, nt);
        gemm_tile(cx, xb, wt, 1024, mt * 128, nt * 128, smem, EpiSwiGLU{reinterpret_cast<u16*>(ws + OFF_BIG + BO_H)});
      }
    } else if (slot == 7) {
      const u16* a = reinterpret_cast<const u16*>(ws + OFF_BIG + BO_H);
      const u16* wt = reinterpret_cast<const u16*>(ws + OFF_WDN + layer * SZ_WDN);
      for (int id = cx.bid; id < 256 * 8; id += cx.nb) {
        int mt, nt; tile_mn(id, 8, mt, nt);
        gemm_tile(cx, a, wt, DFF, mt * 128, nt * 128, smem, EpiResid{outp, outp});
      }
    } else {
      ln_phase(cx, outp, p.ln2g + layer * 1024, p.ln2b + layer * 1024, reinterpret_cast<u16*>(ws + OFF_XB));
    }
  }
}

extern "C" void kernel_launch(void* const* d_in, const int* in_sizes, int n_in, void* d_out, int out_size,
                              void* d_ws, size_t ws_size, hipStream_t stream) {
  static int grid_blocks = 0;
  if (!grid_blocks) {
    int dev = 0, cus = 0, per_cu = 0;
    hipGetDevice(&dev);
    hipDeviceGetAttribute(&cus, hipDeviceAttributeMultiprocessorCount, dev);
    hipOccupancyMaxActiveBlocksPerMultiprocessor(&per_cu, fwd_kernel, 256, 0);
    if (per_cu < 1) per_cu = 1;
    if (per_cu > 2) per_cu = 2;
    grid_blocks = cus * per_cu;
  }
  if (ws_size < WS_NEED) fprintf(stderr, "workspace too small: %zu < %zu\n", ws_size, (size_t)WS_NEED);
  Params p{};
  p.x = (const float*)d_in[0]; p.mem = (const float*)d_in[1]; p.pos = (const int*)d_in[2];
  p.mem_g = (const float*)d_in[3]; p.mem_b = (const float*)d_in[4];
  p.w_in_a = (const float*)d_in[5]; p.idx_g = (const float*)d_in[6]; p.idx_b = (const float*)d_in[7];
  p.w_in_b = (const float*)d_in[8]; p.w_in_c = (const float*)d_in[9];
  p.w_mkv = (const float*)d_in[10]; p.w_out = (const float*)d_in[11];
  p.ln1g = (const float*)d_in[12]; p.ln1b = (const float*)d_in[13];
  p.w_gu = (const float*)d_in[14]; p.w_dn = (const float*)d_in[15];
  p.ln2g = (const float*)d_in[16]; p.ln2b = (const float*)d_in[17];
  p.out = (float*)d_out; p.ws = (char*)d_ws;
  const int NPH = 1 + DEPTH * 9;
#if SINGLE_LAUNCH
  p.ph_lo = 0; p.ph_hi = NPH;
  void* args[] = {&p};
  hipError_t e = hipLaunchCooperativeKernel((void*)fwd_kernel, dim3(grid_blocks), dim3(256), args, 0, stream);
  if (e != hipSuccess) fprintf(stderr, "cooperative launch failed: %s (grid %d)\n", hipGetErrorString(e), grid_blocks);
#else
  for (int ph = 0; ph < NPH; ++ph) {
    if (ph > 0) {
      const int layer = (ph - 1) / 9, slot = (ph - 1) % 9, kind = layer % 3;
      if ((slot == 1 && kind == 1) || (slot == 2 && kind != 0)) continue;
    }
    p.ph_lo = ph; p.ph_hi = ph + 1;
    hipLaunchKernelGGL(fwd_kernel, dim3(grid_blocks), dim3(256), 0, stream, p);
  }
#endif
}
```

```cpp
#include <hip/hip_runtime.h>
#include <hip/hip_cooperative_groups.h>
#include <cstdio>
#include <cmath>
namespace cg = cooperative_groups;

#ifndef EN
#define EN 0xFFFF
#endif
#ifndef SEL_LOW_BIT
#define SEL_LOW_BIT 8
#endif
#ifndef XSYNC
#define XSYNC 0
#endif
#ifndef XP0
#define XP0 0
#endif
#ifndef REP
#define REP 0
#endif
#ifndef REPL
#define REPL 15
#endif
#ifndef SINGLE_LAUNCH
#define SINGLE_LAUNCH 1
#endif

#define DI __device__ __forceinline__
typedef unsigned short u16;
using bf16x8 = __attribute__((ext_vector_type(8))) __bf16;
using bf2 = __attribute__((ext_vector_type(2))) __bf16;
using f32x4 = __attribute__((ext_vector_type(4))) float;
using f32x16 = __attribute__((ext_vector_type(16))) float;
using u32x4 = __attribute__((ext_vector_type(4))) unsigned;

constexpr int NB = 8, S = 4096, DM = 1024, T = NB * S, DEPTH = 4;
constexpr int NMEM = 256, DFF = 2816;
constexpr int NPAD_A = 3328, NPAD_BC = 2560;
constexpr int NMAIN_A = 2560, NMAIN_BC = 1792;
constexpr int NTHR = 512, WPB = 8;
constexpr int LDS_BYTES = 131072;
constexpr int LDS_TOTAL = LDS_BYTES + 16;
constexpr float ALPHA = 1.681792830507429f;
constexpr float LN_EPS = 1e-5f;

constexpr size_t SZ_WIN_A = (size_t)NPAD_A * 1024 * 2, SZ_WIN_BC = (size_t)NPAD_BC * 1024 * 2;
constexpr size_t OFF_WIN0 = 0;
constexpr size_t OFF_WIN1 = OFF_WIN0 + SZ_WIN_A;
constexpr size_t OFF_WIN2 = OFF_WIN1 + SZ_WIN_BC;
constexpr size_t OFF_WIN3 = OFF_WIN2 + SZ_WIN_BC;
constexpr size_t OFF_WMKV = OFF_WIN3 + SZ_WIN_A;
constexpr size_t SZ_WMKV = (size_t)512 * 1024 * 2;
constexpr size_t OFF_WOUT = OFF_WMKV + 4 * SZ_WMKV;
constexpr size_t SZ_WOUT = (size_t)1024 * 1024 * 2;
constexpr size_t OFF_WGU = OFF_WOUT + 4 * SZ_WOUT;
constexpr size_t SZ_WGU = (size_t)5632 * 1024 * 2;
constexpr size_t OFF_WDN = OFF_WGU + 4 * SZ_WGU;
constexpr size_t SZ_WDN = (size_t)1024 * 2816 * 2;
constexpr size_t OFF_XB = OFF_WDN + 4 * SZ_WDN;
constexpr size_t SZ_XB = (size_t)T * 1024 * 2;
constexpr size_t OFF_MIX = OFF_XB + SZ_XB;
constexpr size_t OFF_MEMN = OFF_MIX + SZ_XB;
constexpr size_t OFF_MK = OFF_MEMN + (size_t)2048 * 1024 * 2;
constexpr size_t SZ_MK = (size_t)8 * 4 * 256 * 64 * 2;
constexpr size_t OFF_MVT = OFF_MK + 4 * SZ_MK;
constexpr size_t OFF_COS = OFF_MVT + 4 * SZ_MK;
constexpr size_t OFF_SIN = OFF_COS + (size_t)T * 8 * 4;
constexpr size_t OFF_KMEAN = OFF_SIN + (size_t)T * 8 * 4;
constexpr size_t OFF_KMEANB = OFF_KMEAN + (size_t)8 * 12 * 16 * 64 * 4;
constexpr size_t OFF_BIG = OFF_KMEANB + (size_t)8 * 12 * 16 * 64 * 2;
constexpr size_t SZ_QKV = (size_t)T * 768 * 2;
constexpr size_t BO_Q = 0, BO_K = SZ_QKV, BO_V = 2 * SZ_QKV;
constexpr size_t BO_QM_AC = 3 * SZ_QKV, BO_QM_B = 5 * SZ_QKV;
constexpr size_t SZ_QM = (size_t)T * 256 * 2;
constexpr size_t BO_QI = BO_QM_AC + SZ_QM;
constexpr size_t BO_KIRAW = BO_QI + (size_t)T * 512 * 2;
constexpr size_t BO_KIB = BO_KIRAW + (size_t)T * 64 * 4;
constexpr size_t BO_WI = BO_KIB + (size_t)T * 64 * 2;
constexpr size_t BO_BM = BO_WI + (size_t)T * 8 * 4;
constexpr size_t BO_SCR = BO_BM + (size_t)T * 128 * 4;
constexpr size_t BO_H = 0;
constexpr size_t OFF_STAT = OFF_BIG + 5 * SZ_QKV + SZ_QM;
constexpr size_t OFF_BAR = OFF_STAT + (size_t)T * 8;
constexpr int XCD_BAR_WORDS = 3456;
constexpr size_t WS_NEED = OFF_BAR + (size_t)XCD_BAR_WORDS * 4;

struct Ctx { int tid, bid, nb; };

struct Params {
  const float* x; const float* mem; const int* pos; const float* mem_g; const float* mem_b;
  const float* w_in_a; const float* idx_g; const float* idx_b; const float* w_in_b; const float* w_in_c;
  const float* w_mkv; const float* w_out; const float* ln1g; const float* ln1b;
  const float* w_gu; const float* w_dn; const float* ln2g; const float* ln2b;
  float* out; char* ws;
  float inv_freq[8];
  int ph_lo, ph_hi;
};

DI unsigned pk2(float a, float b) { bf2 v; v[0] = (__bf16)a; v[1] = (__bf16)b; return __builtin_bit_cast(unsigned, v); }
DI u16 f2bf(float a) { return __builtin_bit_cast(u16, (__bf16)a); }
DI float bf2f(u16 b) { return __uint_as_float(((unsigned)b) << 16); }
typedef const bf16x8 __attribute__((address_space(1)))* gp_bf16x8;
typedef const unsigned __attribute__((address_space(1)))* gp_u32;
DI bf16x8 ld8(const u16* p) { return *((gp_bf16x8)(const void*)p); }
DI unsigned ldg32(const unsigned* p) { return *((gp_u32)(const void*)p); }
typedef unsigned u32x2v __attribute__((ext_vector_type(2)));
DI void stg16(void* p, uint4 v) { *((__attribute__((address_space(1))) u32x4*)p) = u32x4{v.x, v.y, v.z, v.w}; }
DI void stg16f(void* p, f32x4 v) { *((__attribute__((address_space(1))) f32x4*)p) = v; }
DI void stg8(void* p, uint2 v) { *((__attribute__((address_space(1))) u32x2v*)p) = u32x2v{v.x, v.y}; }
DI void stg4(void* p, unsigned v) { *((__attribute__((address_space(1))) unsigned*)p) = v; }
DI void stg2(void* p, u16 v) { *((__attribute__((address_space(1))) u16*)p) = v; }
DI f32x4 ldg4(const float* p) { return *((const __attribute__((address_space(1))) f32x4*)(const void*)p); }
typedef float f32x2v __attribute__((ext_vector_type(2)));
DI float2 ldg2(const float2* p) { const f32x2v v = *((const __attribute__((address_space(1))) f32x2v*)(const void*)p); return make_float2(v[0], v[1]); }
DI f32x4 mfma16(bf16x8 a, bf16x8 b, f32x4 c) { return __builtin_amdgcn_mfma_f32_16x16x32_bf16(a, b, c, 0, 0, 0); }
DI f32x16 mfma32(bf16x8 a, bf16x8 b, f32x16 c) { return __builtin_amdgcn_mfma_f32_32x32x16_bf16(a, b, c, 0, 0, 0); }
template <int M> DI float sx(float v) { return __builtin_bit_cast(float, __builtin_amdgcn_ds_swizzle(__builtin_bit_cast(int, v), (M << 10) | 0x1F)); }
DI float red32_sum(float v) { const int iv = __builtin_bit_cast(int, v); int iw = iv; asm volatile("" : "+v"(iw));
  auto r = __builtin_amdgcn_permlane32_swap(iv, iw, false, false); return __builtin_bit_cast(float, (int)r[0]) + __builtin_bit_cast(float, (int)r[1]); }
DI float red32_max(float v) { const int iv = __builtin_bit_cast(int, v); int iw = iv; asm volatile("" : "+v"(iw));
  auto r = __builtin_amdgcn_permlane32_swap(iv, iw, false, false); return fmaxf(__builtin_bit_cast(float, (int)r[0]), __builtin_bit_cast(float, (int)r[1])); }
DI float wave_sum(float v) { v += sx<1>(v); v += sx<2>(v); v += sx<4>(v); v += sx<8>(v); v += sx<16>(v); return red32_sum(v); }
DI size_t win_off(int layer) { return layer == 0 ? OFF_WIN0 : layer == 1 ? OFF_WIN1 : layer == 2 ? OFF_WIN2 : OFF_WIN3; }

DI int rope_pos(int c) { const int d = c & 63; return d < 16 ? (c & ~15) | (d & 3) | ((d & 4) << 1) | ((d & 8) >> 1) : c; }
DI int map_row(int kind, int c) {
  if (kind == 1) {
    if (c < 1536) return rope_pos(c);
    if (c < 2304) return NMAIN_A + (c - 1536);
    if (c < 2816) return 1792 + rope_pos(c - 2304);
    if (c < 2824) return 2368 + (c - 2816);
    if (c < 2888) return 2304 + (c - 2824);
    return 1536 + (c - 2888);
  }
  if (kind == 3) {
    if (c < 1536) return rope_pos(c);
    if (c < 2304) return NMAIN_BC + (c - 1536);
    return 1536 + (c - 2304);
  }
  if (kind == 2) {
    int isu = c >= DFF; int j = c - isu * DFF;
    return (j >> 7) * 256 + isu * 128 + (j & 127);
  }
  return c;
}

DI void conv_job(const Ctx& cx, const float* __restrict__ src, int Ks, int Ns, u16* __restrict__ dst, int kind, float* tile) {
  const int nnt = (Ns + 63) >> 6, nkt = Ks >> 8, tid = cx.tid;
  for (int t = cx.bid; t < nnt * nkt; t += cx.nb) {
    const int kt = t / nnt, nt = t % nnt;
    const int nn = tid & 63, n = nt * 64 + nn;
    float v[32];
#pragma unroll
    for (int i = 0; i < 32; ++i) { const int kk = i * 8 + (tid >> 6); v[i] = n < Ns ? src[(size_t)(kt * 256 + kk) * Ns + n] : 0.f; }
    __syncthreads();
#pragma unroll
    for (int i = 0; i < 32; ++i) tile[(i * 8 + (tid >> 6)) * 65 + nn] = v[i];
    __syncthreads();
#pragma unroll 4
    for (int i = 0; i < 16; ++i) {
      const int n2 = (tid >> 7) + 4 * i, k2 = tid & 127, nr = nt * 64 + n2;
      if (nr < Ns) {
        const int dr = map_row(kind, nr);
        *reinterpret_cast<unsigned*>(dst + (size_t)dr * Ks + kt * 256 + 2 * k2) = pk2(tile[(2 * k2) * 65 + n2], tile[(2 * k2 + 1) * 65 + n2]);
      }
    }
  }
}

DI void phase0(const Ctx& cx, const Params& p, char* ws, char* smem) {
  float* tile = reinterpret_cast<float*>(smem);
  for (int l = 0; l < DEPTH; ++l) {
    const int kind = l % 3, j = l / 3;
    const float* win = kind == 0 ? p.w_in_a + (size_t)j * 1024 * 3144 : kind == 1 ? p.w_in_b : p.w_in_c;
    conv_job(cx, win, 1024, kind == 0 ? 3144 : 2560, (u16*)(ws + win_off(l)), kind == 0 ? 1 : 3, tile);
    conv_job(cx, p.w_mkv + (size_t)l * 1024 * 512, 1024, 512, (u16*)(ws + OFF_WMKV + l * SZ_WMKV), 0, tile);
    conv_job(cx, p.w_out + (size_t)l * 1024 * 1024, 1024, 1024, (u16*)(ws + OFF_WOUT + l * SZ_WOUT), 0, tile);
    conv_job(cx, p.w_gu + (size_t)l * 1024 * 5632, 1024, 5632, (u16*)(ws + OFF_WGU + l * SZ_WGU), 2, tile);
    conv_job(cx, p.w_dn + (size_t)l * 2816 * 1024, 2816, 1024, (u16*)(ws + OFF_WDN + l * SZ_WDN), 0, tile);
  }
  const int gtid = cx.bid * NTHR + cx.tid, gn = cx.nb * NTHR;
  for (int l = 0; l < DEPTH; l += 3) {
    unsigned* d = reinterpret_cast<unsigned*>(ws + win_off(l) + (size_t)2376 * 1024 * 2);
    for (int i = gtid; i < (NMAIN_A - 2376) * 512; i += gn) d[i] = 0u;
  }
  {
    const float4* xs = reinterpret_cast<const float4*>(p.x);
    uint2* xd = reinterpret_cast<uint2*>(ws + OFF_XB);
    for (int i = gtid; i < T * 256; i += 4 * gn) {
      float4 v[4];
#pragma unroll
      for (int j = 0; j < 4; ++j) v[j] = xs[i + j * gn];
#pragma unroll
      for (int j = 0; j < 4; ++j) xd[i + j * gn] = make_uint2(pk2(v[j].x, v[j].y), pk2(v[j].z, v[j].w));
    }
  }
  {
    float* cs = reinterpret_cast<float*>(ws + OFF_COS); float* sn = reinterpret_cast<float*>(ws + OFF_SIN);
    for (int i = gtid; i < T * 8; i += gn) {
      int t = i >> 3, f = i & 7;
      float ang = (float)p.pos[t] * p.inv_freq[f];
      cs[i] = cosf(ang); sn[i] = sinf(ang);
    }
  }
  {
    const int lane = cx.tid & 63, gw = cx.bid * WPB + __builtin_amdgcn_readfirstlane(cx.tid >> 6), nw = cx.nb * WPB;
    u16* mn = reinterpret_cast<u16*>(ws + OFF_MEMN);
    for (int r = gw; r < NB * NMEM; r += nw) {
      const float4* src = reinterpret_cast<const float4*>(p.mem + (size_t)r * 1024);
      float4 v[4]; float s = 0.f;
      for (int i = 0; i < 4; ++i) { v[i] = src[i * 64 + lane]; s += v[i].x + v[i].y + v[i].z + v[i].w; }
      float mu = wave_sum(s) * (1.f / 1024.f);
      float q = 0.f;
      for (int i = 0; i < 4; ++i) { float a = v[i].x - mu, b = v[i].y - mu, c = v[i].z - mu, d = v[i].w - mu; q += a * a + b * b + c * c + d * d; }
      float rs = rsqrtf(wave_sum(q) * (1.f / 1024.f) + LN_EPS);
      for (int i = 0; i < 4; ++i) {
        int c = (i * 64 + lane) * 4;
        float4 g = *reinterpret_cast<const float4*>(p.mem_g + c), bb = *reinterpret_cast<const float4*>(p.mem_b + c);
        uint2 o = make_uint2(pk2((v[i].x - mu) * rs * g.x + bb.x, (v[i].y - mu) * rs * g.y + bb.y),
                             pk2((v[i].z - mu) * rs * g.z + bb.z, (v[i].w - mu) * rs * g.w + bb.w));
        *reinterpret_cast<uint2*>(mn + (size_t)r * 1024 + c) = o;
      }
    }
  }
}

namespace pg8 {
#define PG8_LAS __attribute__((address_space(3)))
typedef short s16x8 __attribute__((ext_vector_type(8)));
constexpr int BM = 256, BK = 64, HALF = 128, HTB = HALF * BK * 2, STAGE_BYTES = 8 * HTB, NXCD = 8, WGM = 8;
DI int lds_byte(int r, int c) { const int st = (r >> 4) * 2 + (c >> 5), rr = r & 15, cc = c & 31, ob = rr * 64 + cc * 2; return st * 1024 + (ob ^ (((ob >> 9) & 1) << 5)); }
DI void stage_rc(int b, int& R, int& C) { const int st = b / 1024, sb = b % 1024, swz = sb ^ (((sb >> 9) & 1) << 5); R = (st >> 1) * 16 + swz / 64; C = (st & 1) * 32 + (swz % 64) / 2; }
DI int perm32(int rho) { const int n = rho >> 4, i = rho & 15; return 8 * (i >> 2) + 4 * n + (i & 3); }
struct Unit { int pm, pn; };
struct Gemm { const u16* A; const u16* Bt; int M, N, K; };
struct StaticOrder {
  int nM, nN, nwg, G, c;
  DI void init(int M, int N, int G_, int c_) { nM = M / BM; nN = N / BM; nwg = nM * nN; G = G_; c = c_; }
  DI bool next(int i, Unit& u) const {
    const long L = (long)i * G + c; if (L >= nwg) return false;
    int wgid = (int)L; { const int q = nwg / NXCD, r = nwg % NXCD, xcd = wgid % NXCD, off = wgid / NXCD; wgid = (xcd < r ? xcd * (q + 1) : r * (q + 1) + (xcd - r) * q) + off; }
    const int nig = WGM * nN, gid = wgid / nig, fm = gid * WGM, gsz = (nM - fm) < WGM ? (nM - fm) : WGM;
    u.pm = fm + ((wgid % nig) % gsz); u.pn = (wgid % nig) / gsz; return true;
  }
};

template <class Epi>
DI void gemm_phase(int tid, PG8_LAS unsigned char* lds, const Gemm g, const StaticOrder& S, const Epi& E) {
  const int wid = __builtin_amdgcn_readfirstlane(tid >> 6), lane = tid & 63, wr = wid >> 2, wc = wid & 3, fr = lane & 15, fq = lane >> 4;
  const int K = g.K, nt = K / BK;
  unsigned voffA[2], voffB[2];
#pragma unroll
  for (int i = 0; i < 2; ++i) { int R, C; stage_rc(tid * 16 + i * 8192, R, C); const int Rb = Epi::PERM ? ((R & ~31) + perm32(R & 31)) : R;
    voffA[i] = (unsigned)(R * K + C) * 2u; voffB[i] = (unsigned)(Rb * K + C) * 2u; }
  const size_t kstep = (size_t)(BK * 2);
  const size_t hstep = (size_t)HALF * K * 2;
  const size_t tstep = 2 * hstep;
  const unsigned ldsw = (unsigned)wid * 1024u;
  const int aoff = lds_byte(wr * 64 + fr, fq * 8), boff = lds_byte(wc * 32 + fr, fq * 8);
#define PG8_SA(b, h) (((b) * 2 + (h)) * HTB)
#define PG8_SB(b, h) ((4 + (b) * 2 + (h)) * HTB)
#define PG8_STAGE(bufoff, gbase, voff) do { _Pragma("unroll") for (int _i = 0; _i < 2; ++_i) \
    __builtin_amdgcn_global_load_lds((const unsigned*)((const char*)(gbase) + (voff)[_i]), (PG8_LAS unsigned*)(lds + (bufoff) + ldsw + _i * 8192), 16, 0, 0); } while (0)
#define PG8_LDA(dst, b, h) do { _Pragma("unroll") for (int m = 0; m < 4; ++m) _Pragma("unroll") for (int k = 0; k < 2; ++k) dst[m][k] = *(const PG8_LAS s16x8*)(lds + PG8_SA(b, h) + aoff + m * 2048 + k * 1024); } while (0)
#define PG8_LDB(dst, b, h) do { _Pragma("unroll") for (int n = 0; n < 2; ++n) _Pragma("unroll") for (int k = 0; k < 2; ++k) dst[n][k] = *(const PG8_LAS s16x8*)(lds + PG8_SB(b, h) + boff + n * 2048 + k * 1024); } while (0)
#define PG8_MMA(ai, bj, At, Bt) do { __builtin_amdgcn_s_setprio(1); _Pragma("unroll") for (int m = 0; m < 4; ++m) _Pragma("unroll") for (int n = 0; n < 2; ++n) _Pragma("unroll") for (int k = 0; k < 2; ++k) \
    acc[ai][bj][m][n] = __builtin_amdgcn_mfma_f32_16x16x32_bf16(__builtin_bit_cast(bf16x8, Bt[n][k]), __builtin_bit_cast(bf16x8, At[m][k]), acc[ai][bj][m][n], 0, 0, 0); __builtin_amdgcn_s_setprio(0); } while (0)
#define PG8_WAIT_V(n) asm volatile("s_waitcnt vmcnt(" #n ")" ::: "memory")
#define PG8_WAIT_L(n) asm volatile("s_waitcnt lgkmcnt(" #n ")" ::: "memory")
#define PG8_BAR __builtin_amdgcn_s_barrier()
#define PG8_SCHED __builtin_amdgcn_sched_barrier(0)
  Unit cur, nxt; int ui = 0;
  if (!S.next(0, cur)) return;
  f32x4 acc[2][2][4][2];
#pragma unroll
  for (int a = 0; a < 2; ++a)
#pragma unroll
    for (int b = 0; b < 2; ++b)
#pragma unroll
      for (int m = 0; m < 4; ++m)
#pragma unroll
        for (int n = 0; n < 2; ++n) acc[a][b][m][n] = (f32x4){0.f, 0.f, 0.f, 0.f};
  s16x8 At[4][2], B0[2][2], B1[2][2];
  const char* cA = (const char*)g.A + (size_t)cur.pm * tstep; const char* cB = (const char*)g.Bt + (size_t)cur.pn * tstep;
  PG8_STAGE(PG8_SB(0, 0), cB, voffB); PG8_STAGE(PG8_SA(0, 0), cA, voffA); PG8_STAGE(PG8_SB(0, 1), cB + hstep, voffB); PG8_STAGE(PG8_SA(0, 1), cA + hstep, voffA);
  if (wr == 1) PG8_BAR;
  PG8_WAIT_V(4); PG8_BAR;
  PG8_STAGE(PG8_SB(1, 0), cB + kstep, voffB); PG8_STAGE(PG8_SA(1, 0), cA + kstep, voffA); PG8_STAGE(PG8_SB(1, 1), cB + hstep + kstep, voffB);
  PG8_WAIT_V(6); PG8_BAR;
  for (;;) {
    const bool has_next = S.next(ui + 1, nxt);
    const char* nA = has_next ? (const char*)g.A + (size_t)nxt.pm * tstep : cA; const char* nB = has_next ? (const char*)g.Bt + (size_t)nxt.pn * tstep : cB;
    for (int t = 0; t < nt; t += 2) {
      const bool last = (t == nt - 2);
      const char* a1 = cA + (size_t)(t + 1) * kstep;
      const char* a2 = last ? nA : cA + (size_t)(t + 2) * kstep; const char* b2 = last ? nB : cB + (size_t)(t + 2) * kstep;
      const char* a3 = a2 + kstep; const char* b3 = b2 + kstep;
      PG8_LDB(B0, 0, 0); PG8_SCHED; PG8_LDA(At, 0, 0); PG8_STAGE(PG8_SA(1, 1), a1 + hstep, voffA);
      PG8_WAIT_L(8); PG8_BAR; PG8_WAIT_L(0); PG8_MMA(0, 0, At, B0); PG8_BAR; PG8_SCHED;
      PG8_LDB(B1, 0, 1); PG8_STAGE(PG8_SB(0, 0), b2, voffB);
      PG8_BAR; PG8_WAIT_L(0); PG8_MMA(0, 1, At, B1); PG8_BAR;
      PG8_LDA(At, 0, 1); PG8_STAGE(PG8_SA(0, 0), a2, voffA);
      PG8_BAR; PG8_WAIT_L(0); PG8_MMA(1, 0, At, B0); PG8_BAR; PG8_SCHED;
      PG8_STAGE(PG8_SB(0, 1), b2 + hstep, voffB);
      PG8_WAIT_V(6); PG8_BAR; PG8_MMA(1, 1, At, B1); PG8_BAR;
      PG8_LDB(B0, 1, 0); PG8_SCHED; PG8_LDA(At, 1, 0); PG8_STAGE(PG8_SA(0, 1), a2 + hstep, voffA);
      PG8_WAIT_L(8); PG8_BAR; PG8_WAIT_L(0); PG8_MMA(0, 0, At, B0); PG8_BAR; PG8_SCHED;
      PG8_LDB(B1, 1, 1); PG8_STAGE(PG8_SB(1, 0), b3, voffB);
      PG8_BAR; PG8_WAIT_L(0); PG8_MMA(0, 1, At, B1); PG8_BAR;
      PG8_LDA(At, 1, 1); PG8_STAGE(PG8_SA(1, 0), a3, voffA);
      PG8_BAR; PG8_WAIT_L(0); PG8_MMA(1, 0, At, B0); PG8_BAR; PG8_SCHED;
      PG8_STAGE(PG8_SB(1, 1), b3 + hstep, voffB);
      PG8_WAIT_V(6); PG8_BAR; PG8_MMA(1, 1, At, B1); PG8_BAR;
    }
    E(acc, cur, wr, wc, fr, fq);
    if (!has_next) break;
#pragma unroll
    for (int a = 0; a < 2; ++a)
#pragma unroll
      for (int b = 0; b < 2; ++b)
#pragma unroll
        for (int m = 0; m < 4; ++m)
#pragma unroll
          for (int n = 0; n < 2; ++n) acc[a][b][m][n] = (f32x4){0.f, 0.f, 0.f, 0.f};
    cur = nxt; cA = nA; cB = nB; ++ui;
  }
  PG8_WAIT_V(0);
  if (wr == 0) PG8_BAR;
  PG8_BAR;
#undef PG8_SA
#undef PG8_SB
#undef PG8_STAGE
#undef PG8_LDA
#undef PG8_LDB
#undef PG8_MMA
#undef PG8_WAIT_V
#undef PG8_WAIT_L
#undef PG8_BAR
#undef PG8_SCHED
}
}

DI uint4 pack8(const f32x4& a, const f32x4& b) { return make_uint4(pk2(a[0], a[1]), pk2(a[2], a[3]), pk2(b[0], b[1]), pk2(b[2], b[3])); }

struct EpiInProj {
  static constexpr bool PERM = true;
  char* ws; int kind;
  DI void operator()(const f32x4 (&acc)[2][2][4][2], const pg8::Unit& u, int wr, int wc, int fr, int fq) const {
    char* big = ws + OFF_BIG;
    const float* cs = reinterpret_cast<const float*>(ws + OFF_COS);
    const float* sn = reinterpret_cast<const float*>(ws + OFF_SIN);
#pragma unroll
    for (int bj = 0; bj < 2; ++bj) {
      const int c32 = u.pn * 256 + bj * 128 + wc * 32;
      const int dd = (c32 & 63) + 8 * fq;
      if (c32 < 2304) {
        int sel, h;
        if (c32 < 768) { sel = 0; h = c32 >> 6; }
        else if (c32 < 1536) { sel = 1; h = (c32 - 768) >> 6; }
        else if (c32 < 1792) { sel = 2; h = (c32 - 1536) >> 6; }
        else { sel = 3; h = (c32 - 1792) >> 6; }
        const bool rope = sel != 2 && (c32 & 63) == 0 && fq < 2;
        f32x4 rc[2][4], rsn[2][4];
        if (rope) {
#pragma unroll
          for (int ai = 0; ai < 2; ++ai)
#pragma unroll
            for (int m = 0; m < 4; ++m) {
              const int row = u.pm * 256 + ai * 128 + wr * 64 + m * 16 + fr;
              rc[ai][m] = ldg4(cs + row * 8 + 4 * fq); rsn[ai][m] = ldg4(sn + row * 8 + 4 * fq);
            }
        }
#pragma unroll
        for (int ai = 0; ai < 2; ++ai)
#pragma unroll
          for (int m = 0; m < 4; ++m) {
            const int row = u.pm * 256 + ai * 128 + wr * 64 + m * 16 + fr;
            f32x4 a = acc[ai][bj][m][0], b = acc[ai][bj][m][1];
            if (rope) {
              const f32x4 na = a * rc[ai][m] - b * rsn[ai][m], nb = b * rc[ai][m] + a * rsn[ai][m];
              a = na; b = nb;
            }
            const int bb = row >> 12, s_ = row & 4095;
            size_t off;
            if (sel == 0) off = BO_Q + (((size_t)(bb * 12 + h) * S + s_) * 64 + dd) * 2;
            else if (sel == 1) off = BO_K + (((size_t)(bb * 12 + h) * S + s_) * 64 + dd) * 2;
            else if (sel == 2) off = (kind == 1 ? BO_QM_B : BO_QM_AC) + (((size_t)(bb * 4 + h) * S + s_) * 64 + dd) * 2;
            else off = BO_QI + (((size_t)row * 8 + h) * 64 + dd) * 2;
            stg16(big + off, pack8(a, b));
          }
      } else if (c32 < 2368) {
#pragma unroll
        for (int ai = 0; ai < 2; ++ai)
#pragma unroll
          for (int m = 0; m < 4; ++m) {
            const int row = u.pm * 256 + ai * 128 + wr * 64 + m * 16 + fr;
            float* dst = reinterpret_cast<float*>(big + BO_KIRAW) + (size_t)row * 64 + (c32 - 2304) + 8 * fq;
            stg16f(dst, acc[ai][bj][m][0]);
            stg16f(dst + 4, acc[ai][bj][m][1]);
          }
      } else if (c32 < 2400) {
        if (fq == 0) {
#pragma unroll
          for (int ai = 0; ai < 2; ++ai)
#pragma unroll
            for (int m = 0; m < 4; ++m) {
              const int row = u.pm * 256 + ai * 128 + wr * 64 + m * 16 + fr;
              float* dst = reinterpret_cast<float*>(big + BO_WI) + (size_t)row * 8;
              stg16f(dst, acc[ai][bj][m][0] * 0.04419417382415922f);
              stg16f(dst + 4, acc[ai][bj][m][1] * 0.04419417382415922f);
            }
        }
      }
    }
  }
};

struct EpiVt {
  static constexpr bool PERM = true;
  char* ws; int kind;
  DI void operator()(const f32x4 (&acc)[2][2][4][2], const pg8::Unit& u, int wr, int wc, int fr, int fq) const {
    char* big = ws + OFF_BIG;
#pragma unroll
    for (int ai = 0; ai < 2; ++ai)
#pragma unroll
      for (int m = 0; m < 4; ++m) {
        const int cv = u.pm * 256 + ai * 128 + wr * 64 + m * 16 + fr;
#pragma unroll
        for (int bj = 0; bj < 2; ++bj) {
          const int tok0 = u.pn * 256 + bj * 128 + wc * 32 + 8 * fq;
          const int bb = tok0 >> 12, s0 = tok0 & 4095;
          const f32x4 a = acc[ai][bj][m][0], b = acc[ai][bj][m][1];
          if (kind != 1) {
            const int h = cv >> 6, d = cv & 63;
            u16* vt = reinterpret_cast<u16*>(big + BO_V) + ((size_t)(bb * 12 + h) * 128 + (s0 >> 5)) * 2048 + d * 32 + (s0 & 31);
            stg16(vt, pack8(a, b));
          } else {
            const int hh = cv / 192, dv = cv % 192;
            u16* v0 = reinterpret_cast<u16*>(big + BO_V) + ((size_t)(bb * 4 + hh) * 128 + (s0 >> 5)) * 6144 + dv * 32 + (s0 & 31);
            stg16(v0, pack8(a, b));
            const int j4 = s0 >> 2, j16 = s0 >> 4, r0 = s0 & 15;
            u16* v1 = reinterpret_cast<u16*>(big + BO_V + SZ_QKV) + (((size_t)(bb * 4 + hh) * 4) * 32 + (j4 >> 5)) * 6144 + dv * 32 + (j4 & 31);
            u16* v2 = reinterpret_cast<u16*>(big + BO_V + 2 * SZ_QKV) + (((size_t)(bb * 4 + hh) * 16 + r0) * 8 + (j16 >> 5)) * 6144 + dv * 32 + (j16 & 31);
#pragma unroll
            for (int r = 0; r < 4; ++r) stg4(v1 + (size_t)r * 32 * 6144, pk2(a[r], b[r]));
#pragma unroll
            for (int i = 0; i < 4; ++i) { stg2(v2 + (size_t)i * 8 * 6144, f2bf(a[i])); stg2(v2 + (size_t)(i + 4) * 8 * 6144, f2bf(b[i])); }
          }
        }
      }
  }
};

struct EpiMemKV {
  static constexpr bool PERM = true;
  char* ws;
  DI void operator()(const f32x4 (&acc)[2][2][4][2], const pg8::Unit& u, int wr, int wc, int fr, int fq) const {
#pragma unroll
    for (int bj = 0; bj < 2; ++bj) {
      const int c32 = u.pn * 256 + bj * 128 + wc * 32;
      const int layer = c32 >> 9, c = c32 & 511;
      const int h = (c & 255) >> 6, dd = (c & 63) + 8 * fq;
      u16* mk = reinterpret_cast<u16*>(ws + OFF_MK + layer * SZ_MK);
      u16* mvt = reinterpret_cast<u16*>(ws + OFF_MVT + layer * SZ_MK);
#pragma unroll
      for (int ai = 0; ai < 2; ++ai)
#pragma unroll
        for (int m = 0; m < 4; ++m) {
          const int row = u.pm * 256 + ai * 128 + wr * 64 + m * 16 + fr;
          const int bb = row >> 8, n = row & 255;
          const f32x4 a = acc[ai][bj][m][0], b = acc[ai][bj][m][1];
          if (c < 256) {
            stg16(mk + ((size_t)(bb * 4 + h) * 256 + n) * 64 + dd, pack8(a, b));
          } else {
            u16* vt = mvt + ((size_t)(bb * 4 + h) * 8 + (n >> 5)) * 2048 + dd * 32 + (n & 31);
#pragma unroll
            for (int i = 0; i < 4; ++i) { stg2(vt + i * 32, f2bf(a[i])); stg2(vt + (i + 4) * 32, f2bf(b[i])); }
          }
        }
    }
  }
};

struct EpiResid {
  static constexpr bool PERM = false;
  const float* xsrc; float* out; const float2* stat; const float* g; const float* b;
  DI void operator()(const f32x4 (&acc)[2][2][4][2], const pg8::Unit& u, int wr, int wc, int fr, int fq) const {
    const int col0 = u.pn * 256 + wc * 32 + 4 * fq;
    f32x4 gg[2][2], bb[2][2];
    if (stat) {
#pragma unroll
      for (int bj = 0; bj < 2; ++bj)
#pragma unroll
        for (int n = 0; n < 2; ++n) { gg[bj][n] = ldg4(g + col0 + bj * 128 + n * 16); bb[bj][n] = ldg4(b + col0 + bj * 128 + n * 16); }
    }
#pragma unroll
    for (int h4 = 0; h4 < 4; ++h4) {
      const int ai = h4 >> 1, m0 = (h4 & 1) * 2;
      f32x4 xv[2][2][2]; float2 st[2];
#pragma unroll
      for (int mm = 0; mm < 2; ++mm) {
        const int row = u.pm * 256 + ai * 128 + wr * 64 + (m0 + mm) * 16 + fr;
        st[mm] = stat ? ldg2(stat + row) : make_float2(0.f, 1.f);
#pragma unroll
        for (int bj = 0; bj < 2; ++bj)
#pragma unroll
          for (int n = 0; n < 2; ++n) xv[mm][bj][n] = ldg4(xsrc + (size_t)row * 1024 + col0 + bj * 128 + n * 16);
      }
#pragma unroll
      for (int mm = 0; mm < 2; ++mm) {
        const int row = u.pm * 256 + ai * 128 + wr * 64 + (m0 + mm) * 16 + fr;
#pragma unroll
        for (int bj = 0; bj < 2; ++bj)
#pragma unroll
          for (int n = 0; n < 2; ++n) {
            f32x4 x = xv[mm][bj][n];
            if (stat) x = (x - st[mm].x) * st[mm].y * gg[bj][n] + bb[bj][n];
            stg16f(out + (size_t)row * 1024 + col0 + bj * 128 + n * 16, x * ALPHA + acc[ai][bj][m0 + mm][n]);
          }
      }
    }
  }
};

struct EpiSwiGLU {
  static constexpr bool PERM = true;
  u16* h;
  DI void operator()(const f32x4 (&acc)[2][2][4][2], const pg8::Unit& u, int wr, int wc, int fr, int fq) const {
    const int j0 = u.pn * 128 + wc * 32 + 8 * fq;
#pragma unroll
    for (int ai = 0; ai < 2; ++ai)
#pragma unroll
      for (int m = 0; m < 4; ++m) {
        const int row = u.pm * 256 + ai * 128 + wr * 64 + m * 16 + fr;
        f32x4 o[2];
#pragma unroll
        for (int n = 0; n < 2; ++n)
#pragma unroll
          for (int i = 0; i < 4; ++i) { const float g = acc[ai][0][m][n][i], uu = acc[ai][1][m][n][i]; o[n][i] = g / (1.f + __expf(-g)) * uu; }
        stg16(h + (size_t)row * DFF + j0, pack8(o[0], o[1]));
      }
  }
};

DI void ln_phase(const Ctx& cx, float* xio, const float* __restrict__ g, const float* __restrict__ b, u16* xb, float2* stat, bool write_f32) {
  const int lane = cx.tid & 63, gw = cx.bid * WPB + __builtin_amdgcn_readfirstlane(cx.tid >> 6), nw = cx.nb * WPB;
  float4 gg[4], bb[4];
  for (int i = 0; i < 4; ++i) { gg[i] = *reinterpret_cast<const float4*>(g + (i * 64 + lane) * 4); bb[i] = *reinterpret_cast<const float4*>(b + (i * 64 + lane) * 4); }
  constexpr int RB = 4;
  for (int r0 = gw * RB; r0 < T; r0 += nw * RB) {
    float4 v[RB][4]; float s[RB], q[RB];
#pragma unroll
    for (int k = 0; k < RB; ++k) {
      const float4* row = reinterpret_cast<const float4*>(xio + (size_t)(r0 + k) * 1024);
      s[k] = 0.f;
#pragma unroll
      for (int i = 0; i < 4; ++i) { v[k][i] = row[i * 64 + lane]; s[k] += v[k][i].x + v[k][i].y + v[k][i].z + v[k][i].w; }
    }
#pragma unroll
    for (int k = 0; k < RB; ++k) s[k] = wave_sum(s[k]) * (1.f / 1024.f);
#pragma unroll
    for (int k = 0; k < RB; ++k) {
      q[k] = 0.f;
#pragma unroll
      for (int i = 0; i < 4; ++i) { float a = v[k][i].x - s[k], b2 = v[k][i].y - s[k], c = v[k][i].z - s[k], d = v[k][i].w - s[k]; q[k] += a * a + b2 * b2 + c * c + d * d; }
    }
#pragma unroll
    for (int k = 0; k < RB; ++k) q[k] = rsqrtf(wave_sum(q[k]) * (1.f / 1024.f) + LN_EPS);
    if (lane < RB) { float2 sv; sv.x = lane == 0 ? s[0] : lane == 1 ? s[1] : lane == 2 ? s[2] : s[3]; sv.y = lane == 0 ? q[0] : lane == 1 ? q[1] : lane == 2 ? q[2] : q[3]; stat[r0 + lane] = sv; }
#pragma unroll
    for (int k = 0; k < RB; ++k) {
      float4* row = reinterpret_cast<float4*>(xio + (size_t)(r0 + k) * 1024);
#pragma unroll
      for (int i = 0; i < 4; ++i) {
        float4 o;
        o.x = (v[k][i].x - s[k]) * q[k] * gg[i].x + bb[i].x; o.y = (v[k][i].y - s[k]) * q[k] * gg[i].y + bb[i].y;
        o.z = (v[k][i].z - s[k]) * q[k] * gg[i].z + bb[i].z; o.w = (v[k][i].w - s[k]) * q[k] * gg[i].w + bb[i].w;
        if (write_f32) row[i * 64 + lane] = o;
        *reinterpret_cast<uint2*>(xb + (size_t)(r0 + k) * 1024 + (i * 64 + lane) * 4) = make_uint2(pk2(o.x, o.y), pk2(o.z, o.w));
      }
    }
  }
}

template <int NDT> struct AttState { f32x16 o[NDT]; float m, l; };
template <int NDT> DI void att_init(AttState<NDT>& st) {
#pragma unroll
  for (int d = 0; d < NDT; ++d)
#pragma unroll
    for (int r = 0; r < 16; ++r) st.o[d][r] = 0.f;
  st.m = -1e30f; st.l = 0.f;
}
DI int pi_swap(int i) { return (i & 0x13) | ((i & 4) << 1) | ((i & 8) >> 1); }

template <int NDT> struct Frags { bf16x8 k[4]; bf16x8 v[NDT == 2 ? 4 : 1]; unsigned w; };
template <int NDT> DI void att_load(Frags<NDT>& f, const u16* krow, const u16* vt) {
#pragma unroll
  for (int c = 0; c < 4; ++c) f.k[c] = ld8(krow + c * 16);
  if (NDT == 2) {
#pragma unroll
    for (int d = 0; d < 2; ++d)
#pragma unroll
      for (int c = 0; c < 2; ++c) f.v[d * 2 + c] = ld8(vt + d * 1024 + c * 16);
  }
}
template <int NDT, class MaskP>
DI void att_compute(AttState<NDT>& st, const bf16x8 (&qf)[4], const Frags<NDT>& f, const u16* vt, const MaskP& maskp) {
  constexpr float CS = 0.18033688011112042f;
  f32x16 s;
#pragma unroll
  for (int r = 0; r < 16; ++r) s[r] = 0.f;
  __builtin_amdgcn_s_setprio(1);
#pragma unroll
  for (int c = 0; c < 4; ++c) s = mfma32(f.k[c], qf[c], s);
  __builtin_amdgcn_s_setprio(0);
  float mx = fmaxf(fmaxf(s[0], s[1]), s[2]);
#pragma unroll
  for (int r = 3; r < 15; r += 2) mx = fmaxf(fmaxf(mx, s[r]), s[r + 1]);
  mx = fmaxf(mx, s[15]);
  mx = red32_max(mx);
  constexpr float DEFER = 8.0f / CS;
  const bool upd = mx > st.m + DEFER;
  if (__any(upd)) {
    const float mnew = upd ? mx : st.m;
    const float alpha = __builtin_amdgcn_exp2f((st.m - mnew) * CS);
    st.l *= alpha; st.m = mnew;
#pragma unroll
    for (int d = 0; d < NDT; ++d)
#pragma unroll
      for (int r = 0; r < 16; ++r) st.o[d][r] *= alpha;
  }
  const float nb = -st.m * CS;
  float ps = 0.f;
#pragma unroll
  for (int r = 0; r < 16; ++r) { s[r] = maskp(r, __builtin_amdgcn_exp2f(fmaf(s[r], CS, nb))); ps += s[r]; }
  st.l += ps;
  bf16x8 pf[2];
#pragma unroll
  for (int c = 0; c < 2; ++c) {
    u32x4 t;
#pragma unroll
    for (int j = 0; j < 4; ++j) t[j] = pk2(s[8 * c + 2 * j], s[8 * c + 2 * j + 1]);
    pf[c] = __builtin_bit_cast(bf16x8, t);
  }
  if (NDT == 2) {
    __builtin_amdgcn_s_setprio(1);
#pragma unroll
    for (int d = 0; d < 2; ++d)
#pragma unroll
      for (int c = 0; c < 2; ++c) st.o[d] = mfma32(f.v[d * 2 + c], pf[c], st.o[d]);
    __builtin_amdgcn_s_setprio(0);
  } else {
    __builtin_amdgcn_sched_barrier(0);
#pragma unroll
    for (int d = 0; d < NDT; ++d) {
      if (d > 0 && (d & 1) == 0) __builtin_amdgcn_sched_barrier(0);
#pragma unroll
      for (int c = 0; c < 2; ++c) st.o[d] = mfma32(ld8(vt + d * 1024 + c * 16), pf[c], st.o[d]);
    }
  }
}
DI float mask_bit(unsigned w, int bit, float p) { int m; asm("v_bfe_i32 %0, %1, %2, 1" : "=v"(m) : "v"(w), "n"(bit)); return __uint_as_float(__float_as_uint(p) & (unsigned)m); }
template <int NDT, class KP, class VP, class WP, class MK>
DI void att_range(AttState<NDT>& st, const bf16x8 (&qf)[4], int k0, int k1, const KP& kp, const VP& vp, const WP& wp, const MK& mk) {
  if (NDT == 2) {
    Frags<NDT> f0, f1, f2;
    att_load<NDT>(f0, kp(k0), vp(k0)); f0.w = wp(k0);
    f1 = f0; f2 = f0;
    if (k0 + 1 <= k1) { att_load<NDT>(f1, kp(k0 + 1), vp(k0 + 1)); f1.w = wp(k0 + 1); }
#pragma unroll 1
    for (int kt = k0; kt <= k1; kt += 3) {
      if (kt + 2 <= k1) { att_load<NDT>(f2, kp(kt + 2), vp(kt + 2)); f2.w = wp(kt + 2); }
      att_compute<NDT>(st, qf, f0, vp(kt), mk(kt, f0.w));
      if (kt + 1 > k1) break;
      if (kt + 3 <= k1) { att_load<NDT>(f0, kp(kt + 3), vp(kt + 3)); f0.w = wp(kt + 3); }
      att_compute<NDT>(st, qf, f1, vp(kt + 1), mk(kt + 1, f1.w));
      if (kt + 2 > k1) break;
      if (kt + 4 <= k1) { att_load<NDT>(f1, kp(kt + 4), vp(kt + 4)); f1.w = wp(kt + 4); }
      att_compute<NDT>(st, qf, f2, vp(kt + 2), mk(kt + 2, f2.w));
    }
  } else {
    Frags<NDT> cur;
    att_load<NDT>(cur, kp(k0), vp(k0)); cur.w = wp(k0);
#pragma unroll 1
    for (int kt = k0; kt <= k1; ++kt) {
      Frags<NDT> nxt = cur;
      if (kt < k1) { att_load<NDT>(nxt, kp(kt + 1), vp(kt + 1)); nxt.w = wp(kt + 1); }
      att_compute<NDT>(st, qf, cur, vp(kt), mk(kt, cur.w));
      cur = nxt;
    }
  }
}

template <int NDT> DI void att_store(AttState<NDT>& st, u16* orow, int hf) {
  const float lt = red32_sum(st.l);
  const float inv = 1.f / lt;
#pragma unroll
  for (int d = 0; d < NDT; ++d)
#pragma unroll
    for (int g = 0; g < 4; ++g) {
      uint2 v = make_uint2(pk2(st.o[d][4 * g] * inv, st.o[d][4 * g + 1] * inv), pk2(st.o[d][4 * g + 2] * inv, st.o[d][4 * g + 3] * inv));
      *reinterpret_cast<uint2*>(orow + d * 32 + 8 * g + 4 * hf) = v;
    }
}

DI void load_q(bf16x8 (&qf)[4], const u16* qrow, int hf) {
#pragma unroll
  for (int c = 0; c < 4; ++c) qf[c] = ld8(qrow + c * 16 + 8 * hf);
}

DI void mem_att_unit(char* ws, int layer, int kind, int u, int lane) {
  const int qt = u & 127, bh = u >> 7, b = bh >> 2, hm = bh & 3;
  const int ql = lane & 31, hf = lane >> 5, tq = qt * 32 + ql;
  const u16* QM = reinterpret_cast<const u16*>(ws + OFF_BIG + (kind == 1 ? BO_QM_B : BO_QM_AC));
  const u16* MK = reinterpret_cast<const u16*>(ws + OFF_MK + layer * SZ_MK);
  const u16* MVT = reinterpret_cast<const u16*>(ws + OFF_MVT + layer * SZ_MK);
  bf16x8 qf[4]; load_q(qf, QM + ((size_t)bh * S + tq) * 64, hf);
  AttState<2> st; att_init(st);
  const int pk = pi_swap(ql);
  const u16* kb = MK + ((size_t)bh * 256 + pk) * 64 + 8 * hf;
  const u16* vb = MVT + ((size_t)bh * 8) * 2048 + ql * 32 + 8 * hf;
  int klast = 7; asm volatile("" : "+s"(klast));
  att_range<2>(st, qf, 0, klast,
               [kb](int kt) { return kb + kt * 2048; }, [vb](int kt) { return vb + kt * 2048; },
               [](int) { return 0u; }, [](int, unsigned) { return [](int, float p) { return p; }; });
  u16* mix = reinterpret_cast<u16*>(ws + OFF_MIX);
  att_store<2>(st, mix + (size_t)(b * S + tq) * 1024 + 768 + hm * 64, hf);
}

DI void dsa_att_unit(char* ws, int bh, int qt, int lane) {
  const int b = bh / 12, h = bh % 12;
  const int ql = lane & 31, hf = lane >> 5, tq = qt * 32 + ql;
  char* big = ws + OFF_BIG;
  const u16* Q = reinterpret_cast<const u16*>(big + BO_Q);
  const u16* K = reinterpret_cast<const u16*>(big + BO_K);
  const u16* VT = reinterpret_cast<const u16*>(big + BO_V);
  const unsigned* BM = reinterpret_cast<const unsigned*>(big + BO_BM) + (size_t)(b * S + tq) * 128;
  bf16x8 qf[4]; load_q(qf, Q + ((size_t)bh * S + tq) * 64, hf);
  AttState<2> st; att_init(st);
  const int pk = pi_swap(ql);
  const u16* kb = K + ((size_t)bh * S + pk) * 64 + 8 * hf;
  const u16* vb = VT + ((size_t)bh * 128) * 2048 + ql * 32 + 8 * hf;
  const int sh = 8 * hf;
  att_range<2>(st, qf, 0, qt,
               [kb](int kt) { return kb + kt * 2048; }, [vb](int kt) { return vb + kt * 2048; },
               [BM](int kt) { return ldg32(BM + kt); },
               [sh](int, unsigned w) { const unsigned ws_ = w >> sh; return [ws_](int r, float p) { return mask_bit(ws_, 16 * (r >> 3) + (r & 7), p); }; });
  u16* mix = reinterpret_cast<u16*>(ws + OFF_MIX);
  att_store<2>(st, mix + (size_t)(b * S + tq) * 1024 + h * 64, hf);
}

DI void moba_att_unit(char* ws, int bh, int qt, int lane) {
  const int b = bh / 12, h = bh % 12;
  const int ql = lane & 31, hf = lane >> 5, tq = qt * 32 + ql;
  char* big = ws + OFF_BIG;
  const u16* Q = reinterpret_cast<const u16*>(big + BO_Q);
  const u16* K = reinterpret_cast<const u16*>(big + BO_K);
  const u16* VT = reinterpret_cast<const u16*>(big + BO_V);
  const float* KM = reinterpret_cast<const float*>(ws + OFF_KMEAN) + (size_t)bh * 16 * 64;
  const u16* qrow = Q + ((size_t)bh * S + tq) * 64;
  bf16x8 qf[4]; load_q(qf, qrow, hf);
  const int own = qt >> 3;
  unsigned selmask = 0u;
  {
    float b0 = -3e38f, b1 = -3e38f, b2 = -3e38f; int i0 = -1, i1 = -1, i2 = -1;
    for (int n = 0; n < own; ++n) {
      float g = 0.f;
      for (int d8 = 0; d8 < 8; ++d8) {
        const u32x4 qq = *reinterpret_cast<const u32x4*>(qrow + d8 * 8);
        const float4 ka = *reinterpret_cast<const float4*>(KM + n * 64 + d8 * 8);
        const float4 kb = *reinterpret_cast<const float4*>(KM + n * 64 + d8 * 8 + 4);
        g += __uint_as_float(qq[0] << 16) * ka.x + __uint_as_float(qq[0] & 0xffff0000u) * ka.y
           + __uint_as_float(qq[1] << 16) * ka.z + __uint_as_float(qq[1] & 0xffff0000u) * ka.w
           + __uint_as_float(qq[2] << 16) * kb.x + __uint_as_float(qq[2] & 0xffff0000u) * kb.y
           + __uint_as_float(qq[3] << 16) * kb.z + __uint_as_float(qq[3] & 0xffff0000u) * kb.w;
      }
      if (g > b0) { b2 = b1; i2 = i1; b1 = b0; i1 = i0; b0 = g; i0 = n; }
      else if (g > b1) { b2 = b1; i2 = i1; b1 = g; i1 = n; }
      else if (g > b2) { b2 = g; i2 = n; }
    }
    if (i0 >= 0) selmask |= 1u << i0;
    if (i1 >= 0) selmask |= 1u << i1;
    if (i2 >= 0) selmask |= 1u << i2;
  }
  AttState<2> st; att_init(st);
  const int pk = pi_swap(ql);
  const u16* kb = K + ((size_t)bh * S + pk) * 64 + 8 * hf;
  const u16* vb = VT + ((size_t)bh * 128) * 2048 + ql * 32 + 8 * hf;
  for (int n = 0; n < own; ++n) {
    const unsigned minew = ((selmask >> n) & 1u) ? 0xffffffffu : 0u;
    if (!__any(minew != 0u)) continue;
    att_range<2>(st, qf, n * 8, n * 8 + 7,
                 [kb](int kt) { return kb + kt * 2048; }, [vb](int kt) { return vb + kt * 2048; },
                 [minew](int) { return minew; }, [](int, unsigned w) { return [w](int, float p) { return w != 0u ? p : 0.f; }; });
  }
  att_range<2>(st, qf, own * 8, qt,
               [kb](int kt) { return kb + kt * 2048; }, [vb](int kt) { return vb + kt * 2048; },
               [](int) { return 0u; },
               [hf, tq](int kt, unsigned) { const int dq = tq - (kt * 32 + 8 * hf); return [dq](int r, float p) { return 16 * (r >> 3) + (r & 7) <= dq ? p : 0.f; }; });
  u16* mix = reinterpret_cast<u16*>(ws + OFF_MIX);
  att_store<2>(st, mix + (size_t)(b * S + tq) * 1024 + h * 64, hf);
}

template <bool DSA>
DI void blk_att_unit(char* ws, char* smem, int wid, int lane, int bh, int Qb) {
  typedef __attribute__((address_space(3))) unsigned char* lds_p;
  typedef __attribute__((address_space(3))) unsigned* lds_u32p;
  constexpr int D = 6, R = 8, SLOT = 10240;
  lds_p lds = (lds_p)smem;
  const int b = bh / 12, h = bh % 12;
  const int ql = lane & 31, hf = lane >> 5, qt = Qb * 8 + wid, tq = qt * 32 + ql, nkt = Qb * 8 + 8;
  char* big = ws + OFF_BIG;
  const u16* Q = reinterpret_cast<const u16*>(big + BO_Q);
  const u16* K = reinterpret_cast<const u16*>(big + BO_K);
  const u16* VT = reinterpret_cast<const u16*>(big + BO_V);
  const u16* qrow = Q + ((size_t)bh * S + tq) * 64;
  bf16x8 qf[4]; load_q(qf, qrow, hf);
  unsigned selmask = 0u;
  if (!DSA) {
    const u16* KMB = reinterpret_cast<const u16*>(ws + OFF_KMEANB) + (size_t)bh * 16 * 64 + 8 * hf;
    f32x16 ga, gb;
#pragma unroll
    for (int r = 0; r < 16; ++r) { ga[r] = 0.f; gb[r] = 0.f; }
#pragma unroll
    for (int c = 0; c < 4; ++c) {
      ga = mfma32(ld8(KMB + (ql & 15) * 64 + c * 16), qf[c], ga);
      gb = mfma32(ld8(KMB + ((ql & 15) ^ 4) * 64 + c * 16), qf[c], gb);
    }
    float b0 = -3e38f, b1 = -3e38f, b2 = -3e38f; int i0 = -1, i1 = -1, i2 = -1;
#pragma unroll
    for (int r = 0; r < 8; ++r) {
#pragma unroll
      for (int t = 0; t < 2; ++t) {
        const int n = ((r & 3) + 8 * (r >> 2) + 4 * hf) ^ (4 * t);
        const float g = (n < Qb) ? (t == 0 ? ga[r] : gb[r]) : -3e38f;
        const bool c0 = g > b0, c1 = g > b1, c2 = g > b2;
        const float nb2 = c1 ? b1 : (c2 ? g : b2); const int ni2 = c1 ? i1 : (c2 ? n : i2);
        const float nb1 = c0 ? b0 : (c1 ? g : b1); const int ni1 = c0 ? i0 : (c1 ? n : i1);
        const float nb0 = c0 ? g : b0;             const int ni0 = c0 ? n : i0;
        b0 = nb0; b1 = nb1; b2 = nb2; i0 = ni0; i1 = ni1; i2 = ni2;
      }
    }
    if (b0 > -1e38f) selmask |= 1u << i0;
    if (b1 > -1e38f) selmask |= 1u << i1;
    if (b2 > -1e38f) selmask |= 1u << i2;
  }
  const char* src;
  {
    const int p = (wid & 3) * 64 + lane;
    if (wid < 4) { const int r = p >> 3, lc = (p & 7) ^ ((r >> 1) & 7); src = reinterpret_cast<const char*>(K + ((size_t)bh * S + r) * 64 + lc * 8); }
    else { const int d = p >> 2, lc = (p & 3) ^ ((d >> 2) & 3); src = reinterpret_cast<const char*>(VT + (size_t)bh * 128 * 2048 + d * 32 + lc * 8); }
  }
  const char* msrc = big + BO_BM + ((size_t)(b * S + Qb * 256 + ((wid & 3) * 64 + lane)) * 128) * 4;
  const unsigned ldsw = (unsigned)wid * 1024u, ldsm = 8192u + (unsigned)wid * 256u;
#define BA_ISSUE(kt_) do { const unsigned _sb = (unsigned)(((kt_) & (R - 1)) * SLOT); \
    __builtin_amdgcn_global_load_lds((const unsigned*)(src + (size_t)(kt_) * 4096), (lds_u32p)(lds + _sb + ldsw), 16, 0, 0); \
    if (DSA) __builtin_amdgcn_global_load_lds((const unsigned*)(msrc + (size_t)(kt_) * 4), (lds_u32p)(lds + _sb + ldsm), 4, 0, 0); } while (0)
#define BA_WAIT(n) asm volatile("s_waitcnt vmcnt(" #n ")" ::: "memory")
  int koff[4], voff[4];
  {
    const int kr = pi_swap(ql);
#pragma unroll
    for (int c = 0; c < 4; ++c) koff[c] = kr * 128 + (((2 * c + hf) ^ ((kr >> 1) & 7)) << 4);
#pragma unroll
    for (int dt = 0; dt < 2; ++dt)
#pragma unroll
      for (int c = 0; c < 2; ++c) { const int d = dt * 32 + ql; voff[dt * 2 + c] = 4096 + d * 64 + (((2 * c + hf) ^ ((d >> 2) & 3)) << 4); }
  }
  const int moff = 8192 + (wid * 32 + ql) * 4;
  AttState<2> st; att_init(st);
  asm volatile("" :: "v"(qf[0]), "v"(qf[1]), "v"(qf[2]), "v"(qf[3]));
  __builtin_amdgcn_s_barrier();
#pragma unroll
  for (int i = 0; i < D; ++i) BA_ISSUE(i);
  for (int kt = 0; kt < nkt; ++kt) {
    if (kt + D < nkt) BA_ISSUE(kt + D);
    int rem = nkt - 1 - kt; rem = rem > D ? D : rem;
    if (DSA) {
      switch (rem) { case 6: BA_WAIT(12); break; case 5: BA_WAIT(10); break; case 4: BA_WAIT(8); break; case 3: BA_WAIT(6); break;
                     case 2: BA_WAIT(4); break; case 1: BA_WAIT(2); break; default: BA_WAIT(0); break; }
    } else {
      switch (rem) { case 6: BA_WAIT(6); break; case 5: BA_WAIT(5); break; case 4: BA_WAIT(4); break; case 3: BA_WAIT(3); break;
                     case 2: BA_WAIT(2); break; case 1: BA_WAIT(1); break; default: BA_WAIT(0); break; }
    }
    __builtin_amdgcn_s_barrier();
    if (kt > qt) continue;
    unsigned wmask = 0xffffffffu;
    if (!DSA && kt < Qb * 8) {
      wmask = ((selmask >> (kt >> 3)) & 1u) ? 0xffffffffu : 0u;
      if (!__any(wmask != 0u)) continue;
    }
    lds_p img = lds + (kt & (R - 1)) * SLOT;
    Frags<2> f;
#pragma unroll
    for (int c = 0; c < 4; ++c) f.k[c] = *(const __attribute__((address_space(3))) bf16x8*)(img + koff[c]);
#pragma unroll
    for (int c = 0; c < 4; ++c) f.v[c] = *(const __attribute__((address_space(3))) bf16x8*)(img + voff[c]);
    if (DSA) {
      const unsigned w_ = (*(const __attribute__((address_space(3))) unsigned*)(img + moff)) >> (8 * hf);
      att_compute<2>(st, qf, f, nullptr, [w_](int r, float p) { return mask_bit(w_, 16 * (r >> 3) + (r & 7), p); });
    } else if (kt < Qb * 8) {
      att_compute<2>(st, qf, f, nullptr, [wmask](int, float p) { return wmask != 0u ? p : 0.f; });
    } else {
      const int dq = tq - (kt * 32 + 8 * hf);
      att_compute<2>(st, qf, f, nullptr, [dq](int r, float p) { return 16 * (r >> 3) + (r & 7) <= dq ? p : 0.f; });
    }
  }
#undef BA_ISSUE
#undef BA_WAIT
  u16* mix = reinterpret_cast<u16*>(ws + OFF_MIX);
  att_store<2>(st, mix + (size_t)(b * S + tq) * 1024 + h * 64, hf);
}

DI void dil_att_unit(char* ws, int u, int lane) {
  const int r16 = u & 15, T0 = (u >> 4) & 7, bhh = u >> 7, b = bhh >> 2, hh = bhh & 3;
  const int ql = lane & 31, hf = lane >> 5;
  const int tq = T0 * 512 + 16 * ql + r16;
  char* big = ws + OFF_BIG;
  const u16* Q = reinterpret_cast<const u16*>(big + BO_Q);
  const u16* K = reinterpret_cast<const u16*>(big + BO_K);
  AttState<6> st; att_init(st);
  const int pk = pi_swap(ql);
  for (int g = 0; g < 3; ++g) {
    const int sh = 2 * g, dil = 1 << sh, r = r16 & (dil - 1);
    const int bh = b * 12 + 4 * g + hh;
    bf16x8 qf[4];
    load_q(qf, Q + ((size_t)bh * S + tq) * 64, hf);
    const int jq = tq >> sh;
    const int jmin = (T0 * 512 + r16) >> sh, jmax = (T0 * 512 + 496 + r16) >> sh;
    int k0 = jmin - 128; k0 = k0 < 0 ? 0 : k0 >> 5;
    const u16* Vg = reinterpret_cast<const u16*>(big + BO_V + (size_t)g * SZ_QKV) + ((size_t)(bhh * dil + r) * (128 >> sh)) * 6144 + ql * 32 + 8 * hf;
    const u16* Kg = K + ((size_t)bh * S + r) * 64 + 8 * hf;
    att_range<6>(st, qf, k0, jmax >> 5,
                 [Kg, pk, sh](int jt) { return Kg + ((size_t)((jt * 32 + pk) << sh)) * 64; },
                 [Vg](int jt) { return Vg + (size_t)jt * 6144; },
                 [](int) { return 0u; },
                 [hf, jq](int jt, unsigned) { const int dq = jq - (jt * 32 + 8 * hf); return [dq](int rr, float p) { return (unsigned)(dq - (16 * (rr >> 3) + (rr & 7))) <= 128u ? p : 0.f; }; });
  }
  u16* mix = reinterpret_cast<u16*>(ws + OFF_MIX);
  att_store<6>(st, mix + (size_t)(b * S + tq) * 1024 + hh * 192, hf);
}

DI void ki_prep_phase(const Ctx& cx, char* ws, const float* g, const float* bta) {
  const int lane = cx.tid & 63, gw = cx.bid * WPB + __builtin_amdgcn_readfirstlane(cx.tid >> 6), nw = cx.nb * WPB;
  const float* raw = reinterpret_cast<const float*>(ws + OFF_BIG + BO_KIRAW);
  u16* kib = reinterpret_cast<u16*>(ws + OFF_BIG + BO_KIB);
  const float* cs = reinterpret_cast<const float*>(ws + OFF_COS);
  const float* sn = reinterpret_cast<const float*>(ws + OFF_SIN);
  const float gg = g[lane], bb = bta[lane];
  constexpr int RB = 4;
  for (int r0 = gw * RB; r0 < T; r0 += nw * RB) {
    float v[RB], c[RB], s[RB];
#pragma unroll
    for (int k = 0; k < RB; ++k) {
      v[k] = raw[(size_t)(r0 + k) * 64 + lane];
      c[k] = cs[(r0 + k) * 8 + (lane & 7)]; s[k] = sn[(r0 + k) * 8 + (lane & 7)];
    }
    float mu[RB], d[RB], rs[RB];
#pragma unroll
    for (int k = 0; k < RB; ++k) mu[k] = wave_sum(v[k]) * (1.f / 64.f);
#pragma unroll
    for (int k = 0; k < RB; ++k) { d[k] = v[k] - mu[k]; rs[k] = rsqrtf(wave_sum(d[k] * d[k]) * (1.f / 64.f) + LN_EPS); }
#pragma unroll
    for (int k = 0; k < RB; ++k) {
      float y = d[k] * rs[k] * gg + bb;
      const float py = sx<8>(y);
      if (lane < 16) y = lane < 8 ? y * c[k] - py * s[k] : y * c[k] + py * s[k];
      kib[(size_t)(r0 + k) * 64 + rope_pos(lane)] = f2bf(y);
    }
  }
}

DI unsigned sortable(float f) { unsigned u = __float_as_uint(f); u = (u & 0x80000000u) ? ~u : (u | 0x80000000u); return u & ~((1u << SEL_LOW_BIT) - 1u); }

DI int wave_total(int v) {
  v += __builtin_amdgcn_update_dpp(0, v, 0x111, 0xf, 0xf, true);
  v += __builtin_amdgcn_update_dpp(0, v, 0x112, 0xf, 0xf, true);
  v += __builtin_amdgcn_update_dpp(0, v, 0x114, 0xf, 0xf, true);
  v += __builtin_amdgcn_update_dpp(0, v, 0x118, 0xf, 0xf, true);
  v += __builtin_amdgcn_update_dpp(0, v, 0x142, 0xa, 0xf, true);
  v += __builtin_amdgcn_update_dpp(0, v, 0x143, 0xc, 0xf, true);
  return __builtin_amdgcn_readlane(v, 63);
}

DI unsigned long long select256(const unsigned (&u)[64], int lane) {
  unsigned th = 0u;
  int g = 0;
  for (int bit = 31; bit >= SEL_LOW_BIT; --bit) {
    const unsigned c = th | (1u << bit);
    int cnt = 0;
#pragma unroll
    for (int r = 0; r < 64; r += 8)
      asm("v_cmp_le_u32 vcc, %1, %2\n\tv_addc_co_u32 %0, vcc, 0, %0, vcc\n\t"
          "v_cmp_le_u32 vcc, %1, %3\n\tv_addc_co_u32 %0, vcc, 0, %0, vcc\n\t"
          "v_cmp_le_u32 vcc, %1, %4\n\tv_addc_co_u32 %0, vcc, 0, %0, vcc\n\t"
          "v_cmp_le_u32 vcc, %1, %5\n\tv_addc_co_u32 %0, vcc, 0, %0, vcc\n\t"
          "v_cmp_le_u32 vcc, %1, %6\n\tv_addc_co_u32 %0, vcc, 0, %0, vcc\n\t"
          "v_cmp_le_u32 vcc, %1, %7\n\tv_addc_co_u32 %0, vcc, 0, %0, vcc\n\t"
          "v_cmp_le_u32 vcc, %1, %8\n\tv_addc_co_u32 %0, vcc, 0, %0, vcc\n\t"
          "v_cmp_le_u32 vcc, %1, %9\n\tv_addc_co_u32 %0, vcc, 0, %0, vcc"
          : "+v"(cnt) : "s"(c), "v"(u[r]), "v"(u[r + 1]), "v"(u[r + 2]), "v"(u[r + 3]), "v"(u[r + 4]), "v"(u[r + 5]), "v"(u[r + 6]), "v"(u[r + 7]) : "vcc");
    const int n = wave_total(cnt);
    if (n == 256) { th = c - 1u; g = 256; break; }
    if (n > 256) th = c; else g = n;
  }
  int need = th == 0u ? 0 : 256 - g;
  int mlo = 0, mhi = 0;
#pragma unroll
  for (int r = 0; r < 64; ++r) {
    const unsigned long long gt = __ballot(u[r] > th), eq = __ballot(u[r] == th);
    unsigned long long tk = 0ull;
    if (need > 0 && eq != 0ull) {
      const int pre = __builtin_amdgcn_mbcnt_hi((unsigned)(eq >> 32), __builtin_amdgcn_mbcnt_lo((unsigned)eq, 0u));
      tk = __ballot(u[r] == th && pre < need);
      need -= __popcll(tk);
    }
    const unsigned long long mv = gt | tk;
    asm volatile("s_nop 3\n\tv_writelane_b32 %0, %2, %4\n\tv_writelane_b32 %1, %3, %4" : "+v"(mlo), "+v"(mhi) : "s"((unsigned)mv), "s"((unsigned)(mv >> 32)), "n"(r));
  }
  return ((unsigned long long)(unsigned)mhi << 32) | (unsigned)mlo;
}

DI void dsa_select_block(char* ws, char* smem, int wid, int lane, int b, int t0, int gwave) {
  typedef __attribute__((address_space(3))) unsigned char* lds_p;
  lds_p lds = (lds_p)smem;
  char* big = ws + OFF_BIG;
  const u16* QI = reinterpret_cast<const u16*>(big + BO_QI);
  const char* kbase = big + BO_KIB + (size_t)b * S * 128;
  const float* WI = reinterpret_cast<const float*>(big + BO_WI);
  unsigned long long* BM = reinterpret_cast<unsigned long long*>(big + BO_BM);
  unsigned* scr = reinterpret_cast<unsigned*>(big + BO_SCR) + (size_t)gwave * 4096 + lane;
  const int tA = t0 + 2 * wid, nch = ((t0 + 15) >> 8) + 1;
  const int row = lane & 15, kq = lane >> 4, tid = wid * 64 + lane;
  const u16* qip = QI + ((size_t)(b * S + tA + (row >> 3)) * 8 + (row & 7)) * 64 + kq * 8;
  const bf16x8 qa0 = ld8(qip), qa1 = ld8(qip + 32);
  const float4 w = *reinterpret_cast<const float4*>(WI + (size_t)(b * S + tA + (kq >> 1)) * 8 + (kq & 1) * 4);
  unsigned soff[4];
#pragma unroll
  for (int i = 0; i < 4; ++i) { const int p = i * 512 + tid, r = p >> 3, lc = (p & 7) ^ ((r >> 1) & 7); soff[i] = (unsigned)(r * 128 + lc * 16); }
  const unsigned ldsw = (unsigned)wid * 1024u;
#define SEL_ISSUE(c, slot) do { _Pragma("unroll") for (int _i = 0; _i < 4; ++_i) \
    __builtin_amdgcn_global_load_lds((const unsigned*)(kbase + (size_t)(c) * 32768 + soff[_i]), (__attribute__((address_space(3))) unsigned*)(lds + (slot) * 32768 + _i * 8192 + ldsw), 16, 0, 0); } while (0)
#define SEL_WAIT(n) asm volatile("s_waitcnt vmcnt(" #n ")" ::: "memory")
  int boff[2];
#pragma unroll
  for (int kk = 0; kk < 2; ++kk) boff[kk] = row * 128 + (((kk * 4 + kq) ^ ((row >> 1) & 7)) << 4);
  asm volatile("" :: "v"(qa0), "v"(qa1), "v"(w.x), "v"(w.y), "v"(w.z), "v"(w.w));
  __builtin_amdgcn_s_barrier();
  SEL_ISSUE(0, 0);
  if (nch > 1) SEL_ISSUE(1, 1);
  unsigned u[64];
#pragma unroll
  for (int c = 0; c < 16; ++c) {
    if (c < nch) {
      if (c + 2 < nch) { SEL_ISSUE(c + 2, (c + 2) & 3); SEL_WAIT(8); }
      else if (c + 1 < nch) SEL_WAIT(4);
      else SEL_WAIT(0);
      __builtin_amdgcn_s_barrier();
      lds_p img = lds + (c & 3) * 32768;
#pragma unroll
      for (int rr = 0; rr < 4; ++rr) {
        const int r = c * 4 + rr;
        float sa[4], sb[4];
        bf16x8 kb0[4], kb1[4];
#pragma unroll
        for (int tt = 0; tt < 4; ++tt) {
          const int tile = rr * 4 + tt;
          kb0[tt] = *(const __attribute__((address_space(3))) bf16x8*)(img + tile * 2048 + boff[0]);
          kb1[tt] = *(const __attribute__((address_space(3))) bf16x8*)(img + tile * 2048 + boff[1]);
        }
        f32x4 cc[4];
#pragma unroll
        for (int tt = 0; tt < 4; ++tt) cc[tt] = mfma16(qa0, kb0[tt], f32x4{0.f, 0.f, 0.f, 0.f});
#pragma unroll
        for (int tt = 0; tt < 4; ++tt) cc[tt] = mfma16(qa1, kb1[tt], cc[tt]);
        float pp[4], ps[4];
#pragma unroll
        for (int tt = 0; tt < 4; ++tt) pp[tt] = w.x * fmaxf(cc[tt][0], 0.f) + w.y * fmaxf(cc[tt][1], 0.f) + w.z * fmaxf(cc[tt][2], 0.f) + w.w * fmaxf(cc[tt][3], 0.f);
#pragma unroll
        for (int tt = 0; tt < 4; ++tt) ps[tt] = sx<16>(pp[tt]);
#pragma unroll
        for (int tt = 0; tt < 4; ++tt) {
          const float pt = pp[tt] + ps[tt];
          const int iv = __builtin_bit_cast(int, pt); int iw = iv; asm volatile("" : "+v"(iw));
          auto sw = __builtin_amdgcn_permlane32_swap(iv, iw, false, false);
          sa[tt] = __builtin_bit_cast(float, (int)sw[0]); sb[tt] = __builtin_bit_cast(float, (int)sw[1]);
        }
        const float scA = kq == 0 ? sa[0] : kq == 1 ? sa[1] : kq == 2 ? sa[2] : sa[3];
        const float scB = kq == 0 ? sb[0] : kq == 1 ? sb[1] : kq == 2 ? sb[2] : sb[3];
        const int key = r * 64 + lane;
        u[r] = key <= tA ? sortable(scA) : 0u;
        stg4(scr + r * 64, key <= tA + 1 ? sortable(scB) : 0u);
      }
    } else {
#pragma unroll
      for (int rr = 0; rr < 4; ++rr) { u[c * 4 + rr] = 0u; stg4(scr + (c * 4 + rr) * 64, 0u); }
    }
  }
#undef SEL_ISSUE
#undef SEL_WAIT
  const unsigned long long mA = select256(u, lane);
  stg8(BM + (size_t)(b * S + tA) * 64 + lane, make_uint2((unsigned)mA, (unsigned)(mA >> 32)));
#pragma unroll
  for (int r = 0; r < 64; ++r) u[r] = ldg32(scr + r * 64);
  const unsigned long long mB = select256(u, lane);
  stg8(BM + (size_t)(b * S + tA + 1) * 64 + lane, make_uint2((unsigned)mB, (unsigned)(mB >> 32)));
}

DI void kmean_phase(const Ctx& cx, char* ws) {
  const int lane = cx.tid & 63, gw = cx.bid * WPB + __builtin_amdgcn_readfirstlane(cx.tid >> 6), nw = cx.nb * WPB;
  const u16* K = reinterpret_cast<const u16*>(ws + OFF_BIG + BO_K);
  float* KM = reinterpret_cast<float*>(ws + OFF_KMEAN);
  for (int u = gw; u < NB * 12 * 16; u += nw) {
    const int bh = u >> 4, blk = u & 15;
    const u16* kp = K + ((size_t)bh * S + blk * 256) * 64 + lane * 8;
    float acc[8];
#pragma unroll
    for (int j = 0; j < 8; ++j) acc[j] = 0.f;
#pragma unroll 8
    for (int i = 0; i < 32; ++i) {
      const u32x4 v = __builtin_bit_cast(u32x4, ld8(kp + i * 512));
#pragma unroll
      for (int j = 0; j < 4; ++j) { acc[2 * j] += __uint_as_float(v[j] << 16); acc[2 * j + 1] += __uint_as_float(v[j] & 0xffff0000u); }
    }
#pragma unroll
    for (int j = 0; j < 8; ++j) { float a = acc[j]; a += sx<8>(a); a += sx<16>(a); a = red32_sum(a); acc[j] = a * (1.f / 256.f); }
    if (lane < 8) {
      float* dst = KM + (size_t)u * 64 + lane * 8;
      *reinterpret_cast<float4*>(dst) = make_float4(acc[0], acc[1], acc[2], acc[3]);
      *reinterpret_cast<float4*>(dst + 4) = make_float4(acc[4], acc[5], acc[6], acc[7]);
      *reinterpret_cast<uint4*>(reinterpret_cast<u16*>(ws + OFF_KMEANB) + (size_t)u * 64 + lane * 8) =
          make_uint4(pk2(acc[0], acc[1]), pk2(acc[2], acc[3]), pk2(acc[4], acc[5]), pk2(acc[6], acc[7]));
    }
  }
}

DI void grid_barrier(unsigned* cnt, unsigned target, int tid) {
  asm volatile("s_waitcnt vmcnt(0)" ::: "memory");
  __syncthreads();
  if (tid == 0) {
    __builtin_amdgcn_fence(__ATOMIC_RELEASE, "agent");
    asm volatile("s_waitcnt vmcnt(0)" ::: "memory");
    __hip_atomic_fetch_add(cnt, 1u, __ATOMIC_RELAXED, __HIP_MEMORY_SCOPE_AGENT);
    while (__hip_atomic_load(cnt, __ATOMIC_RELAXED, __HIP_MEMORY_SCOPE_AGENT) < target) __builtin_amdgcn_s_sleep(1);
    __builtin_amdgcn_fence(__ATOMIC_ACQUIRE, "agent");
    asm volatile("s_waitcnt vmcnt(0)" ::: "memory");
  }
  __syncthreads();
}

#define XB_TMO      128
#define XB_XCNT(j)  (256  + 64 * (j))
#define XB_XSUB(j)  (1280 + 64 * (j))
#define XB_XGEN(j)  (2304 + 64 * (j))
#define XB_TOP      3328
#define XB_TOPGEN   3392
#define XB_SPIN_CAP (1u << 20)
DI unsigned xb_ld(unsigned* p) { return __hip_atomic_load(p, __ATOMIC_RELAXED, __HIP_MEMORY_SCOPE_AGENT); }
DI unsigned xb_add(unsigned* p, unsigned v) { return __hip_atomic_fetch_add(p, v, __ATOMIC_RELAXED, __HIP_MEMORY_SCOPE_AGENT); }
DI unsigned xb_xcc_id() { return (unsigned)__builtin_amdgcn_s_getreg((3 << 11) | 20) & 0xFu; }
#define XB_SPIN(cond, bar) do { unsigned _sp = 0; while (cond) { __builtin_amdgcn_s_sleep(1); \
    if ((++_sp & 255u) == 0u) { if (xb_ld(&(bar)[XB_TMO])) break; if (_sp > XB_SPIN_CAP) { atomicAdd(&(bar)[XB_TMO], 1u); break; } } } } while (0)
typedef volatile __attribute__((address_space(3))) unsigned* xb_lds_p;
DI void xcd_barrier_complete(unsigned* bar, unsigned x, unsigned G, unsigned& nloc, unsigned& nx) {
  unsigned sum, cnt, mine, sp = 0u;
  for (;;) {
    sum = 0u; cnt = 0u; mine = 0u;
#pragma unroll
    for (unsigned j = 0; j < 16; ++j) { const unsigned c = xb_ld(&bar[XB_XCNT(j)]); sum += c; cnt += (c > 0u) ? 1u : 0u; mine = (j == x) ? c : mine; }
    if (sum == G) break;
    __builtin_amdgcn_s_sleep(1);
    if ((++sp & 255u) == 0u) { if (xb_ld(&bar[XB_TMO])) break; if (sp > XB_SPIN_CAP) { atomicAdd(&bar[XB_TMO], 1u); break; } }
  }
  nloc = mine > 0u ? mine : 1u; nx = cnt > 0u ? cnt : 1u;
}
DI void xcd_barrier(unsigned* bar, unsigned x, xb_lds_p st, unsigned G, int tid) {
  asm volatile("s_waitcnt vmcnt(0)" ::: "memory");
  __syncthreads();
  if (tid == 0) {
    __builtin_amdgcn_s_waitcnt(0);
    unsigned nloc = st[0], nx = st[1];
    if (nloc == 0u) { xcd_barrier_complete(bar, x, G, nloc, nx); st[0] = nloc; st[1] = nx; }
    const unsigned old = xb_add(&bar[XB_XSUB(x)], 1u);
    const unsigned gen = old / nloc;
    if (old + 1u == (gen + 1u) * nloc) {
      __builtin_amdgcn_fence(__ATOMIC_RELEASE, "agent");
      asm volatile("s_waitcnt vmcnt(0)" ::: "memory");
      const unsigned og = xb_add(&bar[XB_TOP], 1u);
      const unsigned tg = og / nx;
      if (og + 1u == (tg + 1u) * nx) xb_add(&bar[XB_TOPGEN], 1u);
      else XB_SPIN(xb_ld(&bar[XB_TOPGEN]) == tg, bar);
      __builtin_amdgcn_fence(__ATOMIC_ACQUIRE, "agent");
      xb_add(&bar[XB_XGEN(x)], 1u);
      asm volatile("s_waitcnt vmcnt(0)" ::: "memory");
    } else {
      XB_SPIN(xb_ld(&bar[XB_XGEN(x)]) == gen, bar);
      __builtin_amdgcn_fence(__ATOMIC_ACQUIRE, "agent");
      asm volatile("s_waitcnt vmcnt(0)" ::: "memory");
    }
  }
  __syncthreads();
}

template <class Epi>
DI void run_gemm(const Ctx& cx, char* smem, const u16* A, const u16* Bt, int M, int N, int K, int crot, const Epi& epi) {
  pg8::StaticOrder so; so.init(M, N, cx.nb, (cx.bid + crot) % cx.nb);
  pg8::gemm_phase(cx.tid, (PG8_LAS unsigned char*)smem, pg8::Gemm{A, Bt, M, N, K}, so, epi);
}

__global__ void __launch_bounds__(NTHR, 2) fwd_kernel(Params p) {
  extern __shared__ __attribute__((aligned(16))) char smem[];
  cg::grid_group grid = cg::this_grid();
  bool first = true;
  const int wave_id = __builtin_amdgcn_readfirstlane(threadIdx.x >> 6);
  xb_lds_p xb_st = (xb_lds_p)(smem + LDS_BYTES);
  unsigned* xb_bar = reinterpret_cast<unsigned*>(p.ws + OFF_BAR);
  const unsigned xb_x = xb_xcc_id();
  if (threadIdx.x == 0) { xb_st[0] = 0u; xb_st[1] = 0u; (void)xb_add(&xb_bar[XB_XCNT(xb_x)], 1u); }
  __syncthreads();
  if (p.ph_lo == 0) {
    Ctx cx; cx.tid = threadIdx.x; cx.bid = blockIdx.x; cx.nb = gridDim.x;
    if (EN & 1) phase0(cx, p, p.ws, smem);
    if (XP0) phase0(cx, p, p.ws, smem);
    for (int i = 0; i < XSYNC; ++i) grid.sync();
    first = false;
  }
  bool rep_done = false;
  int nbar = 0;
  for (int ph = p.ph_lo < 1 ? 1 : p.ph_lo; ph < p.ph_hi; ++ph) {
    const int layer = (ph - 1) / 9, slot = (ph - 1) % 9;
    if (REP) { if (((REP >> slot) & 1) && ((REPL >> layer) & 1) && !rep_done) { rep_done = true; --ph; } else rep_done = false; }
    const int kind = layer % 3, jl = layer / 3;
    if ((slot == 1 && kind == 1) || (slot == 2 && kind != 0)) continue;
    if (!first) {
      if (nbar == 0) grid.sync();
      else xcd_barrier(reinterpret_cast<unsigned*>(p.ws + OFF_BAR), xb_x, xb_st, gridDim.x, (int)threadIdx.x);
      ++nbar;
    }
    first = false;
    typedef const Params __attribute__((address_space(4)))* KArgs;
    KArgs pp = (KArgs)__builtin_amdgcn_kernarg_segment_ptr();
    asm volatile("" : "+s"(pp));
    char* ws = pp->ws; float* outp = pp->out;
    Ctx cx; cx.bid = blockIdx.x; cx.nb = gridDim.x;
    int wid = wave_id;
    asm volatile("" : "+s"(ws), "+s"(outp), "+s"(wid), "+s"(cx.bid), "+s"(cx.nb));
    unsigned ones = ~0u; asm volatile("" : "+s"(ones));
    const int lane = __builtin_amdgcn_mbcnt_hi(ones, __builtin_amdgcn_mbcnt_lo(ones, 0u));
    cx.tid = wid * 64 + lane;
    const int gw = cx.bid * WPB + wid, nw = cx.nb * WPB;
    if (slot == 0 && (EN & 2)) {
      const int nmain = kind == 0 ? NMAIN_A : NMAIN_BC;
      run_gemm(cx, smem, reinterpret_cast<const u16*>(ws + OFF_XB), reinterpret_cast<const u16*>(ws + win_off(layer)), T, nmain, 1024, 0, EpiInProj{ws, kind});
      run_gemm(cx, smem, reinterpret_cast<const u16*>(ws + win_off(layer)) + (size_t)nmain * 1024, reinterpret_cast<const u16*>(ws + OFF_XB), 768, T, 1024, kind == 0 ? 0 : cx.nb / 2, EpiVt{ws, kind});
      if (layer == 0 && (EN & 2048))
        run_gemm(cx, smem, reinterpret_cast<const u16*>(ws + OFF_MEMN), reinterpret_cast<const u16*>(ws + OFF_WMKV), NB * NMEM, 4 * 512, 1024, cx.nb / 2, EpiMemKV{ws});
    } else if (slot == 1 && (EN & 4)) {
      if (kind == 0) ki_prep_phase(cx, ws, pp->idx_g + jl * 64, pp->idx_b + jl * 64);
      else kmean_phase(cx, ws);
    } else if (slot == 2 && (EN & 8)) {
      for (int v = cx.bid; v < NB * (S / 16); v += cx.nb) {
        const int b = v >> 8, idx = v & 255, j = (b & 1) ? 255 - idx : idx;
        dsa_select_block(ws, smem, wid, lane, b, j * 16, gw);
      }
    } else if (slot == 3) {
      if (EN & 128) for (int u = gw; u < NB * 4 * 128; u += nw) mem_att_unit(ws, layer, kind, u, lane);
      if (kind == 1 && (EN & 16)) {
        for (int u = gw; u < NB * 4 * 8 * 16; u += nw) dil_att_unit(ws, u, lane);
      } else {
        for (int k = 0; k * cx.nb < NB * 12 * 16; ++k) {
          const int v = k * cx.nb + ((k & 1) ? cx.nb - 1 - cx.bid : cx.bid);
          if (v >= NB * 12 * 16) continue;
          const int Qb = 15 - v / 96, bh = v % 96;
          if (kind == 0) { if (EN & 32) blk_att_unit<true>(ws, smem, wid, lane, bh, Qb); }
          else { if (EN & 64) blk_att_unit<false>(ws, smem, wid, lane, bh, Qb); }
        }
      }
    } else if (slot == 4 && (EN & 256)) {
      run_gemm(cx, smem, reinterpret_cast<const u16*>(ws + OFF_MIX), reinterpret_cast<const u16*>(ws + OFF_WOUT + layer * SZ_WOUT), T, 1024, 1024, 0, EpiResid{layer == 0 ? pp->x : outp, outp, layer == 0 ? nullptr : reinterpret_cast<const float2*>(ws + OFF_STAT), pp->ln2g + (layer - 1) * 1024, pp->ln2b + (layer - 1) * 1024});
    } else if (slot == 5) {
      ln_phase(cx, outp, pp->ln1g + layer * 1024, pp->ln1b + layer * 1024, reinterpret_cast<u16*>(ws + OFF_XB), reinterpret_cast<float2*>(ws + OFF_STAT), false);
    } else if (slot == 6 && (EN & 512)) {
      run_gemm(cx, smem, reinterpret_cast<const u16*>(ws + OFF_XB), reinterpret_cast<const u16*>(ws + OFF_WGU + layer * SZ_WGU), T, 2 * DFF, 1024, 0, EpiSwiGLU{reinterpret_cast<u16*>(ws + OFF_BIG + BO_H)});
    } else if (slot == 7 && (EN & 1024)) {
      run_gemm(cx, smem, reinterpret_cast<const u16*>(ws + OFF_BIG + BO_H), reinterpret_cast<const u16*>(ws + OFF_WDN + layer * SZ_WDN), T, 1024, DFF, 0, EpiResid{outp, outp, reinterpret_cast<const float2*>(ws + OFF_STAT), pp->ln1g + layer * 1024, pp->ln1b + layer * 1024});
    } else {
      ln_phase(cx, outp, pp->ln2g + layer * 1024, pp->ln2b + layer * 1024, reinterpret_cast<u16*>(ws + OFF_XB), reinterpret_cast<float2*>(ws + OFF_STAT), layer == DEPTH - 1);
    }
  }
}

extern "C" void kernel_launch(void* const* d_in, const int* in_sizes, int n_in, void* d_out, int out_size,
                              void* d_ws, size_t ws_size, hipStream_t stream) {
  static int grid_blocks = 0;
  if (!grid_blocks) {
    int dev = 0, cus = 0, per_cu = 0;
    (void)hipGetDevice(&dev);
    (void)hipDeviceGetAttribute(&cus, hipDeviceAttributeMultiprocessorCount, dev);
    if (hipFuncSetAttribute((const void*)fwd_kernel, hipFuncAttributeMaxDynamicSharedMemorySize, LDS_TOTAL) != hipSuccess)
      fprintf(stderr, "hipFuncSetAttribute(max dynamic LDS) failed\n");
    (void)hipOccupancyMaxActiveBlocksPerMultiprocessor(&per_cu, fwd_kernel, NTHR, LDS_TOTAL);
    if (per_cu < 1) fprintf(stderr, "occupancy query reports %d blocks per CU\n", per_cu);
    grid_blocks = cus;
  }
  if (ws_size < WS_NEED) fprintf(stderr, "workspace too small: %zu < %zu\n", ws_size, (size_t)WS_NEED);
  Params p{};
  p.x = (const float*)d_in[0]; p.mem = (const float*)d_in[1]; p.pos = (const int*)d_in[2];
  p.mem_g = (const float*)d_in[3]; p.mem_b = (const float*)d_in[4];
  p.w_in_a = (const float*)d_in[5]; p.idx_g = (const float*)d_in[6]; p.idx_b = (const float*)d_in[7];
  p.w_in_b = (const float*)d_in[8]; p.w_in_c = (const float*)d_in[9];
  p.w_mkv = (const float*)d_in[10]; p.w_out = (const float*)d_in[11];
  p.ln1g = (const float*)d_in[12]; p.ln1b = (const float*)d_in[13];
  p.w_gu = (const float*)d_in[14]; p.w_dn = (const float*)d_in[15];
  p.ln2g = (const float*)d_in[16]; p.ln2b = (const float*)d_in[17];
  p.out = (float*)d_out; p.ws = (char*)d_ws;
  for (int i = 0; i < 8; ++i) p.inv_freq[i] = (float)pow(500000.0, -(double)i / 8.0);
  const int NPH = 1 + DEPTH * 9;
#if SINGLE_LAUNCH
  (void)hipMemsetAsync((char*)d_ws + OFF_BAR, 0, (size_t)XCD_BAR_WORDS * 4, stream);
  p.ph_lo = 0; p.ph_hi = NPH;
  void* args[] = {&p};
  hipError_t e = hipLaunchCooperativeKernel((void*)fwd_kernel, dim3(grid_blocks), dim3(NTHR), args, LDS_TOTAL, stream);
  if (e != hipSuccess) fprintf(stderr, "cooperative launch failed: %s (grid %d)\n", hipGetErrorString(e), grid_blocks);
#else
  for (int ph = 0; ph < NPH; ++ph) {
    if (ph > 0) {
      const int layer = (ph - 1) / 9, slot = (ph - 1) % 9, kind = layer % 3;
      if ((slot == 1 && kind == 1) || (slot == 2 && kind != 0)) continue;
    }
    p.ph_lo = ph; p.ph_hi = ph + 1;
    hipLaunchKernelGGL(fwd_kernel, dim3(grid_blocks), dim3(NTHR), LDS_TOTAL, stream, p);
  }
#endif
}
```

```cpp
#include <hip/hip_runtime.h>
#include <hip/hip_cooperative_groups.h>
#include <cstdio>
#include <cmath>
namespace cg = cooperative_groups;

#ifndef EN
#define EN 0xFFFF
#endif
#ifndef SEL_LOW_BIT
#define SEL_LOW_BIT 8
#endif
#ifndef XSYNC
#define XSYNC 0
#endif
#ifndef XP0
#define XP0 0
#endif
#ifndef REP
#define REP 0
#endif
#ifndef REPL
#define REPL 15
#endif
#ifndef SINGLE_LAUNCH
#define SINGLE_LAUNCH 1
#endif

#define DI __device__ __forceinline__
typedef unsigned short u16;
using bf16x8 = __attribute__((ext_vector_type(8))) __bf16;
using bf2 = __attribute__((ext_vector_type(2))) __bf16;
using f32x4 = __attribute__((ext_vector_type(4))) float;
using f32x16 = __attribute__((ext_vector_type(16))) float;
using u32x4 = __attribute__((ext_vector_type(4))) unsigned;

constexpr int NB = 8, S = 4096, DM = 1024, T = NB * S, DEPTH = 4;
constexpr int NMEM = 256, DFF = 2816;
constexpr int NPAD_A = 3328, NPAD_BC = 2560;
constexpr int NMAIN_A = 2560, NMAIN_BC = 1792;
constexpr int NTHR = 512, WPB = 8;
constexpr int LDS_BYTES = 131072;
constexpr int LDS_TOTAL = LDS_BYTES + 16;
constexpr float ALPHA = 1.681792830507429f;
constexpr float LN_EPS = 1e-5f;

constexpr size_t SZ_WIN_A = (size_t)NPAD_A * 1024 * 2, SZ_WIN_BC = (size_t)NPAD_BC * 1024 * 2;
constexpr size_t OFF_WIN0 = 0;
constexpr size_t OFF_WIN1 = OFF_WIN0 + SZ_WIN_A;
constexpr size_t OFF_WIN2 = OFF_WIN1 + SZ_WIN_BC;
constexpr size_t OFF_WIN3 = OFF_WIN2 + SZ_WIN_BC;
constexpr size_t OFF_WMKV = OFF_WIN3 + SZ_WIN_A;
constexpr size_t SZ_WMKV = (size_t)512 * 1024 * 2;
constexpr size_t OFF_WOUT = OFF_WMKV + 4 * SZ_WMKV;
constexpr size_t SZ_WOUT = (size_t)1024 * 1024 * 2;
constexpr size_t OFF_WGU = OFF_WOUT + 4 * SZ_WOUT;
constexpr size_t SZ_WGU = (size_t)5632 * 1024 * 2;
constexpr size_t OFF_WDN = OFF_WGU + 4 * SZ_WGU;
constexpr size_t SZ_WDN = (size_t)1024 * 2816 * 2;
constexpr size_t OFF_XB = OFF_WDN + 4 * SZ_WDN;
constexpr size_t SZ_XB = (size_t)T * 1024 * 2;
constexpr size_t OFF_MIX = OFF_XB + SZ_XB;
constexpr size_t OFF_MEMN = OFF_MIX + SZ_XB;
constexpr size_t OFF_MK = OFF_MEMN + (size_t)2048 * 1024 * 2;
constexpr size_t SZ_MK = (size_t)8 * 4 * 256 * 64 * 2;
constexpr size_t OFF_MVT = OFF_MK + 4 * SZ_MK;
constexpr size_t OFF_COS = OFF_MVT + 4 * SZ_MK;
constexpr size_t OFF_SIN = OFF_COS + (size_t)T * 8 * 4;
constexpr size_t OFF_KMEAN = OFF_SIN + (size_t)T * 8 * 4;
constexpr size_t OFF_KMEANB = OFF_KMEAN + (size_t)8 * 12 * 16 * 64 * 4;
constexpr size_t OFF_BIG = OFF_KMEANB + (size_t)8 * 12 * 16 * 64 * 2;
constexpr size_t SZ_QKV = (size_t)T * 768 * 2;
constexpr size_t BO_Q = 0, BO_K = SZ_QKV, BO_V = 2 * SZ_QKV;
constexpr size_t BO_QM_AC = 3 * SZ_QKV, BO_QM_B = 5 * SZ_QKV;
constexpr size_t SZ_QM = (size_t)T * 256 * 2;
constexpr size_t BO_QI = BO_QM_AC + SZ_QM;
constexpr size_t BO_KIRAW = BO_QI + (size_t)T * 512 * 2;
constexpr size_t BO_KIB = BO_KIRAW + (size_t)T * 64 * 4;
constexpr size_t BO_WI = BO_KIB + (size_t)T * 64 * 2;
constexpr size_t BO_BM = BO_WI + (size_t)T * 8 * 4;
constexpr size_t BO_SCR = BO_BM + (size_t)T * 128 * 4;
constexpr size_t BO_H = 0;
constexpr size_t OFF_STAT = OFF_BIG + 5 * SZ_QKV + SZ_QM;
constexpr size_t OFF_BAR = OFF_STAT + (size_t)T * 8;
constexpr int XCD_BAR_WORDS = 3456;
constexpr size_t WS_NEED = OFF_BAR + (size_t)XCD_BAR_WORDS * 4;

struct Ctx { int tid, bid, nb; };

struct Params {
  const float* x; const float* mem; const int* pos; const float* mem_g; const float* mem_b;
  const float* w_in_a; const float* idx_g; const float* idx_b; const float* w_in_b; const float* w_in_c;
  const float* w_mkv; const float* w_out; const float* ln1g; const float* ln1b;
  const float* w_gu; const float* w_dn; const float* ln2g; const float* ln2b;
  float* out; char* ws;
  float inv_freq[8];
  int ph_lo, ph_hi;
};

DI unsigned pk2(float a, float b) { bf2 v; v[0] = (__bf16)a; v[1] = (__bf16)b; return __builtin_bit_cast(unsigned, v); }
DI u16 f2bf(float a) { return __builtin_bit_cast(u16, (__bf16)a); }
DI float bf2f(u16 b) { return __uint_as_float(((unsigned)b) << 16); }
typedef const bf16x8 __attribute__((address_space(1)))* gp_bf16x8;
typedef const unsigned __attribute__((address_space(1)))* gp_u32;
DI bf16x8 ld8(const u16* p) { return *((gp_bf16x8)(const void*)p); }
DI unsigned ldg32(const unsigned* p) { return *((gp_u32)(const void*)p); }
typedef unsigned u32x2v __attribute__((ext_vector_type(2)));
DI void stg16(void* p, uint4 v) { *((__attribute__((address_space(1))) u32x4*)p) = u32x4{v.x, v.y, v.z, v.w}; }
DI void stg16f(void* p, f32x4 v) { *((__attribute__((address_space(1))) f32x4*)p) = v; }
DI void stg8(void* p, uint2 v) { *((__attribute__((address_space(1))) u32x2v*)p) = u32x2v{v.x, v.y}; }
DI void stg4(void* p, unsigned v) { *((__attribute__((address_space(1))) unsigned*)p) = v; }
DI void stg2(void* p, u16 v) { *((__attribute__((address_space(1))) u16*)p) = v; }
DI f32x4 ldg4(const float* p) { return *((const __attribute__((address_space(1))) f32x4*)(const void*)p); }
typedef float f32x2v __attribute__((ext_vector_type(2)));
DI float2 ldg2(const float2* p) { const f32x2v v = *((const __attribute__((address_space(1))) f32x2v*)(const void*)p); return make_float2(v[0], v[1]); }
DI f32x4 mfma16(bf16x8 a, bf16x8 b, f32x4 c) { return __builtin_amdgcn_mfma_f32_16x16x32_bf16(a, b, c, 0, 0, 0); }
DI f32x16 mfma32(bf16x8 a, bf16x8 b, f32x16 c) { return __builtin_amdgcn_mfma_f32_32x32x16_bf16(a, b, c, 0, 0, 0); }
template <int M> DI float sx(float v) { return __builtin_bit_cast(float, __builtin_amdgcn_ds_swizzle(__builtin_bit_cast(int, v), (M << 10) | 0x1F)); }
DI float red32_sum(float v) { const int iv = __builtin_bit_cast(int, v); int iw = iv; asm volatile("" : "+v"(iw));
  auto r = __builtin_amdgcn_permlane32_swap(iv, iw, false, false); return __builtin_bit_cast(float, (int)r[0]) + __builtin_bit_cast(float, (int)r[1]); }
DI float red32_max(float v) { const int iv = __builtin_bit_cast(int, v); int iw = iv; asm volatile("" : "+v"(iw));
  auto r = __builtin_amdgcn_permlane32_swap(iv, iw, false, false); return fmaxf(__builtin_bit_cast(float, (int)r[0]), __builtin_bit_cast(float, (int)r[1])); }
DI float wave_sum(float v) { v += sx<1>(v); v += sx<2>(v); v += sx<4>(v); v += sx<8>(v); v += sx<16>(v); return red32_sum(v); }
DI size_t win_off(int layer) { return layer == 0 ? OFF_WIN0 : layer == 1 ? OFF_WIN1 : layer == 2 ? OFF_WIN2 : OFF_WIN3; }

DI int rope_pos(int c) { const int d = c & 63; return d < 16 ? (c & ~15) | (d & 3) | ((d & 4) << 1) | ((d & 8) >> 1) : c; }
DI int map_row(int kind, int c) {
  if (kind == 1) {
    if (c < 1536) return rope_pos(c);
    if (c < 2304) return NMAIN_A + (c - 1536);
    if (c < 2816) return 1792 + rope_pos(c - 2304);
    if (c < 2824) return 2368 + (c - 2816);
    if (c < 2888) return 2304 + (c - 2824);
    return 1536 + (c - 2888);
  }
  if (kind == 3) {
    if (c < 1536) return rope_pos(c);
    if (c < 2304) return NMAIN_BC + (c - 1536);
    return 1536 + (c - 2304);
  }
  if (kind == 2) {
    int isu = c >= DFF; int j = c - isu * DFF;
    return (j >> 7) * 256 + isu * 128 + (j & 127);
  }
  return c;
}

DI void conv_job(const Ctx& cx, const float* __restrict__ src, int Ks, int Ns, u16* __restrict__ dst, int kind, float* tile) {
  const int nnt = (Ns + 63) >> 6, nkt = Ks >> 8, tid = cx.tid;
  for (int t = cx.bid; t < nnt * nkt; t += cx.nb) {
    const int kt = t / nnt, nt = t % nnt;
    const int nn = tid & 63, n = nt * 64 + nn;
    float v[32];
#pragma unroll
    for (int i = 0; i < 32; ++i) { const int kk = i * 8 + (tid >> 6); v[i] = n < Ns ? src[(size_t)(kt * 256 + kk) * Ns + n] : 0.f; }
    __syncthreads();
#pragma unroll
    for (int i = 0; i < 32; ++i) tile[(i * 8 + (tid >> 6)) * 65 + nn] = v[i];
    __syncthreads();
#pragma unroll 4
    for (int i = 0; i < 16; ++i) {
      const int n2 = (tid >> 7) + 4 * i, k2 = tid & 127, nr = nt * 64 + n2;
      if (nr < Ns) {
        const int dr = map_row(kind, nr);
        *reinterpret_cast<unsigned*>(dst + (size_t)dr * Ks + kt * 256 + 2 * k2) = pk2(tile[(2 * k2) * 65 + n2], tile[(2 * k2 + 1) * 65 + n2]);
      }
    }
  }
}

DI void phase0(const Ctx& cx, const Params& p, char* ws, char* smem) {
  float* tile = reinterpret_cast<float*>(smem);
  for (int l = 0; l < DEPTH; ++l) {
    const int kind = l % 3, j = l / 3;
    const float* win = kind == 0 ? p.w_in_a + (size_t)j * 1024 * 3144 : kind == 1 ? p.w_in_b : p.w_in_c;
    conv_job(cx, win, 1024, kind == 0 ? 3144 : 2560, (u16*)(ws + win_off(l)), kind == 0 ? 1 : 3, tile);
    conv_job(cx, p.w_mkv + (size_t)l * 1024 * 512, 1024, 512, (u16*)(ws + OFF_WMKV + l * SZ_WMKV), 0, tile);
    conv_job(cx, p.w_out + (size_t)l * 1024 * 1024, 1024, 1024, (u16*)(ws + OFF_WOUT + l * SZ_WOUT), 0, tile);
    conv_job(cx, p.w_gu + (size_t)l * 1024 * 5632, 1024, 5632, (u16*)(ws + OFF_WGU + l * SZ_WGU), 2, tile);
    conv_job(cx, p.w_dn + (size_t)l * 2816 * 1024, 2816, 1024, (u16*)(ws + OFF_WDN + l * SZ_WDN), 0, tile);
  }
  const int gtid = cx.bid * NTHR + cx.tid, gn = cx.nb * NTHR;
  for (int l = 0; l < DEPTH; l += 3) {
    unsigned* d = reinterpret_cast<unsigned*>(ws + win_off(l) + (size_t)2376 * 1024 * 2);
    for (int i = gtid; i < (NMAIN_A - 2376) * 512; i += gn) d[i] = 0u;
  }
  {
    const float4* xs = reinterpret_cast<const float4*>(p.x);
    uint2* xd = reinterpret_cast<uint2*>(ws + OFF_XB);
    for (int i = gtid; i < T * 256; i += 4 * gn) {
      float4 v[4];
#pragma unroll
      for (int j = 0; j < 4; ++j) v[j] = xs[i + j * gn];
#pragma unroll
      for (int j = 0; j < 4; ++j) xd[i + j * gn] = make_uint2(pk2(v[j].x, v[j].y), pk2(v[j].z, v[j].w));
    }
  }
  {
    float* cs = reinterpret_cast<float*>(ws + OFF_COS); float* sn = reinterpret_cast<float*>(ws + OFF_SIN);
    for (int i = gtid; i < T * 8; i += gn) {
      int t = i >> 3, f = i & 7;
      float ang = (float)p.pos[t] * p.inv_freq[f];
      cs[i] = cosf(ang); sn[i] = sinf(ang);
    }
  }
  {
    const int lane = cx.tid & 63, gw = cx.bid * WPB + __builtin_amdgcn_readfirstlane(cx.tid >> 6), nw = cx.nb * WPB;
    u16* mn = reinterpret_cast<u16*>(ws + OFF_MEMN);
    for (int r = gw; r < NB * NMEM; r += nw) {
      const float4* src = reinterpret_cast<const float4*>(p.mem + (size_t)r * 1024);
      float4 v[4]; float s = 0.f;
      for (int i = 0; i < 4; ++i) { v[i] = src[i * 64 + lane]; s += v[i].x + v[i].y + v[i].z + v[i].w; }
      float mu = wave_sum(s) * (1.f / 1024.f);
      float q = 0.f;
      for (int i = 0; i < 4; ++i) { float a = v[i].x - mu, b = v[i].y - mu, c = v[i].z - mu, d = v[i].w - mu; q += a * a + b * b + c * c + d * d; }
      float rs = rsqrtf(wave_sum(q) * (1.f / 1024.f) + LN_EPS);
      for (int i = 0; i < 4; ++i) {
        int c = (i * 64 + lane) * 4;
        float4 g = *reinterpret_cast<const float4*>(p.mem_g + c), bb = *reinterpret_cast<const float4*>(p.mem_b + c);
        uint2 o = make_uint2(pk2((v[i].x - mu) * rs * g.x + bb.x, (v[i].y - mu) * rs * g.y + bb.y),
                             pk2((v[i].z - mu) * rs * g.z + bb.z, (v[i].w - mu) * rs * g.w + bb.w));
        *reinterpret_cast<uint2*>(mn + (size_t)r * 1024 + c) = o;
      }
    }
  }
}

namespace pg8 {
#define PG8_LAS __attribute__((address_space(3)))
typedef short s16x8 __attribute__((ext_vector_type(8)));
constexpr int BM = 256, BK = 64, HALF = 128, HTB = HALF * BK * 2, STAGE_BYTES = 8 * HTB, NXCD = 8, WGM = 8;
DI int lds_byte(int r, int c) { const int st = (r >> 4) * 2 + (c >> 5), rr = r & 15, cc = c & 31, ob = rr * 64 + cc * 2; return st * 1024 + (ob ^ (((ob >> 9) & 1) << 5)); }
DI void stage_rc(int b, int& R, int& C) { const int st = b / 1024, sb = b % 1024, swz = sb ^ (((sb >> 9) & 1) << 5); R = (st >> 1) * 16 + swz / 64; C = (st & 1) * 32 + (swz % 64) / 2; }
DI int perm32(int rho) { const int n = rho >> 4, i = rho & 15; return 8 * (i >> 2) + 4 * n + (i & 3); }
struct Unit { int pm, pn; };
struct Gemm { const u16* A; const u16* Bt; int M, N, K; };
struct StaticOrder {
  int nM, nN, nwg, G, c;
  DI void init(int M, int N, int G_, int c_) { nM = M / BM; nN = N / BM; nwg = nM * nN; G = G_; c = c_; }
  DI bool next(int i, Unit& u) const {
    const long L = (long)i * G + c; if (L >= nwg) return false;
    int wgid = (int)L; { const int q = nwg / NXCD, r = nwg % NXCD, xcd = wgid % NXCD, off = wgid / NXCD; wgid = (xcd < r ? xcd * (q + 1) : r * (q + 1) + (xcd - r) * q) + off; }
    const int nig = WGM * nN, gid = wgid / nig, fm = gid * WGM, gsz = (nM - fm) < WGM ? (nM - fm) : WGM;
    u.pm = fm + ((wgid % nig) % gsz); u.pn = (wgid % nig) / gsz; return true;
  }
};

template <class Epi>
DI void gemm_phase(int tid, PG8_LAS unsigned char* lds, const Gemm g, const StaticOrder& S, const Epi& E) {
  const int wid = __builtin_amdgcn_readfirstlane(tid >> 6), lane = tid & 63, wr = wid >> 2, wc = wid & 3, fr = lane & 15, fq = lane >> 4;
  const int K = g.K, nt = K / BK;
  unsigned voffA[2], voffB[2];
#pragma unroll
  for (int i = 0; i < 2; ++i) { int R, C; stage_rc(tid * 16 + i * 8192, R, C); const int Rb = Epi::PERM ? ((R & ~31) + perm32(R & 31)) : R;
    voffA[i] = (unsigned)(R * K + C) * 2u; voffB[i] = (unsigned)(Rb * K + C) * 2u; }
  const size_t kstep = (size_t)(BK * 2);
  const size_t hstep = (size_t)HALF * K * 2;
  const size_t tstep = 2 * hstep;
  const unsigned ldsw = (unsigned)wid * 1024u;
  const int aoff = lds_byte(wr * 64 + fr, fq * 8), boff = lds_byte(wc * 32 + fr, fq * 8);
#define PG8_SA(b, h) (((b) * 2 + (h)) * HTB)
#define PG8_SB(b, h) ((4 + (b) * 2 + (h)) * HTB)
#define PG8_STAGE(bufoff, gbase, voff) do { _Pragma("unroll") for (int _i = 0; _i < 2; ++_i) \
    __builtin_amdgcn_global_load_lds((const unsigned*)((const char*)(gbase) + (voff)[_i]), (PG8_LAS unsigned*)(lds + (bufoff) + ldsw + _i * 8192), 16, 0, 0); } while (0)
#define PG8_LDA(dst, b, h) do { _Pragma("unroll") for (int m = 0; m < 4; ++m) _Pragma("unroll") for (int k = 0; k < 2; ++k) dst[m][k] = *(const PG8_LAS s16x8*)(lds + PG8_SA(b, h) + aoff + m * 2048 + k * 1024); } while (0)
#define PG8_LDB(dst, b, h) do { _Pragma("unroll") for (int n = 0; n < 2; ++n) _Pragma("unroll") for (int k = 0; k < 2; ++k) dst[n][k] = *(const PG8_LAS s16x8*)(lds + PG8_SB(b, h) + boff + n * 2048 + k * 1024); } while (0)
#define PG8_MMA(ai, bj, At, Bt) do { __builtin_amdgcn_s_setprio(1); _Pragma("unroll") for (int m = 0; m < 4; ++m) _Pragma("unroll") for (int n = 0; n < 2; ++n) _Pragma("unroll") for (int k = 0; k < 2; ++k) \
    acc[ai][bj][m][n] = __builtin_amdgcn_mfma_f32_16x16x32_bf16(__builtin_bit_cast(bf16x8, Bt[n][k]), __builtin_bit_cast(bf16x8, At[m][k]), acc[ai][bj][m][n], 0, 0, 0); __builtin_amdgcn_s_setprio(0); } while (0)
#define PG8_WAIT_V(n) asm volatile("s_waitcnt vmcnt(" #n ")" ::: "memory")
#define PG8_WAIT_L(n) asm volatile("s_waitcnt lgkmcnt(" #n ")" ::: "memory")
#define PG8_BAR __builtin_amdgcn_s_barrier()
#define PG8_SCHED __builtin_amdgcn_sched_barrier(0)
  Unit cur, nxt; int ui = 0;
  if (!S.next(0, cur)) return;
  f32x4 acc[2][2][4][2];
#pragma unroll
  for (int a = 0; a < 2; ++a)
#pragma unroll
    for (int b = 0; b < 2; ++b)
#pragma unroll
      for (int m = 0; m < 4; ++m)
#pragma unroll
        for (int n = 0; n < 2; ++n) acc[a][b][m][n] = (f32x4){0.f, 0.f, 0.f, 0.f};
  s16x8 At[4][2], B0[2][2], B1[2][2];
  const char* cA = (const char*)g.A + (size_t)cur.pm * tstep; const char* cB = (const char*)g.Bt + (size_t)cur.pn * tstep;
  PG8_STAGE(PG8_SB(0, 0), cB, voffB); PG8_STAGE(PG8_SA(0, 0), cA, voffA); PG8_STAGE(PG8_SB(0, 1), cB + hstep, voffB); PG8_STAGE(PG8_SA(0, 1), cA + hstep, voffA);
  if (wr == 1) PG8_BAR;
  PG8_WAIT_V(4); PG8_BAR;
  PG8_STAGE(PG8_SB(1, 0), cB + kstep, voffB); PG8_STAGE(PG8_SA(1, 0), cA + kstep, voffA); PG8_STAGE(PG8_SB(1, 1), cB + hstep + kstep, voffB);
  PG8_WAIT_V(6); PG8_BAR;
  for (;;) {
    const bool has_next = S.next(ui + 1, nxt);
    const char* nA = has_next ? (const char*)g.A + (size_t)nxt.pm * tstep : cA; const char* nB = has_next ? (const char*)g.Bt + (size_t)nxt.pn * tstep : cB;
    for (int t = 0; t < nt; t += 2) {
      const bool last = (t == nt - 2);
      const char* a1 = cA + (size_t)(t + 1) * kstep;
      const char* a2 = last ? nA : cA + (size_t)(t + 2) * kstep; const char* b2 = last ? nB : cB + (size_t)(t + 2) * kstep;
      const char* a3 = a2 + kstep; const char* b3 = b2 + kstep;
      PG8_LDB(B0, 0, 0); PG8_SCHED; PG8_LDA(At, 0, 0); PG8_STAGE(PG8_SA(1, 1), a1 + hstep, voffA);
      PG8_WAIT_L(8); PG8_BAR; PG8_WAIT_L(0); PG8_MMA(0, 0, At, B0); PG8_BAR; PG8_SCHED;
      PG8_LDB(B1, 0, 1); PG8_STAGE(PG8_SB(0, 0), b2, voffB);
      PG8_BAR; PG8_WAIT_L(0); PG8_MMA(0, 1, At, B1); PG8_BAR;
      PG8_LDA(At, 0, 1); PG8_STAGE(PG8_SA(0, 0), a2, voffA);
      PG8_BAR; PG8_WAIT_L(0); PG8_MMA(1, 0, At, B0); PG8_BAR; PG8_SCHED;
      PG8_STAGE(PG8_SB(0, 1), b2 + hstep, voffB);
      PG8_WAIT_V(6); PG8_BAR; PG8_MMA(1, 1, At, B1); PG8_BAR;
      PG8_LDB(B0, 1, 0); PG8_SCHED; PG8_LDA(At, 1, 0); PG8_STAGE(PG8_SA(0, 1), a2 + hstep, voffA);
      PG8_WAIT_L(8); PG8_BAR; PG8_WAIT_L(0); PG8_MMA(0, 0, At, B0); PG8_BAR; PG8_SCHED;
      PG8_LDB(B1, 1, 1); PG8_STAGE(PG8_SB(1, 0), b3, voffB);
      PG8_BAR; PG8_WAIT_L(0); PG8_MMA(0, 1, At, B1); PG8_BAR;
      PG8_LDA(At, 1, 1); PG8_STAGE(PG8_SA(1, 0), a3, voffA);
      PG8_BAR; PG8_WAIT_L(0); PG8_MMA(1, 0, At, B0); PG8_BAR; PG8_SCHED;
      PG8_STAGE(PG8_SB(1, 1), b3 + hstep, voffB);
      PG8_WAIT_V(6); PG8_BAR; PG8_MMA(1, 1, At, B1); PG8_BAR;
    }
    E(acc, cur, wr, wc, fr, fq);
    if (!has_next) break;
#pragma unroll
    for (int a = 0; a < 2; ++a)
#pragma unroll
      for (int b = 0; b < 2; ++b)
#pragma unroll
        for (int m = 0; m < 4; ++m)
#pragma unroll
          for (int n = 0; n < 2; ++n) acc[a][b][m][n] = (f32x4){0.f, 0.f, 0.f, 0.f};
    cur = nxt; cA = nA; cB = nB; ++ui;
  }
  PG8_WAIT_V(0);
  if (wr == 0) PG8_BAR;
  PG8_BAR;
#undef PG8_SA
#undef PG8_SB
#undef PG8_STAGE
#undef PG8_LDA
#undef PG8_LDB
#undef PG8_MMA
#undef PG8_WAIT_V
#undef PG8_WAIT_L
#undef PG8_BAR
#undef PG8_SCHED
}
}

DI uint4 pack8(const f32x4& a, const f32x4& b) { return make_uint4(pk2(a[0], a[1]), pk2(a[2], a[3]), pk2(b[0], b[1]), pk2(b[2], b[3])); }

struct EpiInProj {
  static constexpr bool PERM = true;
  char* ws; int kind;
  DI void operator()(const f32x4 (&acc)[2][2][4][2], const pg8::Unit& u, int wr, int wc, int fr, int fq) const {
    char* big = ws + OFF_BIG;
    const float* cs = reinterpret_cast<const float*>(ws + OFF_COS);
    const float* sn = reinterpret_cast<const float*>(ws + OFF_SIN);
#pragma unroll
    for (int bj = 0; bj < 2; ++bj) {
      const int c32 = u.pn * 256 + bj * 128 + wc * 32;
      const int dd = (c32 & 63) + 8 * fq;
      if (c32 < 2304) {
        int sel, h;
        if (c32 < 768) { sel = 0; h = c32 >> 6; }
        else if (c32 < 1536) { sel = 1; h = (c32 - 768) >> 6; }
        else if (c32 < 1792) { sel = 2; h = (c32 - 1536) >> 6; }
        else { sel = 3; h = (c32 - 1792) >> 6; }
        const bool rope = sel != 2 && (c32 & 63) == 0 && fq < 2;
        f32x4 rc[2][4], rsn[2][4];
        if (rope) {
#pragma unroll
          for (int ai = 0; ai < 2; ++ai)
#pragma unroll
            for (int m = 0; m < 4; ++m) {
              const int row = u.pm * 256 + ai * 128 + wr * 64 + m * 16 + fr;
              rc[ai][m] = ldg4(cs + row * 8 + 4 * fq); rsn[ai][m] = ldg4(sn + row * 8 + 4 * fq);
            }
        }
#pragma unroll
        for (int ai = 0; ai < 2; ++ai)
#pragma unroll
          for (int m = 0; m < 4; ++m) {
            const int row = u.pm * 256 + ai * 128 + wr * 64 + m * 16 + fr;
            f32x4 a = acc[ai][bj][m][0], b = acc[ai][bj][m][1];
            if (rope) {
              const f32x4 na = a * rc[ai][m] - b * rsn[ai][m], nb = b * rc[ai][m] + a * rsn[ai][m];
              a = na; b = nb;
            }
            const int bb = row >> 12, s_ = row & 4095;
            size_t off;
            if (sel == 0) off = BO_Q + (((size_t)(bb * 12 + h) * S + s_) * 64 + dd) * 2;
            else if (sel == 1) off = BO_K + (((size_t)(bb * 12 + h) * S + s_) * 64 + dd) * 2;
            else if (sel == 2) off = (kind == 1 ? BO_QM_B : BO_QM_AC) + (((size_t)(bb * 4 + h) * S + s_) * 64 + dd) * 2;
            else off = BO_QI + (((size_t)row * 8 + h) * 64 + dd) * 2;
            stg16(big + off, pack8(a, b));
          }
      } else if (c32 < 2368) {
#pragma unroll
        for (int ai = 0; ai < 2; ++ai)
#pragma unroll
          for (int m = 0; m < 4; ++m) {
            const int row = u.pm * 256 + ai * 128 + wr * 64 + m * 16 + fr;
            float* dst = reinterpret_cast<float*>(big + BO_KIRAW) + (size_t)row * 64 + (c32 - 2304) + 8 * fq;
            stg16f(dst, acc[ai][bj][m][0]);
            stg16f(dst + 4, acc[ai][bj][m][1]);
          }
      } else if (c32 < 2400) {
        if (fq == 0) {
#pragma unroll
          for (int ai = 0; ai < 2; ++ai)
#pragma unroll
            for (int m = 0; m < 4; ++m) {
              const int row = u.pm * 256 + ai * 128 + wr * 64 + m * 16 + fr;
              float* dst = reinterpret_cast<float*>(big + BO_WI) + (size_t)row * 8;
              stg16f(dst, acc[ai][bj][m][0] * 0.04419417382415922f);
              stg16f(dst + 4, acc[ai][bj][m][1] * 0.04419417382415922f);
            }
        }
      }
    }
  }
};

struct EpiVt {
  static constexpr bool PERM = true;
  char* ws; int kind;
  DI void operator()(const f32x4 (&acc)[2][2][4][2], const pg8::Unit& u, int wr, int wc, int fr, int fq) const {
    char* big = ws + OFF_BIG;
#pragma unroll
    for (int ai = 0; ai < 2; ++ai)
#pragma unroll
      for (int m = 0; m < 4; ++m) {
        const int cv = u.pm * 256 + ai * 128 + wr * 64 + m * 16 + fr;
#pragma unroll
        for (int bj = 0; bj < 2; ++bj) {
          const int tok0 = u.pn * 256 + bj * 128 + wc * 32 + 8 * fq;
          const int bb = tok0 >> 12, s0 = tok0 & 4095;
          const f32x4 a = acc[ai][bj][m][0], b = acc[ai][bj][m][1];
          if (kind != 1) {
            const int h = cv >> 6, d = cv & 63;
            u16* vt = reinterpret_cast<u16*>(big + BO_V) + ((size_t)(bb * 12 + h) * 128 + (s0 >> 5)) * 2048 + d * 32 + (s0 & 31);
            stg16(vt, pack8(a, b));
          } else {
            const int hh = cv / 192, dv = cv % 192;
            u16* v0 = reinterpret_cast<u16*>(big + BO_V) + ((size_t)(bb * 4 + hh) * 128 + (s0 >> 5)) * 6144 + dv * 32 + (s0 & 31);
            stg16(v0, pack8(a, b));
            const int j4 = s0 >> 2, j16 = s0 >> 4, r0 = s0 & 15;
            u16* v1 = reinterpret_cast<u16*>(big + BO_V + SZ_QKV) + (((size_t)(bb * 4 + hh) * 4) * 32 + (j4 >> 5)) * 6144 + dv * 32 + (j4 & 31);
            u16* v2 = reinterpret_cast<u16*>(big + BO_V + 2 * SZ_QKV) + (((size_t)(bb * 4 + hh) * 16 + r0) * 8 + (j16 >> 5)) * 6144 + dv * 32 + (j16 & 31);
#pragma unroll
            for (int r = 0; r < 4; ++r) stg4(v1 + (size_t)r * 32 * 6144, pk2(a[r], b[r]));
#pragma unroll
            for (int i = 0; i < 4; ++i) { stg2(v2 + (size_t)i * 8 * 6144, f2bf(a[i])); stg2(v2 + (size_t)(i + 4) * 8 * 6144, f2bf(b[i])); }
          }
        }
      }
  }
};

struct EpiMemKV {
  static constexpr bool PERM = true;
  char* ws;
  DI void operator()(const f32x4 (&acc)[2][2][4][2], const pg8::Unit& u, int wr, int wc, int fr, int fq) const {
#pragma unroll
    for (int bj = 0; bj < 2; ++bj) {
      const int c32 = u.pn * 256 + bj * 128 + wc * 32;
      const int layer = c32 >> 9, c = c32 & 511;
      const int h = (c & 255) >> 6, dd = (c & 63) + 8 * fq;
      u16* mk = reinterpret_cast<u16*>(ws + OFF_MK + layer * SZ_MK);
      u16* mvt = reinterpret_cast<u16*>(ws + OFF_MVT + layer * SZ_MK);
#pragma unroll
      for (int ai = 0; ai < 2; ++ai)
#pragma unroll
        for (int m = 0; m < 4; ++m) {
          const int row = u.pm * 256 + ai * 128 + wr * 64 + m * 16 + fr;
          const int bb = row >> 8, n = row & 255;
          const f32x4 a = acc[ai][bj][m][0], b = acc[ai][bj][m][1];
          if (c < 256) {
            stg16(mk + ((size_t)(bb * 4 + h) * 256 + n) * 64 + dd, pack8(a, b));
          } else {
            u16* vt = mvt + ((size_t)(bb * 4 + h) * 8 + (n >> 5)) * 2048 + dd * 32 + (n & 31);
#pragma unroll
            for (int i = 0; i < 4; ++i) { stg2(vt + i * 32, f2bf(a[i])); stg2(vt + (i + 4) * 32, f2bf(b[i])); }
          }
        }
    }
  }
};

struct EpiResid {
  static constexpr bool PERM = false;
  const float* xsrc; float* out; const float2* stat; const float* g; const float* b;
  DI void operator()(const f32x4 (&acc)[2][2][4][2], const pg8::Unit& u, int wr, int wc, int fr, int fq) const {
    const int col0 = u.pn * 256 + wc * 32 + 4 * fq;
    f32x4 gg[2][2], bb[2][2];
    if (stat) {
#pragma unroll
      for (int bj = 0; bj < 2; ++bj)
#pragma unroll
        for (int n = 0; n < 2; ++n) { gg[bj][n] = ldg4(g + col0 + bj * 128 + n * 16); bb[bj][n] = ldg4(b + col0 + bj * 128 + n * 16); }
    }
#pragma unroll
    for (int h4 = 0; h4 < 4; ++h4) {
      const int ai = h4 >> 1, m0 = (h4 & 1) * 2;
      f32x4 xv[2][2][2]; float2 st[2];
#pragma unroll
      for (int mm = 0; mm < 2; ++mm) {
        const int row = u.pm * 256 + ai * 128 + wr * 64 + (m0 + mm) * 16 + fr;
        st[mm] = stat ? ldg2(stat + row) : make_float2(0.f, 1.f);
#pragma unroll
        for (int bj = 0; bj < 2; ++bj)
#pragma unroll
          for (int n = 0; n < 2; ++n) xv[mm][bj][n] = ldg4(xsrc + (size_t)row * 1024 + col0 + bj * 128 + n * 16);
      }
#pragma unroll
      for (int mm = 0; mm < 2; ++mm) {
        const int row = u.pm * 256 + ai * 128 + wr * 64 + (m0 + mm) * 16 + fr;
#pragma unroll
        for (int bj = 0; bj < 2; ++bj)
#pragma unroll
          for (int n = 0; n < 2; ++n) {
            f32x4 x = xv[mm][bj][n];
            if (stat) x = (x - st[mm].x) * st[mm].y * gg[bj][n] + bb[bj][n];
            stg16f(out + (size_t)row * 1024 + col0 + bj * 128 + n * 16, x * ALPHA + acc[ai][bj][m0 + mm][n]);
          }
      }
    }
  }
};

struct EpiSwiGLU {
  static constexpr bool PERM = true;
  u16* h;
  DI void operator()(const f32x4 (&acc)[2][2][4][2], const pg8::Unit& u, int wr, int wc, int fr, int fq) const {
    const int j0 = u.pn * 128 + wc * 32 + 8 * fq;
#pragma unroll
    for (int ai = 0; ai < 2; ++ai)
#pragma unroll
      for (int m = 0; m < 4; ++m) {
        const int row = u.pm * 256 + ai * 128 + wr * 64 + m * 16 + fr;
        f32x4 o[2];
#pragma unroll
        for (int n = 0; n < 2; ++n)
#pragma unroll
          for (int i = 0; i < 4; ++i) { const float g = acc[ai][0][m][n][i], uu = acc[ai][1][m][n][i]; o[n][i] = g * __builtin_amdgcn_rcpf(1.f + __expf(-g)) * uu; }
        stg16(h + (size_t)row * DFF + j0, pack8(o[0], o[1]));
      }
  }
};

DI void ln_phase(const Ctx& cx, float* xio, const float* __restrict__ g, const float* __restrict__ b, u16* xb, float2* stat, bool write_f32) {
  const int lane = cx.tid & 63, gw = cx.bid * WPB + __builtin_amdgcn_readfirstlane(cx.tid >> 6), nw = cx.nb * WPB;
  float4 gg[4], bb[4];
  for (int i = 0; i < 4; ++i) { gg[i] = *reinterpret_cast<const float4*>(g + (i * 64 + lane) * 4); bb[i] = *reinterpret_cast<const float4*>(b + (i * 64 + lane) * 4); }
  constexpr int RB = 4;
  for (int r0 = gw * RB; r0 < T; r0 += nw * RB) {
    float4 v[RB][4]; float s[RB], q[RB];
#pragma unroll
    for (int k = 0; k < RB; ++k) {
      const float4* row = reinterpret_cast<const float4*>(xio + (size_t)(r0 + k) * 1024);
      s[k] = 0.f;
#pragma unroll
      for (int i = 0; i < 4; ++i) { v[k][i] = row[i * 64 + lane]; s[k] += v[k][i].x + v[k][i].y + v[k][i].z + v[k][i].w; }
    }
#pragma unroll
    for (int k = 0; k < RB; ++k) s[k] = wave_sum(s[k]) * (1.f / 1024.f);
#pragma unroll
    for (int k = 0; k < RB; ++k) {
      q[k] = 0.f;
#pragma unroll
      for (int i = 0; i < 4; ++i) { float a = v[k][i].x - s[k], b2 = v[k][i].y - s[k], c = v[k][i].z - s[k], d = v[k][i].w - s[k]; q[k] += a * a + b2 * b2 + c * c + d * d; }
    }
#pragma unroll
    for (int k = 0; k < RB; ++k) q[k] = rsqrtf(wave_sum(q[k]) * (1.f / 1024.f) + LN_EPS);
    if (lane < RB) { float2 sv; sv.x = lane == 0 ? s[0] : lane == 1 ? s[1] : lane == 2 ? s[2] : s[3]; sv.y = lane == 0 ? q[0] : lane == 1 ? q[1] : lane == 2 ? q[2] : q[3]; stat[r0 + lane] = sv; }
#pragma unroll
    for (int k = 0; k < RB; ++k) {
      float4* row = reinterpret_cast<float4*>(xio + (size_t)(r0 + k) * 1024);
#pragma unroll
      for (int i = 0; i < 4; ++i) {
        float4 o;
        o.x = (v[k][i].x - s[k]) * q[k] * gg[i].x + bb[i].x; o.y = (v[k][i].y - s[k]) * q[k] * gg[i].y + bb[i].y;
        o.z = (v[k][i].z - s[k]) * q[k] * gg[i].z + bb[i].z; o.w = (v[k][i].w - s[k]) * q[k] * gg[i].w + bb[i].w;
        if (write_f32) row[i * 64 + lane] = o;
        *reinterpret_cast<uint2*>(xb + (size_t)(r0 + k) * 1024 + (i * 64 + lane) * 4) = make_uint2(pk2(o.x, o.y), pk2(o.z, o.w));
      }
    }
  }
}

template <int NDT> struct AttState { f32x16 o[NDT]; float m, l; };
template <int NDT> DI void att_init(AttState<NDT>& st) {
#pragma unroll
  for (int d = 0; d < NDT; ++d)
#pragma unroll
    for (int r = 0; r < 16; ++r) st.o[d][r] = 0.f;
  st.m = -1e30f; st.l = 0.f;
}
DI int pi_swap(int i) { return (i & 0x13) | ((i & 4) << 1) | ((i & 8) >> 1); }

template <int NDT> struct Frags { bf16x8 k[4]; bf16x8 v[NDT == 2 ? 4 : 1]; unsigned w; };
template <int NDT> DI void att_load(Frags<NDT>& f, const u16* krow, const u16* vt) {
#pragma unroll
  for (int c = 0; c < 4; ++c) f.k[c] = ld8(krow + c * 16);
  if (NDT == 2) {
#pragma unroll
    for (int d = 0; d < 2; ++d)
#pragma unroll
      for (int c = 0; c < 2; ++c) f.v[d * 2 + c] = ld8(vt + d * 1024 + c * 16);
  }
}
template <int NDT, class MaskP>
DI void att_compute(AttState<NDT>& st, const bf16x8 (&qf)[4], const Frags<NDT>& f, const u16* vt, const MaskP& maskp) {
  constexpr float CS = 0.18033688011112042f;
  f32x16 s;
#pragma unroll
  for (int r = 0; r < 16; ++r) s[r] = 0.f;
#pragma unroll
  for (int c = 0; c < 4; ++c) s = mfma32(f.k[c], qf[c], s);
  float mx = fmaxf(fmaxf(s[0], s[1]), s[2]);
#pragma unroll
  for (int r = 3; r < 15; r += 2) mx = fmaxf(fmaxf(mx, s[r]), s[r + 1]);
  mx = fmaxf(mx, s[15]);
  mx = red32_max(mx);
  constexpr float DEFER = 8.0f / CS;
  const bool upd = mx > st.m + DEFER;
  if (__any(upd)) {
    const float mnew = upd ? mx : st.m;
    const float alpha = __builtin_amdgcn_exp2f((st.m - mnew) * CS);
    st.l *= alpha; st.m = mnew;
#pragma unroll
    for (int d = 0; d < NDT; ++d)
#pragma unroll
      for (int r = 0; r < 16; ++r) st.o[d][r] *= alpha;
  }
  const float nb = -st.m * CS;
  float ps = 0.f;
#pragma unroll
  for (int r = 0; r < 16; ++r) { s[r] = maskp(r, __builtin_amdgcn_exp2f(fmaf(s[r], CS, nb))); ps += s[r]; }
  st.l += ps;
  bf16x8 pf[2];
#pragma unroll
  for (int c = 0; c < 2; ++c) {
    u32x4 t;
#pragma unroll
    for (int j = 0; j < 4; ++j) t[j] = pk2(s[8 * c + 2 * j], s[8 * c + 2 * j + 1]);
    pf[c] = __builtin_bit_cast(bf16x8, t);
  }
  if (NDT == 2) {
#pragma unroll
    for (int d = 0; d < 2; ++d)
#pragma unroll
      for (int c = 0; c < 2; ++c) st.o[d] = mfma32(f.v[d * 2 + c], pf[c], st.o[d]);
  } else {
    __builtin_amdgcn_sched_barrier(0);
#pragma unroll
    for (int d = 0; d < NDT; ++d) {
      if (d > 0 && (d & 1) == 0) __builtin_amdgcn_sched_barrier(0);
#pragma unroll
      for (int c = 0; c < 2; ++c) st.o[d] = mfma32(ld8(vt + d * 1024 + c * 16), pf[c], st.o[d]);
    }
  }
}
DI float mask_bit(unsigned w, int bit, float p) { int m; asm("v_bfe_i32 %0, %1, %2, 1" : "=v"(m) : "v"(w), "n"(bit)); return __uint_as_float(__float_as_uint(p) & (unsigned)m); }
template <int NDT, class KP, class VP, class WP, class MK>
DI void att_range(AttState<NDT>& st, const bf16x8 (&qf)[4], int k0, int k1, const KP& kp, const VP& vp, const WP& wp, const MK& mk) {
  if (NDT == 2) {
    Frags<NDT> f0, f1, f2;
    att_load<NDT>(f0, kp(k0), vp(k0)); f0.w = wp(k0);
    f1 = f0; f2 = f0;
    if (k0 + 1 <= k1) { att_load<NDT>(f1, kp(k0 + 1), vp(k0 + 1)); f1.w = wp(k0 + 1); }
#pragma unroll 1
    for (int kt = k0; kt <= k1; kt += 3) {
      if (kt + 2 <= k1) { att_load<NDT>(f2, kp(kt + 2), vp(kt + 2)); f2.w = wp(kt + 2); }
      att_compute<NDT>(st, qf, f0, vp(kt), mk(kt, f0.w));
      if (kt + 1 > k1) break;
      if (kt + 3 <= k1) { att_load<NDT>(f0, kp(kt + 3), vp(kt + 3)); f0.w = wp(kt + 3); }
      att_compute<NDT>(st, qf, f1, vp(kt + 1), mk(kt + 1, f1.w));
      if (kt + 2 > k1) break;
      if (kt + 4 <= k1) { att_load<NDT>(f1, kp(kt + 4), vp(kt + 4)); f1.w = wp(kt + 4); }
      att_compute<NDT>(st, qf, f2, vp(kt + 2), mk(kt + 2, f2.w));
    }
  } else {
    Frags<NDT> cur;
    att_load<NDT>(cur, kp(k0), vp(k0)); cur.w = wp(k0);
#pragma unroll 1
    for (int kt = k0; kt <= k1; ++kt) {
      Frags<NDT> nxt = cur;
      if (kt < k1) { att_load<NDT>(nxt, kp(kt + 1), vp(kt + 1)); nxt.w = wp(kt + 1); }
      att_compute<NDT>(st, qf, cur, vp(kt), mk(kt, cur.w));
      cur = nxt;
    }
  }
}

template <int NDT> DI void att_store(AttState<NDT>& st, u16* orow, int hf) {
  const float lt = red32_sum(st.l);
  const float inv = 1.f / lt;
#pragma unroll
  for (int d = 0; d < NDT; ++d)
#pragma unroll
    for (int g = 0; g < 4; ++g) {
      uint2 v = make_uint2(pk2(st.o[d][4 * g] * inv, st.o[d][4 * g + 1] * inv), pk2(st.o[d][4 * g + 2] * inv, st.o[d][4 * g + 3] * inv));
      *reinterpret_cast<uint2*>(orow + d * 32 + 8 * g + 4 * hf) = v;
    }
}

DI void load_q(bf16x8 (&qf)[4], const u16* qrow, int hf) {
#pragma unroll
  for (int c = 0; c < 4; ++c) qf[c] = ld8(qrow + c * 16 + 8 * hf);
}

DI void mem_att_unit(char* ws, int layer, int kind, int u, int lane) {
  const int qt = u & 127, bh = u >> 7, b = bh >> 2, hm = bh & 3;
  const int ql = lane & 31, hf = lane >> 5, tq = qt * 32 + ql;
  const u16* QM = reinterpret_cast<const u16*>(ws + OFF_BIG + (kind == 1 ? BO_QM_B : BO_QM_AC));
  const u16* MK = reinterpret_cast<const u16*>(ws + OFF_MK + layer * SZ_MK);
  const u16* MVT = reinterpret_cast<const u16*>(ws + OFF_MVT + layer * SZ_MK);
  bf16x8 qf[4]; load_q(qf, QM + ((size_t)bh * S + tq) * 64, hf);
  AttState<2> st; att_init(st);
  const int pk = pi_swap(ql);
  const u16* kb = MK + ((size_t)bh * 256 + pk) * 64 + 8 * hf;
  const u16* vb = MVT + ((size_t)bh * 8) * 2048 + ql * 32 + 8 * hf;
  int klast = 7; asm volatile("" : "+s"(klast));
  att_range<2>(st, qf, 0, klast,
               [kb](int kt) { return kb + kt * 2048; }, [vb](int kt) { return vb + kt * 2048; },
               [](int) { return 0u; }, [](int, unsigned) { return [](int, float p) { return p; }; });
  u16* mix = reinterpret_cast<u16*>(ws + OFF_MIX);
  att_store<2>(st, mix + (size_t)(b * S + tq) * 1024 + 768 + hm * 64, hf);
}

DI void dsa_att_unit(char* ws, int bh, int qt, int lane) {
  const int b = bh / 12, h = bh % 12;
  const int ql = lane & 31, hf = lane >> 5, tq = qt * 32 + ql;
  char* big = ws + OFF_BIG;
  const u16* Q = reinterpret_cast<const u16*>(big + BO_Q);
  const u16* K = reinterpret_cast<const u16*>(big + BO_K);
  const u16* VT = reinterpret_cast<const u16*>(big + BO_V);
  const unsigned* BM = reinterpret_cast<const unsigned*>(big + BO_BM) + (size_t)(b * S + tq) * 128;
  bf16x8 qf[4]; load_q(qf, Q + ((size_t)bh * S + tq) * 64, hf);
  AttState<2> st; att_init(st);
  const int pk = pi_swap(ql);
  const u16* kb = K + ((size_t)bh * S + pk) * 64 + 8 * hf;
  const u16* vb = VT + ((size_t)bh * 128) * 2048 + ql * 32 + 8 * hf;
  const int sh = 8 * hf;
  att_range<2>(st, qf, 0, qt,
               [kb](int kt) { return kb + kt * 2048; }, [vb](int kt) { return vb + kt * 2048; },
               [BM](int kt) { return ldg32(BM + kt); },
               [sh](int, unsigned w) { const unsigned ws_ = w >> sh; return [ws_](int r, float p) { return mask_bit(ws_, 16 * (r >> 3) + (r & 7), p); }; });
  u16* mix = reinterpret_cast<u16*>(ws + OFF_MIX);
  att_store<2>(st, mix + (size_t)(b * S + tq) * 1024 + h * 64, hf);
}

DI void moba_att_unit(char* ws, int bh, int qt, int lane) {
  const int b = bh / 12, h = bh % 12;
  const int ql = lane & 31, hf = lane >> 5, tq = qt * 32 + ql;
  char* big = ws + OFF_BIG;
  const u16* Q = reinterpret_cast<const u16*>(big + BO_Q);
  const u16* K = reinterpret_cast<const u16*>(big + BO_K);
  const u16* VT = reinterpret_cast<const u16*>(big + BO_V);
  const float* KM = reinterpret_cast<const float*>(ws + OFF_KMEAN) + (size_t)bh * 16 * 64;
  const u16* qrow = Q + ((size_t)bh * S + tq) * 64;
  bf16x8 qf[4]; load_q(qf, qrow, hf);
  const int own = qt >> 3;
  unsigned selmask = 0u;
  {
    float b0 = -3e38f, b1 = -3e38f, b2 = -3e38f; int i0 = -1, i1 = -1, i2 = -1;
    for (int n = 0; n < own; ++n) {
      float g = 0.f;
      for (int d8 = 0; d8 < 8; ++d8) {
        const u32x4 qq = *reinterpret_cast<const u32x4*>(qrow + d8 * 8);
        const float4 ka = *reinterpret_cast<const float4*>(KM + n * 64 + d8 * 8);
        const float4 kb = *reinterpret_cast<const float4*>(KM + n * 64 + d8 * 8 + 4);
        g += __uint_as_float(qq[0] << 16) * ka.x + __uint_as_float(qq[0] & 0xffff0000u) * ka.y
           + __uint_as_float(qq[1] << 16) * ka.z + __uint_as_float(qq[1] & 0xffff0000u) * ka.w
           + __uint_as_float(qq[2] << 16) * kb.x + __uint_as_float(qq[2] & 0xffff0000u) * kb.y
           + __uint_as_float(qq[3] << 16) * kb.z + __uint_as_float(qq[3] & 0xffff0000u) * kb.w;
      }
      if (g > b0) { b2 = b1; i2 = i1; b1 = b0; i1 = i0; b0 = g; i0 = n; }
      else if (g > b1) { b2 = b1; i2 = i1; b1 = g; i1 = n; }
      else if (g > b2) { b2 = g; i2 = n; }
    }
    if (i0 >= 0) selmask |= 1u << i0;
    if (i1 >= 0) selmask |= 1u << i1;
    if (i2 >= 0) selmask |= 1u << i2;
  }
  AttState<2> st; att_init(st);
  const int pk = pi_swap(ql);
  const u16* kb = K + ((size_t)bh * S + pk) * 64 + 8 * hf;
  const u16* vb = VT + ((size_t)bh * 128) * 2048 + ql * 32 + 8 * hf;
  for (int n = 0; n < own; ++n) {
    const unsigned minew = ((selmask >> n) & 1u) ? 0xffffffffu : 0u;
    if (!__any(minew != 0u)) continue;
    att_range<2>(st, qf, n * 8, n * 8 + 7,
                 [kb](int kt) { return kb + kt * 2048; }, [vb](int kt) { return vb + kt * 2048; },
                 [minew](int) { return minew; }, [](int, unsigned w) { return [w](int, float p) { return w != 0u ? p : 0.f; }; });
  }
  att_range<2>(st, qf, own * 8, qt,
               [kb](int kt) { return kb + kt * 2048; }, [vb](int kt) { return vb + kt * 2048; },
               [](int) { return 0u; },
               [hf, tq](int kt, unsigned) { const int dq = tq - (kt * 32 + 8 * hf); return [dq](int r, float p) { return 16 * (r >> 3) + (r & 7) <= dq ? p : 0.f; }; });
  u16* mix = reinterpret_cast<u16*>(ws + OFF_MIX);
  att_store<2>(st, mix + (size_t)(b * S + tq) * 1024 + h * 64, hf);
}

template <bool DSA>
DI void blk_att_unit(char* ws, char* smem, int wid, int lane, int bh, int Qb) {
  typedef __attribute__((address_space(3))) unsigned char* lds_p;
  typedef __attribute__((address_space(3))) unsigned* lds_u32p;
  constexpr int D = 6, R = 8, SLOT = 10240;
  lds_p lds = (lds_p)smem;
  const int b = bh / 12, h = bh % 12;
  const int ql = lane & 31, hf = lane >> 5, qt = Qb * 8 + wid, tq = qt * 32 + ql, nkt = Qb * 8 + 8;
  char* big = ws + OFF_BIG;
  const u16* Q = reinterpret_cast<const u16*>(big + BO_Q);
  const u16* K = reinterpret_cast<const u16*>(big + BO_K);
  const u16* VT = reinterpret_cast<const u16*>(big + BO_V);
  const u16* qrow = Q + ((size_t)bh * S + tq) * 64;
  bf16x8 qf[4]; load_q(qf, qrow, hf);
  unsigned selmask = 0u;
  if (!DSA) {
    const u16* KMB = reinterpret_cast<const u16*>(ws + OFF_KMEANB) + (size_t)bh * 16 * 64 + 8 * hf;
    f32x16 ga, gb;
#pragma unroll
    for (int r = 0; r < 16; ++r) { ga[r] = 0.f; gb[r] = 0.f; }
#pragma unroll
    for (int c = 0; c < 4; ++c) {
      ga = mfma32(ld8(KMB + (ql & 15) * 64 + c * 16), qf[c], ga);
      gb = mfma32(ld8(KMB + ((ql & 15) ^ 4) * 64 + c * 16), qf[c], gb);
    }
    float b0 = -3e38f, b1 = -3e38f, b2 = -3e38f; int i0 = -1, i1 = -1, i2 = -1;
#pragma unroll
    for (int r = 0; r < 8; ++r) {
#pragma unroll
      for (int t = 0; t < 2; ++t) {
        const int n = ((r & 3) + 8 * (r >> 2) + 4 * hf) ^ (4 * t);
        const float g = (n < Qb) ? (t == 0 ? ga[r] : gb[r]) : -3e38f;
        const bool c0 = g > b0, c1 = g > b1, c2 = g > b2;
        const float nb2 = c1 ? b1 : (c2 ? g : b2); const int ni2 = c1 ? i1 : (c2 ? n : i2);
        const float nb1 = c0 ? b0 : (c1 ? g : b1); const int ni1 = c0 ? i0 : (c1 ? n : i1);
        const float nb0 = c0 ? g : b0;             const int ni0 = c0 ? n : i0;
        b0 = nb0; b1 = nb1; b2 = nb2; i0 = ni0; i1 = ni1; i2 = ni2;
      }
    }
    if (b0 > -1e38f) selmask |= 1u << i0;
    if (b1 > -1e38f) selmask |= 1u << i1;
    if (b2 > -1e38f) selmask |= 1u << i2;
  }
  const char* src;
  {
    const int p = (wid & 3) * 64 + lane;
    if (wid < 4) { const int r = p >> 3, lc = (p & 7) ^ ((r >> 1) & 7); src = reinterpret_cast<const char*>(K + ((size_t)bh * S + r) * 64 + lc * 8); }
    else { const int d = p >> 2, lc = (p & 3) ^ ((d >> 2) & 3); src = reinterpret_cast<const char*>(VT + (size_t)bh * 128 * 2048 + d * 32 + lc * 8); }
  }
  const char* msrc = big + BO_BM + ((size_t)(b * S + Qb * 256 + ((wid & 3) * 64 + lane)) * 128) * 4;
  const unsigned ldsw = (unsigned)wid * 1024u, ldsm = 8192u + (unsigned)wid * 256u;
#define BA_ISSUE(kt_) do { const unsigned _sb = (unsigned)(((kt_) & (R - 1)) * SLOT); \
    __builtin_amdgcn_global_load_lds((const unsigned*)(src + (size_t)(kt_) * 4096), (lds_u32p)(lds + _sb + ldsw), 16, 0, 0); \
    if (DSA) __builtin_amdgcn_global_load_lds((const unsigned*)(msrc + (size_t)(kt_) * 4), (lds_u32p)(lds + _sb + ldsm), 4, 0, 0); } while (0)
#define BA_WAIT(n) asm volatile("s_waitcnt vmcnt(" #n ")" ::: "memory")
  int koff[4], voff[4];
  {
    const int kr = pi_swap(ql);
#pragma unroll
    for (int c = 0; c < 4; ++c) koff[c] = kr * 128 + (((2 * c + hf) ^ ((kr >> 1) & 7)) << 4);
#pragma unroll
    for (int dt = 0; dt < 2; ++dt)
#pragma unroll
      for (int c = 0; c < 2; ++c) { const int d = dt * 32 + ql; voff[dt * 2 + c] = 4096 + d * 64 + (((2 * c + hf) ^ ((d >> 2) & 3)) << 4); }
  }
  const int moff = 8192 + (wid * 32 + ql) * 4;
  AttState<2> st; att_init(st);
  asm volatile("" :: "v"(qf[0]), "v"(qf[1]), "v"(qf[2]), "v"(qf[3]));
  __builtin_amdgcn_s_barrier();
#pragma unroll
  for (int i = 0; i < D; ++i) BA_ISSUE(i);
  for (int kt = 0; kt < nkt; ++kt) {
    if (kt + D < nkt) BA_ISSUE(kt + D);
    int rem = nkt - 1 - kt; rem = rem > D ? D : rem;
    if (DSA) {
      switch (rem) { case 6: BA_WAIT(12); break; case 5: BA_WAIT(10); break; case 4: BA_WAIT(8); break; case 3: BA_WAIT(6); break;
                     case 2: BA_WAIT(4); break; case 1: BA_WAIT(2); break; default: BA_WAIT(0); break; }
    } else {
      switch (rem) { case 6: BA_WAIT(6); break; case 5: BA_WAIT(5); break; case 4: BA_WAIT(4); break; case 3: BA_WAIT(3); break;
                     case 2: BA_WAIT(2); break; case 1: BA_WAIT(1); break; default: BA_WAIT(0); break; }
    }
    __builtin_amdgcn_s_barrier();
    if (kt > qt) continue;
    unsigned wmask = 0xffffffffu;
    if (!DSA && kt < Qb * 8) {
      wmask = ((selmask >> (kt >> 3)) & 1u) ? 0xffffffffu : 0u;
      if (!__any(wmask != 0u)) continue;
    }
    lds_p img = lds + (kt & (R - 1)) * SLOT;
    Frags<2> f;
#pragma unroll
    for (int c = 0; c < 4; ++c) f.k[c] = *(const __attribute__((address_space(3))) bf16x8*)(img + koff[c]);
#pragma unroll
    for (int c = 0; c < 4; ++c) f.v[c] = *(const __attribute__((address_space(3))) bf16x8*)(img + voff[c]);
    if (DSA) {
      const unsigned w_ = (*(const __attribute__((address_space(3))) unsigned*)(img + moff)) >> (8 * hf);
      att_compute<2>(st, qf, f, nullptr, [w_](int r, float p) { return mask_bit(w_, 16 * (r >> 3) + (r & 7), p); });
    } else if (kt < Qb * 8) {
      att_compute<2>(st, qf, f, nullptr, [wmask](int, float p) { return wmask != 0u ? p : 0.f; });
    } else {
      const int dq = tq - (kt * 32 + 8 * hf);
      att_compute<2>(st, qf, f, nullptr, [dq](int r, float p) { return 16 * (r >> 3) + (r & 7) <= dq ? p : 0.f; });
    }
  }
#undef BA_ISSUE
#undef BA_WAIT
  u16* mix = reinterpret_cast<u16*>(ws + OFF_MIX);
  att_store<2>(st, mix + (size_t)(b * S + tq) * 1024 + h * 64, hf);
}

DI void dil_att_unit(char* ws, int u, int lane) {
  const int r16 = u & 15, T0 = (u >> 4) & 7, bhh = u >> 7, b = bhh >> 2, hh = bhh & 3;
  const int ql = lane & 31, hf = lane >> 5;
  const int tq = T0 * 512 + 16 * ql + r16;
  char* big = ws + OFF_BIG;
  const u16* Q = reinterpret_cast<const u16*>(big + BO_Q);
  const u16* K = reinterpret_cast<const u16*>(big + BO_K);
  AttState<6> st; att_init(st);
  const int pk = pi_swap(ql);
  for (int g = 0; g < 3; ++g) {
    const int sh = 2 * g, dil = 1 << sh, r = r16 & (dil - 1);
    const int bh = b * 12 + 4 * g + hh;
    bf16x8 qf[4];
    load_q(qf, Q + ((size_t)bh * S + tq) * 64, hf);
    const int jq = tq >> sh;
    const int jmin = (T0 * 512 + r16) >> sh, jmax = (T0 * 512 + 496 + r16) >> sh;
    int k0 = jmin - 128; k0 = k0 < 0 ? 0 : k0 >> 5;
    const u16* Vg = reinterpret_cast<const u16*>(big + BO_V + (size_t)g * SZ_QKV) + ((size_t)(bhh * dil + r) * (128 >> sh)) * 6144 + ql * 32 + 8 * hf;
    const u16* Kg = K + ((size_t)bh * S + r) * 64 + 8 * hf;
    att_range<6>(st, qf, k0, jmax >> 5,
                 [Kg, pk, sh](int jt) { return Kg + ((size_t)((jt * 32 + pk) << sh)) * 64; },
                 [Vg](int jt) { return Vg + (size_t)jt * 6144; },
                 [](int) { return 0u; },
                 [hf, jq](int jt, unsigned) { const int dq = jq - (jt * 32 + 8 * hf); return [dq](int rr, float p) { return (unsigned)(dq - (16 * (rr >> 3) + (rr & 7))) <= 128u ? p : 0.f; }; });
  }
  u16* mix = reinterpret_cast<u16*>(ws + OFF_MIX);
  att_store<6>(st, mix + (size_t)(b * S + tq) * 1024 + hh * 192, hf);
}

DI void ki_prep_phase(const Ctx& cx, char* ws, const float* g, const float* bta) {
  const int lane = cx.tid & 63, gw = cx.bid * WPB + __builtin_amdgcn_readfirstlane(cx.tid >> 6), nw = cx.nb * WPB;
  const float* raw = reinterpret_cast<const float*>(ws + OFF_BIG + BO_KIRAW);
  u16* kib = reinterpret_cast<u16*>(ws + OFF_BIG + BO_KIB);
  const float* cs = reinterpret_cast<const float*>(ws + OFF_COS);
  const float* sn = reinterpret_cast<const float*>(ws + OFF_SIN);
  const float gg = g[lane], bb = bta[lane];
  constexpr int RB = 4;
  for (int r0 = gw * RB; r0 < T; r0 += nw * RB) {
    float v[RB], c[RB], s[RB];
#pragma unroll
    for (int k = 0; k < RB; ++k) {
      v[k] = raw[(size_t)(r0 + k) * 64 + lane];
      c[k] = cs[(r0 + k) * 8 + (lane & 7)]; s[k] = sn[(r0 + k) * 8 + (lane & 7)];
    }
    float mu[RB], d[RB], rs[RB];
#pragma unroll
    for (int k = 0; k < RB; ++k) mu[k] = wave_sum(v[k]) * (1.f / 64.f);
#pragma unroll
    for (int k = 0; k < RB; ++k) { d[k] = v[k] - mu[k]; rs[k] = rsqrtf(wave_sum(d[k] * d[k]) * (1.f / 64.f) + LN_EPS); }
#pragma unroll
    for (int k = 0; k < RB; ++k) {
      float y = d[k] * rs[k] * gg + bb;
      const float py = sx<8>(y);
      if (lane < 16) y = lane < 8 ? y * c[k] - py * s[k] : y * c[k] + py * s[k];
      kib[(size_t)(r0 + k) * 64 + rope_pos(lane)] = f2bf(y);
    }
  }
}

DI unsigned sortable(float f) { unsigned u = __float_as_uint(f); u = (u & 0x80000000u) ? ~u : (u | 0x80000000u); return u & ~((1u << SEL_LOW_BIT) - 1u); }

DI int wave_total(int v) {
  v += __builtin_amdgcn_update_dpp(0, v, 0x111, 0xf, 0xf, true);
  v += __builtin_amdgcn_update_dpp(0, v, 0x112, 0xf, 0xf, true);
  v += __builtin_amdgcn_update_dpp(0, v, 0x114, 0xf, 0xf, true);
  v += __builtin_amdgcn_update_dpp(0, v, 0x118, 0xf, 0xf, true);
  v += __builtin_amdgcn_update_dpp(0, v, 0x142, 0xa, 0xf, true);
  v += __builtin_amdgcn_update_dpp(0, v, 0x143, 0xc, 0xf, true);
  return __builtin_amdgcn_readlane(v, 63);
}

DI unsigned long long select256(const unsigned (&u)[64], int lane) {
  unsigned th = 0u;
  int g = 0;
  for (int bit = 31; bit >= SEL_LOW_BIT; --bit) {
    const unsigned c = th | (1u << bit);
    int cnt = 0;
#pragma unroll
    for (int r = 0; r < 64; r += 8)
      asm("v_cmp_le_u32 vcc, %1, %2\n\tv_addc_co_u32 %0, vcc, 0, %0, vcc\n\t"
          "v_cmp_le_u32 vcc, %1, %3\n\tv_addc_co_u32 %0, vcc, 0, %0, vcc\n\t"
          "v_cmp_le_u32 vcc, %1, %4\n\tv_addc_co_u32 %0, vcc, 0, %0, vcc\n\t"
          "v_cmp_le_u32 vcc, %1, %5\n\tv_addc_co_u32 %0, vcc, 0, %0, vcc\n\t"
          "v_cmp_le_u32 vcc, %1, %6\n\tv_addc_co_u32 %0, vcc, 0, %0, vcc\n\t"
          "v_cmp_le_u32 vcc, %1, %7\n\tv_addc_co_u32 %0, vcc, 0, %0, vcc\n\t"
          "v_cmp_le_u32 vcc, %1, %8\n\tv_addc_co_u32 %0, vcc, 0, %0, vcc\n\t"
          "v_cmp_le_u32 vcc, %1, %9\n\tv_addc_co_u32 %0, vcc, 0, %0, vcc"
          : "+v"(cnt) : "s"(c), "v"(u[r]), "v"(u[r + 1]), "v"(u[r + 2]), "v"(u[r + 3]), "v"(u[r + 4]), "v"(u[r + 5]), "v"(u[r + 6]), "v"(u[r + 7]) : "vcc");
    const int n = wave_total(cnt);
    if (n == 256) { th = c - 1u; g = 256; break; }
    if (n > 256) th = c; else g = n;
  }
  int need = th == 0u ? 0 : 256 - g;
  int mlo = 0, mhi = 0;
#pragma unroll
  for (int r = 0; r < 64; ++r) {
    const unsigned long long gt = __ballot(u[r] > th), eq = __ballot(u[r] == th);
    unsigned long long tk = 0ull;
    if (need > 0 && eq != 0ull) {
      const int pre = __builtin_amdgcn_mbcnt_hi((unsigned)(eq >> 32), __builtin_amdgcn_mbcnt_lo((unsigned)eq, 0u));
      tk = __ballot(u[r] == th && pre < need);
      need -= __popcll(tk);
    }
    const unsigned long long mv = gt | tk;
    asm volatile("s_nop 3\n\tv_writelane_b32 %0, %2, %4\n\tv_writelane_b32 %1, %3, %4" : "+v"(mlo), "+v"(mhi) : "s"((unsigned)mv), "s"((unsigned)(mv >> 32)), "n"(r));
  }
  return ((unsigned long long)(unsigned)mhi << 32) | (unsigned)mlo;
}

DI void dsa_select_block(char* ws, char* smem, int wid, int lane, int b, int t0, int gwave) {
  typedef __attribute__((address_space(3))) unsigned char* lds_p;
  lds_p lds = (lds_p)smem;
  char* big = ws + OFF_BIG;
  const u16* QI = reinterpret_cast<const u16*>(big + BO_QI);
  const char* kbase = big + BO_KIB + (size_t)b * S * 128;
  const float* WI = reinterpret_cast<const float*>(big + BO_WI);
  unsigned long long* BM = reinterpret_cast<unsigned long long*>(big + BO_BM);
  unsigned* scr = reinterpret_cast<unsigned*>(big + BO_SCR) + (size_t)gwave * 4096 + lane;
  const int tA = t0 + 2 * wid, nch = ((t0 + 15) >> 8) + 1;
  const int row = lane & 15, kq = lane >> 4, tid = wid * 64 + lane;
  const u16* qip = QI + ((size_t)(b * S + tA + (row >> 3)) * 8 + (row & 7)) * 64 + kq * 8;
  const bf16x8 qa0 = ld8(qip), qa1 = ld8(qip + 32);
  const float4 w = *reinterpret_cast<const float4*>(WI + (size_t)(b * S + tA + (kq >> 1)) * 8 + (kq & 1) * 4);
  unsigned soff[4];
#pragma unroll
  for (int i = 0; i < 4; ++i) { const int p = i * 512 + tid, r = p >> 3, lc = (p & 7) ^ ((r >> 1) & 7); soff[i] = (unsigned)(r * 128 + lc * 16); }
  const unsigned ldsw = (unsigned)wid * 1024u;
#define SEL_ISSUE(c, slot) do { _Pragma("unroll") for (int _i = 0; _i < 4; ++_i) \
    __builtin_amdgcn_global_load_lds((const unsigned*)(kbase + (size_t)(c) * 32768 + soff[_i]), (__attribute__((address_space(3))) unsigned*)(lds + (slot) * 32768 + _i * 8192 + ldsw), 16, 0, 0); } while (0)
#define SEL_WAIT(n) asm volatile("s_waitcnt vmcnt(" #n ")" ::: "memory")
  int boff[2];
#pragma unroll
  for (int kk = 0; kk < 2; ++kk) boff[kk] = row * 128 + (((kk * 4 + kq) ^ ((row >> 1) & 7)) << 4);
  asm volatile("" :: "v"(qa0), "v"(qa1), "v"(w.x), "v"(w.y), "v"(w.z), "v"(w.w));
  __builtin_amdgcn_s_barrier();
  SEL_ISSUE(0, 0);
  if (nch > 1) SEL_ISSUE(1, 1);
  unsigned u[64];
#pragma unroll
  for (int c = 0; c < 16; ++c) {
    if (c < nch) {
      if (c + 2 < nch) { SEL_ISSUE(c + 2, (c + 2) & 3); SEL_WAIT(8); }
      else if (c + 1 < nch) SEL_WAIT(4);
      else SEL_WAIT(0);
      __builtin_amdgcn_s_barrier();
      lds_p img = lds + (c & 3) * 32768;
#pragma unroll
      for (int rr = 0; rr < 4; ++rr) {
        const int r = c * 4 + rr;
        float sa[4], sb[4];
        bf16x8 kb0[4], kb1[4];
#pragma unroll
        for (int tt = 0; tt < 4; ++tt) {
          const int tile = rr * 4 + tt;
          kb0[tt] = *(const __attribute__((address_space(3))) bf16x8*)(img + tile * 2048 + boff[0]);
          kb1[tt] = *(const __attribute__((address_space(3))) bf16x8*)(img + tile * 2048 + boff[1]);
        }
        f32x4 cc[4];
#pragma unroll
        for (int tt = 0; tt < 4; ++tt) cc[tt] = mfma16(qa0, kb0[tt], f32x4{0.f, 0.f, 0.f, 0.f});
#pragma unroll
        for (int tt = 0; tt < 4; ++tt) cc[tt] = mfma16(qa1, kb1[tt], cc[tt]);
        float pp[4], ps[4];
#pragma unroll
        for (int tt = 0; tt < 4; ++tt) pp[tt] = w.x * fmaxf(cc[tt][0], 0.f) + w.y * fmaxf(cc[tt][1], 0.f) + w.z * fmaxf(cc[tt][2], 0.f) + w.w * fmaxf(cc[tt][3], 0.f);
#pragma unroll
        for (int tt = 0; tt < 4; ++tt) ps[tt] = sx<16>(pp[tt]);
#pragma unroll
        for (int tt = 0; tt < 4; ++tt) {
          const float pt = pp[tt] + ps[tt];
          const int iv = __builtin_bit_cast(int, pt); int iw = iv; asm volatile("" : "+v"(iw));
          auto sw = __builtin_amdgcn_permlane32_swap(iv, iw, false, false);
          sa[tt] = __builtin_bit_cast(float, (int)sw[0]); sb[tt] = __builtin_bit_cast(float, (int)sw[1]);
        }
        const float scA = kq == 0 ? sa[0] : kq == 1 ? sa[1] : kq == 2 ? sa[2] : sa[3];
        const float scB = kq == 0 ? sb[0] : kq == 1 ? sb[1] : kq == 2 ? sb[2] : sb[3];
        const int key = r * 64 + lane;
        u[r] = key <= tA ? sortable(scA) : 0u;
        stg4(scr + r * 64, key <= tA + 1 ? sortable(scB) : 0u);
      }
    } else {
#pragma unroll
      for (int rr = 0; rr < 4; ++rr) { u[c * 4 + rr] = 0u; stg4(scr + (c * 4 + rr) * 64, 0u); }
    }
  }
#undef SEL_ISSUE
#undef SEL_WAIT
  const unsigned long long mA = select256(u, lane);
  stg8(BM + (size_t)(b * S + tA) * 64 + lane, make_uint2((unsigned)mA, (unsigned)(mA >> 32)));
#pragma unroll
  for (int r = 0; r < 64; ++r) u[r] = ldg32(scr + r * 64);
  const unsigned long long mB = select256(u, lane);
  stg8(BM + (size_t)(b * S + tA + 1) * 64 + lane, make_uint2((unsigned)mB, (unsigned)(mB >> 32)));
}

DI void kmean_phase(const Ctx& cx, char* ws) {
  const int lane = cx.tid & 63, gw = cx.bid * WPB + __builtin_amdgcn_readfirstlane(cx.tid >> 6), nw = cx.nb * WPB;
  const u16* K = reinterpret_cast<const u16*>(ws + OFF_BIG + BO_K);
  float* KM = reinterpret_cast<float*>(ws + OFF_KMEAN);
  for (int u = gw; u < NB * 12 * 16; u += nw) {
    const int bh = u >> 4, blk = u & 15;
    const u16* kp = K + ((size_t)bh * S + blk * 256) * 64 + lane * 8;
    float acc[8];
#pragma unroll
    for (int j = 0; j < 8; ++j) acc[j] = 0.f;
#pragma unroll 8
    for (int i = 0; i < 32; ++i) {
      const u32x4 v = __builtin_bit_cast(u32x4, ld8(kp + i * 512));
#pragma unroll
      for (int j = 0; j < 4; ++j) { acc[2 * j] += __uint_as_float(v[j] << 16); acc[2 * j + 1] += __uint_as_float(v[j] & 0xffff0000u); }
    }
#pragma unroll
    for (int j = 0; j < 8; ++j) { float a = acc[j]; a += sx<8>(a); a += sx<16>(a); a = red32_sum(a); acc[j] = a * (1.f / 256.f); }
    if (lane < 8) {
      float* dst = KM + (size_t)u * 64 + lane * 8;
      *reinterpret_cast<float4*>(dst) = make_float4(acc[0], acc[1], acc[2], acc[3]);
      *reinterpret_cast<float4*>(dst + 4) = make_float4(acc[4], acc[5], acc[6], acc[7]);
      *reinterpret_cast<uint4*>(reinterpret_cast<u16*>(ws + OFF_KMEANB) + (size_t)u * 64 + lane * 8) =
          make_uint4(pk2(acc[0], acc[1]), pk2(acc[2], acc[3]), pk2(acc[4], acc[5]), pk2(acc[6], acc[7]));
    }
  }
}

DI void grid_barrier(unsigned* cnt, unsigned target, int tid) {
  asm volatile("s_waitcnt vmcnt(0)" ::: "memory");
  __syncthreads();
  if (tid == 0) {
    __builtin_amdgcn_fence(__ATOMIC_RELEASE, "agent");
    asm volatile("s_waitcnt vmcnt(0)" ::: "memory");
    __hip_atomic_fetch_add(cnt, 1u, __ATOMIC_RELAXED, __HIP_MEMORY_SCOPE_AGENT);
    while (__hip_atomic_load(cnt, __ATOMIC_RELAXED, __HIP_MEMORY_SCOPE_AGENT) < target) __builtin_amdgcn_s_sleep(1);
    __builtin_amdgcn_fence(__ATOMIC_ACQUIRE, "agent");
    asm volatile("s_waitcnt vmcnt(0)" ::: "memory");
  }
  __syncthreads();
}

#define XB_TMO      128
#define XB_XCNT(j)  (256  + 64 * (j))
#define XB_XSUB(j)  (1280 + 64 * (j))
#define XB_XGEN(j)  (2304 + 64 * (j))
#define XB_TOP      3328
#define XB_TOPGEN   3392
#define XB_SPIN_CAP (1u << 20)
DI unsigned xb_ld(unsigned* p) { return __hip_atomic_load(p, __ATOMIC_RELAXED, __HIP_MEMORY_SCOPE_AGENT); }
DI unsigned xb_add(unsigned* p, unsigned v) { return __hip_atomic_fetch_add(p, v, __ATOMIC_RELAXED, __HIP_MEMORY_SCOPE_AGENT); }
DI unsigned xb_xcc_id() { return (unsigned)__builtin_amdgcn_s_getreg((3 << 11) | 20) & 0xFu; }
#define XB_SPIN(cond, bar) do { unsigned _sp = 0; while (cond) { __builtin_amdgcn_s_sleep(1); \
    if ((++_sp & 255u) == 0u) { if (xb_ld(&(bar)[XB_TMO])) break; if (_sp > XB_SPIN_CAP) { atomicAdd(&(bar)[XB_TMO], 1u); break; } } } } while (0)
typedef volatile __attribute__((address_space(3))) unsigned* xb_lds_p;
DI void xcd_barrier_complete(unsigned* bar, unsigned x, unsigned G, unsigned& nloc, unsigned& nx) {
  unsigned sum, cnt, mine, sp = 0u;
  for (;;) {
    sum = 0u; cnt = 0u; mine = 0u;
#pragma unroll
    for (unsigned j = 0; j < 16; ++j) { const unsigned c = xb_ld(&bar[XB_XCNT(j)]); sum += c; cnt += (c > 0u) ? 1u : 0u; mine = (j == x) ? c : mine; }
    if (sum == G) break;
    __builtin_amdgcn_s_sleep(1);
    if ((++sp & 255u) == 0u) { if (xb_ld(&bar[XB_TMO])) break; if (sp > XB_SPIN_CAP) { atomicAdd(&bar[XB_TMO], 1u); break; } }
  }
  nloc = mine > 0u ? mine : 1u; nx = cnt > 0u ? cnt : 1u;
}
DI void xcd_barrier(unsigned* bar, unsigned x, xb_lds_p st, unsigned G, int tid) {
  asm volatile("s_waitcnt vmcnt(0)" ::: "memory");
  __syncthreads();
  if (tid == 0) {
    __builtin_amdgcn_s_waitcnt(0);
    unsigned nloc = st[0], nx = st[1];
    if (nloc == 0u) { xcd_barrier_complete(bar, x, G, nloc, nx); st[0] = nloc; st[1] = nx; }
    const unsigned old = xb_add(&bar[XB_XSUB(x)], 1u);
    const unsigned gen = old / nloc;
    if (old + 1u == (gen + 1u) * nloc) {
      __builtin_amdgcn_fence(__ATOMIC_RELEASE, "agent");
      asm volatile("s_waitcnt vmcnt(0)" ::: "memory");
      const unsigned og = xb_add(&bar[XB_TOP], 1u);
      const unsigned tg = og / nx;
      if (og + 1u == (tg + 1u) * nx) xb_add(&bar[XB_TOPGEN], 1u);
      else XB_SPIN(xb_ld(&bar[XB_TOPGEN]) == tg, bar);
      __builtin_amdgcn_fence(__ATOMIC_ACQUIRE, "agent");
      xb_add(&bar[XB_XGEN(x)], 1u);
      asm volatile("s_waitcnt vmcnt(0)" ::: "memory");
    } else {
      XB_SPIN(xb_ld(&bar[XB_XGEN(x)]) == gen, bar);
      __builtin_amdgcn_fence(__ATOMIC_ACQUIRE, "agent");
      asm volatile("s_waitcnt vmcnt(0)" ::: "memory");
    }
  }
  __syncthreads();
}

template <class Epi>
DI void run_gemm(const Ctx& cx, char* smem, const u16* A, const u16* Bt, int M, int N, int K, int crot, const Epi& epi) {
  pg8::StaticOrder so; so.init(M, N, cx.nb, (cx.bid + crot) % cx.nb);
  pg8::gemm_phase(cx.tid, (PG8_LAS unsigned char*)smem, pg8::Gemm{A, Bt, M, N, K}, so, epi);
}

__global__ void __launch_bounds__(NTHR, 2) fwd_kernel(Params p) {
  extern __shared__ __attribute__((aligned(16))) char smem[];
  cg::grid_group grid = cg::this_grid();
  bool first = true;
  const int wave_id = __builtin_amdgcn_readfirstlane(threadIdx.x >> 6);
  xb_lds_p xb_st = (xb_lds_p)(smem + LDS_BYTES);
  unsigned* xb_bar = reinterpret_cast<unsigned*>(p.ws + OFF_BAR);
  const unsigned xb_x = xb_xcc_id();
  if (threadIdx.x == 0) { xb_st[0] = 0u; xb_st[1] = 0u; (void)xb_add(&xb_bar[XB_XCNT(xb_x)], 1u); }
  __syncthreads();
  if (p.ph_lo == 0) {
    Ctx cx; cx.tid = threadIdx.x; cx.bid = blockIdx.x; cx.nb = gridDim.x;
    if (EN & 1) phase0(cx, p, p.ws, smem);
    if (XP0) phase0(cx, p, p.ws, smem);
    for (int i = 0; i < XSYNC; ++i) grid.sync();
    first = false;
  }
  bool rep_done = false;
  int nbar = 0;
  for (int ph = p.ph_lo < 1 ? 1 : p.ph_lo; ph < p.ph_hi; ++ph) {
    const int layer = (ph - 1) / 9, slot = (ph - 1) % 9;
    if (REP) { if (((REP >> slot) & 1) && ((REPL >> layer) & 1) && !rep_done) { rep_done = true; --ph; } else rep_done = false; }
    const int kind = layer % 3, jl = layer / 3;
    if ((slot == 1 && kind == 1) || (slot == 2 && kind != 0)) continue;
    if (!first) {
      if (nbar == 0) grid.sync();
      else xcd_barrier(reinterpret_cast<unsigned*>(p.ws + OFF_BAR), xb_x, xb_st, gridDim.x, (int)threadIdx.x);
      ++nbar;
    }
    first = false;
    typedef const Params __attribute__((address_space(4)))* KArgs;
    KArgs pp = (KArgs)__builtin_amdgcn_kernarg_segment_ptr();
    asm volatile("" : "+s"(pp));
    char* ws = pp->ws; float* outp = pp->out;
    Ctx cx; cx.bid = blockIdx.x; cx.nb = gridDim.x;
    int wid = wave_id;
    asm volatile("" : "+s"(ws), "+s"(outp), "+s"(wid), "+s"(cx.bid), "+s"(cx.nb));
    unsigned ones = ~0u; asm volatile("" : "+s"(ones));
    const int lane = __builtin_amdgcn_mbcnt_hi(ones, __builtin_amdgcn_mbcnt_lo(ones, 0u));
    cx.tid = wid * 64 + lane;
    const int gw = cx.bid * WPB + wid, nw = cx.nb * WPB;
    if (slot == 0 && (EN & 2)) {
      const int nmain = kind == 0 ? NMAIN_A : NMAIN_BC;
      run_gemm(cx, smem, reinterpret_cast<const u16*>(ws + OFF_XB), reinterpret_cast<const u16*>(ws + win_off(layer)), T, nmain, 1024, 0, EpiInProj{ws, kind});
      run_gemm(cx, smem, reinterpret_cast<const u16*>(ws + win_off(layer)) + (size_t)nmain * 1024, reinterpret_cast<const u16*>(ws + OFF_XB), 768, T, 1024, kind == 0 ? 0 : cx.nb / 2, EpiVt{ws, kind});
      if (layer == 0 && (EN & 2048))
        run_gemm(cx, smem, reinterpret_cast<const u16*>(ws + OFF_MEMN), reinterpret_cast<const u16*>(ws + OFF_WMKV), NB * NMEM, 4 * 512, 1024, cx.nb / 2, EpiMemKV{ws});
    } else if (slot == 1 && (EN & 4)) {
      if (kind == 0) ki_prep_phase(cx, ws, pp->idx_g + jl * 64, pp->idx_b + jl * 64);
      else kmean_phase(cx, ws);
    } else if (slot == 2 && (EN & 8)) {
      for (int v = cx.bid; v < NB * (S / 16); v += cx.nb) {
        const int b = v >> 8, idx = v & 255, j = (b & 1) ? 255 - idx : idx;
        dsa_select_block(ws, smem, wid, lane, b, j * 16, gw);
      }
    } else if (slot == 3) {
      if (EN & 128) for (int u = gw; u < NB * 4 * 128; u += nw) mem_att_unit(ws, layer, kind, u, lane);
      if (kind == 1 && (EN & 16)) {
        for (int u = gw; u < NB * 4 * 8 * 16; u += nw) dil_att_unit(ws, u, lane);
      } else {
        for (int k = 0; k * cx.nb < NB * 12 * 16; ++k) {
          const int v = k * cx.nb + ((k & 1) ? cx.nb - 1 - cx.bid : cx.bid);
          if (v >= NB * 12 * 16) continue;
          const int Qb = 15 - v / 96, bh = v % 96;
          if (kind == 0) { if (EN & 32) blk_att_unit<true>(ws, smem, wid, lane, bh, Qb); }
          else { if (EN & 64) blk_att_unit<false>(ws, smem, wid, lane, bh, Qb); }
        }
      }
    } else if (slot == 4 && (EN & 256)) {
      run_gemm(cx, smem, reinterpret_cast<const u16*>(ws + OFF_MIX), reinterpret_cast<const u16*>(ws + OFF_WOUT + layer * SZ_WOUT), T, 1024, 1024, 0, EpiResid{layer == 0 ? pp->x : outp, outp, layer == 0 ? nullptr : reinterpret_cast<const float2*>(ws + OFF_STAT), pp->ln2g + (layer - 1) * 1024, pp->ln2b + (layer - 1) * 1024});
    } else if (slot == 5) {
      ln_phase(cx, outp, pp->ln1g + layer * 1024, pp->ln1b + layer * 1024, reinterpret_cast<u16*>(ws + OFF_XB), reinterpret_cast<float2*>(ws + OFF_STAT), false);
    } else if (slot == 6 && (EN & 512)) {
      run_gemm(cx, smem, reinterpret_cast<const u16*>(ws + OFF_XB), reinterpret_cast<const u16*>(ws + OFF_WGU + layer * SZ_WGU), T, 2 * DFF, 1024, 0, EpiSwiGLU{reinterpret_cast<u16*>(ws + OFF_BIG + BO_H)});
    } else if (slot == 7 && (EN & 1024)) {
      run_gemm(cx, smem, reinterpret_cast<const u16*>(ws + OFF_BIG + BO_H), reinterpret_cast<const u16*>(ws + OFF_WDN + layer * SZ_WDN), T, 1024, DFF, 0, EpiResid{outp, outp, reinterpret_cast<const float2*>(ws + OFF_STAT), pp->ln1g + layer * 1024, pp->ln1b + layer * 1024});
    } else {
      ln_phase(cx, outp, pp->ln2g + layer * 1024, pp->ln2b + layer * 1024, reinterpret_cast<u16*>(ws + OFF_XB), reinterpret_cast<float2*>(ws + OFF_STAT), layer == DEPTH - 1);
    }
  }
}

extern "C" void kernel_launch(void* const* d_in, const int* in_sizes, int n_in, void* d_out, int out_size,
                              void* d_ws, size_t ws_size, hipStream_t stream) {
  static int grid_blocks = 0;
  if (!grid_blocks) {
    int dev = 0, cus = 0, per_cu = 0;
    (void)hipGetDevice(&dev);
    (void)hipDeviceGetAttribute(&cus, hipDeviceAttributeMultiprocessorCount, dev);
    if (hipFuncSetAttribute((const void*)fwd_kernel, hipFuncAttributeMaxDynamicSharedMemorySize, LDS_TOTAL) != hipSuccess)
      fprintf(stderr, "hipFuncSetAttribute(max dynamic LDS) failed\n");
    (void)hipOccupancyMaxActiveBlocksPerMultiprocessor(&per_cu, fwd_kernel, NTHR, LDS_TOTAL);
    if (per_cu < 1) fprintf(stderr, "occupancy query reports %d blocks per CU\n", per_cu);
    grid_blocks = cus;
  }
  if (ws_size < WS_NEED) fprintf(stderr, "workspace too small: %zu < %zu\n", ws_size, (size_t)WS_NEED);
  Params p{};
  p.x = (const float*)d_in[0]; p.mem = (const float*)d_in[1]; p.pos = (const int*)d_in[2];
  p.mem_g = (const float*)d_in[3]; p.mem_b = (const float*)d_in[4];
  p.w_in_a = (const float*)d_in[5]; p.idx_g = (const float*)d_in[6]; p.idx_b = (const float*)d_in[7];
  p.w_in_b = (const float*)d_in[8]; p.w_in_c = (const float*)d_in[9];
  p.w_mkv = (const float*)d_in[10]; p.w_out = (const float*)d_in[11];
  p.ln1g = (const float*)d_in[12]; p.ln1b = (const float*)d_in[13];
  p.w_gu = (const float*)d_in[14]; p.w_dn = (const float*)d_in[15];
  p.ln2g = (const float*)d_in[16]; p.ln2b = (const float*)d_in[17];
  p.out = (float*)d_out; p.ws = (char*)d_ws;
  for (int i = 0; i < 8; ++i) p.inv_freq[i] = (float)pow(500000.0, -(double)i / 8.0);
  const int NPH = 1 + DEPTH * 9;
#if SINGLE_LAUNCH
  (void)hipMemsetAsync((char*)d_ws + OFF_BAR, 0, (size_t)XCD_BAR_WORDS * 4, stream);
  p.ph_lo = 0; p.ph_hi = NPH;
  void* args[] = {&p};
  hipError_t e = hipLaunchCooperativeKernel((void*)fwd_kernel, dim3(grid_blocks), dim3(NTHR), args, LDS_TOTAL, stream);
  if (e != hipSuccess) fprintf(stderr, "cooperative launch failed: %s (grid %d)\n", hipGetErrorString(e), grid_blocks);
#else
  for (int ph = 0; ph < NPH; ++ph) {
    if (ph > 0) {
      const int layer = (ph - 1) / 9, slot = (ph - 1) % 9, kind = layer % 3;
      if ((slot == 1 && kind == 1) || (slot == 2 && kind != 0)) continue;
    }
    p.ph_lo = ph; p.ph_hi = ph + 1;
    hipLaunchKernelGGL(fwd_kernel, dim3(grid_blocks), dim3(NTHR), LDS_TOTAL, stream, p);
  }
#endif
}
```

```cpp
#include <hip/hip_runtime.h>
#include <hip/hip_cooperative_groups.h>
#include <cstdio>
#include <cmath>
namespace cg = cooperative_groups;

#ifndef EN
#define EN 0xFFFF
#endif
#ifndef SEL_LOW_BIT
#define SEL_LOW_BIT 8
#endif
#ifndef XSYNC
#define XSYNC 0
#endif
#ifndef XP0
#define XP0 0
#endif
#ifndef REP
#define REP 0
#endif
#ifndef REPL
#define REPL 15
#endif
#ifndef SINGLE_LAUNCH
#define SINGLE_LAUNCH 1
#endif

#define DI __device__ __forceinline__
typedef unsigned short u16;
using bf16x8 = __attribute__((ext_vector_type(8))) __bf16;
using bf2 = __attribute__((ext_vector_type(2))) __bf16;
using f32x4 = __attribute__((ext_vector_type(4))) float;
using f32x16 = __attribute__((ext_vector_type(16))) float;
using u32x4 = __attribute__((ext_vector_type(4))) unsigned;

constexpr int NB = 8, S = 4096, DM = 1024, T = NB * S, DEPTH = 4;
constexpr int NMEM = 256, DFF = 2816;
constexpr int NPAD_A = 3328, NPAD_BC = 2560;
constexpr int NMAIN_A = 2560, NMAIN_BC = 1792;
constexpr int NTHR = 512, WPB = 8;
constexpr int LDS_BYTES = 131072;
constexpr int LDS_TOTAL = LDS_BYTES + 16;
constexpr float ALPHA = 1.681792830507429f;
constexpr float LN_EPS = 1e-5f;

constexpr size_t SZ_WIN_A = (size_t)NPAD_A * 1024 * 2, SZ_WIN_BC = (size_t)NPAD_BC * 1024 * 2;
constexpr size_t OFF_WIN0 = 0;
constexpr size_t OFF_WIN1 = OFF_WIN0 + SZ_WIN_A;
constexpr size_t OFF_WIN2 = OFF_WIN1 + SZ_WIN_BC;
constexpr size_t OFF_WIN3 = OFF_WIN2 + SZ_WIN_BC;
constexpr size_t OFF_WMKV = OFF_WIN3 + SZ_WIN_A;
constexpr size_t SZ_WMKV = (size_t)512 * 1024 * 2;
constexpr size_t OFF_WOUT = OFF_WMKV + 4 * SZ_WMKV;
constexpr size_t SZ_WOUT = (size_t)1024 * 1024 * 2;
constexpr size_t OFF_WGU = OFF_WOUT + 4 * SZ_WOUT;
constexpr size_t SZ_WGU = (size_t)5632 * 1024 * 2;
constexpr size_t OFF_WDN = OFF_WGU + 4 * SZ_WGU;
constexpr size_t SZ_WDN = (size_t)1024 * 2816 * 2;
constexpr size_t OFF_XB = OFF_WDN + 4 * SZ_WDN;
constexpr size_t SZ_XB = (size_t)T * 1024 * 2;
constexpr size_t OFF_MIX = OFF_XB + SZ_XB;
constexpr size_t OFF_MEMN = OFF_MIX + SZ_XB;
constexpr size_t OFF_MK = OFF_MEMN + (size_t)2048 * 1024 * 2;
constexpr size_t SZ_MK = (size_t)8 * 4 * 256 * 64 * 2;
constexpr size_t OFF_MVT = OFF_MK + 4 * SZ_MK;
constexpr size_t OFF_COS = OFF_MVT + 4 * SZ_MK;
constexpr size_t OFF_SIN = OFF_COS + (size_t)T * 8 * 4;
constexpr size_t OFF_KMEAN = OFF_SIN + (size_t)T * 8 * 4;
constexpr size_t OFF_KMEANB = OFF_KMEAN + (size_t)8 * 12 * 16 * 64 * 4;
constexpr size_t OFF_BIG = OFF_KMEANB + (size_t)8 * 12 * 16 * 64 * 2;
constexpr size_t SZ_QKV = (size_t)T * 768 * 2;
constexpr size_t BO_Q = 0, BO_K = SZ_QKV, BO_V = 2 * SZ_QKV;
constexpr size_t BO_QM_AC = 3 * SZ_QKV, BO_QM_B = 5 * SZ_QKV;
constexpr size_t SZ_QM = (size_t)T * 256 * 2;
constexpr size_t BO_QI = BO_QM_AC + SZ_QM;
constexpr size_t BO_KIRAW = BO_QI + (size_t)T * 512 * 2;
constexpr size_t BO_KIB = BO_KIRAW + (size_t)T * 64 * 4;
constexpr size_t BO_WI = BO_KIB + (size_t)T * 64 * 2;
constexpr size_t BO_BM = BO_WI + (size_t)T * 8 * 4;
constexpr size_t BO_SCR = BO_BM + (size_t)T * 128 * 4;
constexpr size_t BO_H = 0;
constexpr size_t OFF_STAT = OFF_BIG + 5 * SZ_QKV + SZ_QM;
constexpr size_t OFF_BAR = OFF_STAT + (size_t)T * 8;
constexpr int XCD_BAR_WORDS = 3456;
constexpr size_t WS_NEED = OFF_BAR + (size_t)XCD_BAR_WORDS * 4;

struct Ctx { int tid, bid, nb; };

struct Params {
  const float* x; const float* mem; const int* pos; const float* mem_g; const float* mem_b;
  const float* w_in_a; const float* idx_g; const float* idx_b; const float* w_in_b; const float* w_in_c;
  const float* w_mkv; const float* w_out; const float* ln1g; const float* ln1b;
  const float* w_gu; const float* w_dn; const float* ln2g; const float* ln2b;
  float* out; char* ws;
  float inv_freq[8];
  int ph_lo, ph_hi;
};

DI unsigned pk2(float a, float b) { bf2 v; v[0] = (__bf16)a; v[1] = (__bf16)b; return __builtin_bit_cast(unsigned, v); }
DI u16 f2bf(float a) { return __builtin_bit_cast(u16, (__bf16)a); }
DI float bf2f(u16 b) { return __uint_as_float(((unsigned)b) << 16); }
typedef const bf16x8 __attribute__((address_space(1)))* gp_bf16x8;
typedef const unsigned __attribute__((address_space(1)))* gp_u32;
DI bf16x8 ld8(const u16* p) { return *((gp_bf16x8)(const void*)p); }
DI unsigned ldg32(const unsigned* p) { return *((gp_u32)(const void*)p); }
typedef unsigned u32x2v __attribute__((ext_vector_type(2)));
DI void stg16(void* p, uint4 v) { *((__attribute__((address_space(1))) u32x4*)p) = u32x4{v.x, v.y, v.z, v.w}; }
DI void stg16f(void* p, f32x4 v) { *((__attribute__((address_space(1))) f32x4*)p) = v; }
DI void stg8(void* p, uint2 v) { *((__attribute__((address_space(1))) u32x2v*)p) = u32x2v{v.x, v.y}; }
DI void stg4(void* p, unsigned v) { *((__attribute__((address_space(1))) unsigned*)p) = v; }
DI void stg2(void* p, u16 v) { *((__attribute__((address_space(1))) u16*)p) = v; }
DI f32x4 ldg4(const float* p) { return *((const __attribute__((address_space(1))) f32x4*)(const void*)p); }
typedef float f32x2v __attribute__((ext_vector_type(2)));
DI float2 ldg2(const float2* p) { const f32x2v v = *((const __attribute__((address_space(1))) f32x2v*)(const void*)p); return make_float2(v[0], v[1]); }
DI f32x4 mfma16(bf16x8 a, bf16x8 b, f32x4 c) { return __builtin_amdgcn_mfma_f32_16x16x32_bf16(a, b, c, 0, 0, 0); }
DI f32x16 mfma32(bf16x8 a, bf16x8 b, f32x16 c) { return __builtin_amdgcn_mfma_f32_32x32x16_bf16(a, b, c, 0, 0, 0); }
template <int M> DI float sx(float v) { return __builtin_bit_cast(float, __builtin_amdgcn_ds_swizzle(__builtin_bit_cast(int, v), (M << 10) | 0x1F)); }
DI float red32_sum(float v) { const int iv = __builtin_bit_cast(int, v); int iw = iv; asm volatile("" : "+v"(iw));
  auto r = __builtin_amdgcn_permlane32_swap(iv, iw, false, false); return __builtin_bit_cast(float, (int)r[0]) + __builtin_bit_cast(float, (int)r[1]); }
DI float red32_max(float v) { const int iv = __builtin_bit_cast(int, v); int iw = iv; asm volatile("" : "+v"(iw));
  auto r = __builtin_amdgcn_permlane32_swap(iv, iw, false, false); return fmaxf(__builtin_bit_cast(float, (int)r[0]), __builtin_bit_cast(float, (int)r[1])); }
DI float wave_sum(float v) { v += sx<1>(v); v += sx<2>(v); v += sx<4>(v); v += sx<8>(v); v += sx<16>(v); return red32_sum(v); }
DI size_t win_off(int layer) { return layer == 0 ? OFF_WIN0 : layer == 1 ? OFF_WIN1 : layer == 2 ? OFF_WIN2 : OFF_WIN3; }

DI int rope_pos(int c) { const int d = c & 63; return d < 16 ? (c & ~15) | (d & 3) | ((d & 4) << 1) | ((d & 8) >> 1) : c; }
DI int map_row(int kind, int c) {
  if (kind == 1) {
    if (c < 1536) return rope_pos(c);
    if (c < 2304) return NMAIN_A + (c - 1536);
    if (c < 2816) return 1792 + rope_pos(c - 2304);
    if (c < 2824) return 2368 + (c - 2816);
    if (c < 2888) return 2304 + (c - 2824);
    return 1536 + (c - 2888);
  }
  if (kind == 3) {
    if (c < 1536) return rope_pos(c);
    if (c < 2304) return NMAIN_BC + (c - 1536);
    return 1536 + (c - 2304);
  }
  if (kind == 2) {
    int isu = c >= DFF; int j = c - isu * DFF;
    return (j >> 7) * 256 + isu * 128 + (j & 127);
  }
  return c;
}

DI void conv_job(const Ctx& cx, const float* __restrict__ src, int Ks, int Ns, u16* __restrict__ dst, int kind, float* tile) {
  const int nnt = (Ns + 63) >> 6, nkt = Ks >> 8, tid = cx.tid;
  for (int t = cx.bid; t < nnt * nkt; t += cx.nb) {
    const int kt = t / nnt, nt = t % nnt;
    const int nn = tid & 63, n = nt * 64 + nn;
    float v[32];
#pragma unroll
    for (int i = 0; i < 32; ++i) { const int kk = i * 8 + (tid >> 6); v[i] = n < Ns ? src[(size_t)(kt * 256 + kk) * Ns + n] : 0.f; }
    __syncthreads();
#pragma unroll
    for (int i = 0; i < 32; ++i) tile[(i * 8 + (tid >> 6)) * 65 + nn] = v[i];
    __syncthreads();
#pragma unroll 4
    for (int i = 0; i < 16; ++i) {
      const int n2 = (tid >> 7) + 4 * i, k2 = tid & 127, nr = nt * 64 + n2;
      if (nr < Ns) {
        const int dr = map_row(kind, nr);
        *reinterpret_cast<unsigned*>(dst + (size_t)dr * Ks + kt * 256 + 2 * k2) = pk2(tile[(2 * k2) * 65 + n2], tile[(2 * k2 + 1) * 65 + n2]);
      }
    }
  }
}

DI void phase0(const Ctx& cx, const Params& p, char* ws, char* smem) {
  float* tile = reinterpret_cast<float*>(smem);
  for (int l = 0; l < DEPTH; ++l) {
    const int kind = l % 3, j = l / 3;
    const float* win = kind == 0 ? p.w_in_a + (size_t)j * 1024 * 3144 : kind == 1 ? p.w_in_b : p.w_in_c;
    conv_job(cx, win, 1024, kind == 0 ? 3144 : 2560, (u16*)(ws + win_off(l)), kind == 0 ? 1 : 3, tile);
    conv_job(cx, p.w_mkv + (size_t)l * 1024 * 512, 1024, 512, (u16*)(ws + OFF_WMKV + l * SZ_WMKV), 0, tile);
    conv_job(cx, p.w_out + (size_t)l * 1024 * 1024, 1024, 1024, (u16*)(ws + OFF_WOUT + l * SZ_WOUT), 0, tile);
    conv_job(cx, p.w_gu + (size_t)l * 1024 * 5632, 1024, 5632, (u16*)(ws + OFF_WGU + l * SZ_WGU), 2, tile);
    conv_job(cx, p.w_dn + (size_t)l * 2816 * 1024, 2816, 1024, (u16*)(ws + OFF_WDN + l * SZ_WDN), 0, tile);
  }
  const int gtid = cx.bid * NTHR + cx.tid, gn = cx.nb * NTHR;
  for (int l = 0; l < DEPTH; l += 3) {
    unsigned* d = reinterpret_cast<unsigned*>(ws + win_off(l) + (size_t)2376 * 1024 * 2);
    for (int i = gtid; i < (NMAIN_A - 2376) * 512; i += gn) d[i] = 0u;
  }
  {
    const float4* xs = reinterpret_cast<const float4*>(p.x);
    uint2* xd = reinterpret_cast<uint2*>(ws + OFF_XB);
    for (int i = gtid; i < T * 256; i += 4 * gn) {
      float4 v[4];
#pragma unroll
      for (int j = 0; j < 4; ++j) v[j] = xs[i + j * gn];
#pragma unroll
      for (int j = 0; j < 4; ++j) xd[i + j * gn] = make_uint2(pk2(v[j].x, v[j].y), pk2(v[j].z, v[j].w));
    }
  }
  {
    float* cs = reinterpret_cast<float*>(ws + OFF_COS); float* sn = reinterpret_cast<float*>(ws + OFF_SIN);
    for (int i = gtid; i < T * 8; i += gn) {
      int t = i >> 3, f = i & 7;
      float ang = (float)p.pos[t] * p.inv_freq[f];
      cs[i] = cosf(ang); sn[i] = sinf(ang);
    }
  }
  {
    const int lane = cx.tid & 63, gw = cx.bid * WPB + __builtin_amdgcn_readfirstlane(cx.tid >> 6), nw = cx.nb * WPB;
    u16* mn = reinterpret_cast<u16*>(ws + OFF_MEMN);
    for (int r = gw; r < NB * NMEM; r += nw) {
      const float4* src = reinterpret_cast<const float4*>(p.mem + (size_t)r * 1024);
      float4 v[4]; float s = 0.f;
      for (int i = 0; i < 4; ++i) { v[i] = src[i * 64 + lane]; s += v[i].x + v[i].y + v[i].z + v[i].w; }
      float mu = wave_sum(s) * (1.f / 1024.f);
      float q = 0.f;
      for (int i = 0; i < 4; ++i) { float a = v[i].x - mu, b = v[i].y - mu, c = v[i].z - mu, d = v[i].w - mu; q += a * a + b * b + c * c + d * d; }
      float rs = rsqrtf(wave_sum(q) * (1.f / 1024.f) + LN_EPS);
      for (int i = 0; i < 4; ++i) {
        int c = (i * 64 + lane) * 4;
        float4 g = *reinterpret_cast<const float4*>(p.mem_g + c), bb = *reinterpret_cast<const float4*>(p.mem_b + c);
        uint2 o = make_uint2(pk2((v[i].x - mu) * rs * g.x + bb.x, (v[i].y - mu) * rs * g.y + bb.y),
                             pk2((v[i].z - mu) * rs * g.z + bb.z, (v[i].w - mu) * rs * g.w + bb.w));
        *reinterpret_cast<uint2*>(mn + (size_t)r * 1024 + c) = o;
      }
    }
  }
}

namespace pg8 {
#define PG8_LAS __attribute__((address_space(3)))
typedef short s16x8 __attribute__((ext_vector_type(8)));
constexpr int BM = 256, BK = 64, HALF = 128, HTB = HALF * BK * 2, STAGE_BYTES = 8 * HTB, NXCD = 8, WGM = 8;
DI int lds_byte(int r, int c) { const int st = (r >> 4) * 2 + (c >> 5), rr = r & 15, cc = c & 31, ob = rr * 64 + cc * 2; return st * 1024 + (ob ^ (((ob >> 9) & 1) << 5)); }
DI void stage_rc(int b, int& R, int& C) { const int st = b / 1024, sb = b % 1024, swz = sb ^ (((sb >> 9) & 1) << 5); R = (st >> 1) * 16 + swz / 64; C = (st & 1) * 32 + (swz % 64) / 2; }
DI int perm32(int rho) { const int n = rho >> 4, i = rho & 15; return 8 * (i >> 2) + 4 * n + (i & 3); }
struct Unit { int pm, pn; };
struct Gemm { const u16* A; const u16* Bt; int M, N, K; };
struct StaticOrder {
  int nM, nN, nwg, G, c;
  DI void init(int M, int N, int G_, int c_) { nM = M / BM; nN = N / BM; nwg = nM * nN; G = G_; c = c_; }
  DI bool next(int i, Unit& u) const {
    const long L = (long)i * G + c; if (L >= nwg) return false;
    int wgid = (int)L; { const int q = nwg / NXCD, r = nwg % NXCD, xcd = wgid % NXCD, off = wgid / NXCD; wgid = (xcd < r ? xcd * (q + 1) : r * (q + 1) + (xcd - r) * q) + off; }
    const int nig = WGM * nN, gid = wgid / nig, fm = gid * WGM, gsz = (nM - fm) < WGM ? (nM - fm) : WGM;
    u.pm = fm + ((wgid % nig) % gsz); u.pn = (wgid % nig) / gsz; return true;
  }
};

template <class Epi>
DI void gemm_phase(int tid, PG8_LAS unsigned char* lds, const Gemm g, const StaticOrder& S, const Epi& E) {
  const int wid = __builtin_amdgcn_readfirstlane(tid >> 6), lane = tid & 63, wr = wid >> 2, wc = wid & 3, fr = lane & 15, fq = lane >> 4;
  const int K = g.K, nt = K / BK;
  unsigned voffA[2], voffB[2];
#pragma unroll
  for (int i = 0; i < 2; ++i) { int R, C; stage_rc(tid * 16 + i * 8192, R, C); const int Rb = Epi::PERM ? ((R & ~31) + perm32(R & 31)) : R;
    voffA[i] = (unsigned)(R * K + C) * 2u; voffB[i] = (unsigned)(Rb * K + C) * 2u; }
  const size_t kstep = (size_t)(BK * 2);
  const size_t hstep = (size_t)HALF * K * 2;
  const size_t tstep = 2 * hstep;
  const unsigned ldsw = (unsigned)wid * 1024u;
  const int aoff = lds_byte(wr * 64 + fr, fq * 8), boff = lds_byte(wc * 32 + fr, fq * 8);
#define PG8_SA(b, h) (((b) * 2 + (h)) * HTB)
#define PG8_SB(b, h) ((4 + (b) * 2 + (h)) * HTB)
#define PG8_STAGE(bufoff, gbase, voff) do { _Pragma("unroll") for (int _i = 0; _i < 2; ++_i) \
    __builtin_amdgcn_global_load_lds((const unsigned*)((const char*)(gbase) + (voff)[_i]), (PG8_LAS unsigned*)(lds + (bufoff) + ldsw + _i * 8192), 16, 0, 0); } while (0)
#define PG8_LDA(dst, b, h) do { _Pragma("unroll") for (int m = 0; m < 4; ++m) _Pragma("unroll") for (int k = 0; k < 2; ++k) dst[m][k] = *(const PG8_LAS s16x8*)(lds + PG8_SA(b, h) + aoff + m * 2048 + k * 1024); } while (0)
#define PG8_LDB(dst, b, h) do { _Pragma("unroll") for (int n = 0; n < 2; ++n) _Pragma("unroll") for (int k = 0; k < 2; ++k) dst[n][k] = *(const PG8_LAS s16x8*)(lds + PG8_SB(b, h) + boff + n * 2048 + k * 1024); } while (0)
#define PG8_MMA(ai, bj, At, Bt) do { __builtin_amdgcn_s_setprio(1); _Pragma("unroll") for (int m = 0; m < 4; ++m) _Pragma("unroll") for (int n = 0; n < 2; ++n) _Pragma("unroll") for (int k = 0; k < 2; ++k) \
    acc[ai][bj][m][n] = __builtin_amdgcn_mfma_f32_16x16x32_bf16(__builtin_bit_cast(bf16x8, Bt[n][k]), __builtin_bit_cast(bf16x8, At[m][k]), acc[ai][bj][m][n], 0, 0, 0); __builtin_amdgcn_s_setprio(0); } while (0)
#define PG8_WAIT_V(n) asm volatile("s_waitcnt vmcnt(" #n ")" ::: "memory")
#define PG8_WAIT_L(n) asm volatile("s_waitcnt lgkmcnt(" #n ")" ::: "memory")
#define PG8_BAR __builtin_amdgcn_s_barrier()
#define PG8_SCHED __builtin_amdgcn_sched_barrier(0)
  Unit cur, nxt; int ui = 0;
  if (!S.next(0, cur)) return;
  f32x4 acc[2][2][4][2];
#pragma unroll
  for (int a = 0; a < 2; ++a)
#pragma unroll
    for (int b = 0; b < 2; ++b)
#pragma unroll
      for (int m = 0; m < 4; ++m)
#pragma unroll
        for (int n = 0; n < 2; ++n) acc[a][b][m][n] = (f32x4){0.f, 0.f, 0.f, 0.f};
  s16x8 At[4][2], B0[2][2], B1[2][2];
  const char* cA = (const char*)g.A + (size_t)cur.pm * tstep; const char* cB = (const char*)g.Bt + (size_t)cur.pn * tstep;
  PG8_STAGE(PG8_SB(0, 0), cB, voffB); PG8_STAGE(PG8_SA(0, 0), cA, voffA); PG8_STAGE(PG8_SB(0, 1), cB + hstep, voffB); PG8_STAGE(PG8_SA(0, 1), cA + hstep, voffA);
  if (wr == 1) PG8_BAR;
  PG8_WAIT_V(4); PG8_BAR;
  PG8_STAGE(PG8_SB(1, 0), cB + kstep, voffB); PG8_STAGE(PG8_SA(1, 0), cA + kstep, voffA); PG8_STAGE(PG8_SB(1, 1), cB + hstep + kstep, voffB);
  PG8_WAIT_V(6); PG8_BAR;
  for (;;) {
    const bool has_next = S.next(ui + 1, nxt);
    const char* nA = has_next ? (const char*)g.A + (size_t)nxt.pm * tstep : cA; const char* nB = has_next ? (const char*)g.Bt + (size_t)nxt.pn * tstep : cB;
    for (int t = 0; t < nt; t += 2) {
      const bool last = (t == nt - 2);
      const char* a1 = cA + (size_t)(t + 1) * kstep;
      const char* a2 = last ? nA : cA + (size_t)(t + 2) * kstep; const char* b2 = last ? nB : cB + (size_t)(t + 2) * kstep;
      const char* a3 = a2 + kstep; const char* b3 = b2 + kstep;
      PG8_LDB(B0, 0, 0); PG8_SCHED; PG8_LDA(At, 0, 0); PG8_STAGE(PG8_SA(1, 1), a1 + hstep, voffA);
      PG8_WAIT_L(8); PG8_BAR; PG8_WAIT_L(0); PG8_MMA(0, 0, At, B0); PG8_BAR; PG8_SCHED;
      PG8_LDB(B1, 0, 1); PG8_STAGE(PG8_SB(0, 0), b2, voffB);
      PG8_BAR; PG8_WAIT_L(0); PG8_MMA(0, 1, At, B1); PG8_BAR;
      PG8_LDA(At, 0, 1); PG8_STAGE(PG8_SA(0, 0), a2, voffA);
      PG8_BAR; PG8_WAIT_L(0); PG8_MMA(1, 0, At, B0); PG8_BAR; PG8_SCHED;
      PG8_STAGE(PG8_SB(0, 1), b2 + hstep, voffB);
      PG8_WAIT_V(6); PG8_BAR; PG8_MMA(1, 1, At, B1); PG8_BAR;
      PG8_LDB(B0, 1, 0); PG8_SCHED; PG8_LDA(At, 1, 0); PG8_STAGE(PG8_SA(0, 1), a2 + hstep, voffA);
      PG8_WAIT_L(8); PG8_BAR; PG8_WAIT_L(0); PG8_MMA(0, 0, At, B0); PG8_BAR; PG8_SCHED;
      PG8_LDB(B1, 1, 1); PG8_STAGE(PG8_SB(1, 0), b3, voffB);
      PG8_BAR; PG8_WAIT_L(0); PG8_MMA(0, 1, At, B1); PG8_BAR;
      PG8_LDA(At, 1, 1); PG8_STAGE(PG8_SA(1, 0), a3, voffA);
      PG8_BAR; PG8_WAIT_L(0); PG8_MMA(1, 0, At, B0); PG8_BAR; PG8_SCHED;
      PG8_STAGE(PG8_SB(1, 1), b3 + hstep, voffB);
      PG8_WAIT_V(6); PG8_BAR; PG8_MMA(1, 1, At, B1); PG8_BAR;
    }
    E(acc, cur, wr, wc, fr, fq);
    if (!has_next) break;
#pragma unroll
    for (int a = 0; a < 2; ++a)
#pragma unroll
      for (int b = 0; b < 2; ++b)
#pragma unroll
        for (int m = 0; m < 4; ++m)
#pragma unroll
          for (int n = 0; n < 2; ++n) acc[a][b][m][n] = (f32x4){0.f, 0.f, 0.f, 0.f};
    cur = nxt; cA = nA; cB = nB; ++ui;
  }
  PG8_WAIT_V(0);
  if (wr == 0) PG8_BAR;
  PG8_BAR;
#undef PG8_SA
#undef PG8_SB
#undef PG8_STAGE
#undef PG8_LDA
#undef PG8_LDB
#undef PG8_MMA
#undef PG8_WAIT_V
#undef PG8_WAIT_L
#undef PG8_BAR
#undef PG8_SCHED
}
}

DI uint4 pack8(const f32x4& a, const f32x4& b) { return make_uint4(pk2(a[0], a[1]), pk2(a[2], a[3]), pk2(b[0], b[1]), pk2(b[2], b[3])); }

struct EpiInProj {
  static constexpr bool PERM = true;
  char* ws; int kind;
  DI void operator()(const f32x4 (&acc)[2][2][4][2], const pg8::Unit& u, int wr, int wc, int fr, int fq) const {
    char* big = ws + OFF_BIG;
    const float* cs = reinterpret_cast<const float*>(ws + OFF_COS);
    const float* sn = reinterpret_cast<const float*>(ws + OFF_SIN);
#pragma unroll
    for (int bj = 0; bj < 2; ++bj) {
      const int c32 = u.pn * 256 + bj * 128 + wc * 32;
      const int dd = (c32 & 63) + 8 * fq;
      if (c32 < 2304) {
        int sel, h;
        if (c32 < 768) { sel = 0; h = c32 >> 6; }
        else if (c32 < 1536) { sel = 1; h = (c32 - 768) >> 6; }
        else if (c32 < 1792) { sel = 2; h = (c32 - 1536) >> 6; }
        else { sel = 3; h = (c32 - 1792) >> 6; }
        const bool rope = sel != 2 && (c32 & 63) == 0 && fq < 2;
        f32x4 rc[2][4], rsn[2][4];
        if (rope) {
#pragma unroll
          for (int ai = 0; ai < 2; ++ai)
#pragma unroll
            for (int m = 0; m < 4; ++m) {
              const int row = u.pm * 256 + ai * 128 + wr * 64 + m * 16 + fr;
              rc[ai][m] = ldg4(cs + row * 8 + 4 * fq); rsn[ai][m] = ldg4(sn + row * 8 + 4 * fq);
            }
        }
#pragma unroll
        for (int ai = 0; ai < 2; ++ai)
#pragma unroll
          for (int m = 0; m < 4; ++m) {
            const int row = u.pm * 256 + ai * 128 + wr * 64 + m * 16 + fr;
            f32x4 a = acc[ai][bj][m][0], b = acc[ai][bj][m][1];
            if (rope) {
              const f32x4 na = a * rc[ai][m] - b * rsn[ai][m], nb = b * rc[ai][m] + a * rsn[ai][m];
              a = na; b = nb;
            }
            const int bb = row >> 12, s_ = row & 4095;
            size_t off;
            if (sel == 0) off = BO_Q + (((size_t)(bb * 12 + h) * S + s_) * 64 + dd) * 2;
            else if (sel == 1) off = BO_K + (((size_t)(bb * 12 + h) * S + s_) * 64 + dd) * 2;
            else if (sel == 2) off = (kind == 1 ? BO_QM_B : BO_QM_AC) + (((size_t)(bb * 4 + h) * S + s_) * 64 + dd) * 2;
            else off = BO_QI + (((size_t)row * 8 + h) * 64 + dd) * 2;
            stg16(big + off, pack8(a, b));
          }
      } else if (c32 < 2368) {
#pragma unroll
        for (int ai = 0; ai < 2; ++ai)
#pragma unroll
          for (int m = 0; m < 4; ++m) {
            const int row = u.pm * 256 + ai * 128 + wr * 64 + m * 16 + fr;
            float* dst = reinterpret_cast<float*>(big + BO_KIRAW) + (size_t)row * 64 + (c32 - 2304) + 8 * fq;
            stg16f(dst, acc[ai][bj][m][0]);
            stg16f(dst + 4, acc[ai][bj][m][1]);
          }
      } else if (c32 < 2400) {
        if (fq == 0) {
#pragma unroll
          for (int ai = 0; ai < 2; ++ai)
#pragma unroll
            for (int m = 0; m < 4; ++m) {
              const int row = u.pm * 256 + ai * 128 + wr * 64 + m * 16 + fr;
              float* dst = reinterpret_cast<float*>(big + BO_WI) + (size_t)row * 8;
              stg16f(dst, acc[ai][bj][m][0] * 0.04419417382415922f);
              stg16f(dst + 4, acc[ai][bj][m][1] * 0.04419417382415922f);
            }
        }
      }
    }
  }
};

struct EpiVt {
  static constexpr bool PERM = true;
  char* ws; int kind;
  DI void operator()(const f32x4 (&acc)[2][2][4][2], const pg8::Unit& u, int wr, int wc, int fr, int fq) const {
    char* big = ws + OFF_BIG;
#pragma unroll
    for (int ai = 0; ai < 2; ++ai)
#pragma unroll
      for (int m = 0; m < 4; ++m) {
        const int cv = u.pm * 256 + ai * 128 + wr * 64 + m * 16 + fr;
#pragma unroll
        for (int bj = 0; bj < 2; ++bj) {
          const int tok0 = u.pn * 256 + bj * 128 + wc * 32 + 8 * fq;
          const int bb = tok0 >> 12, s0 = tok0 & 4095;
          const f32x4 a = acc[ai][bj][m][0], b = acc[ai][bj][m][1];
          if (kind != 1) {
            const int h = cv >> 6, d = cv & 63;
            u16* vt = reinterpret_cast<u16*>(big + BO_V) + ((size_t)(bb * 12 + h) * 128 + (s0 >> 5)) * 2048 + d * 32 + (s0 & 31);
            stg16(vt, pack8(a, b));
          } else {
            const int hh = cv / 192, dv = cv % 192;
            u16* v0 = reinterpret_cast<u16*>(big + BO_V) + ((size_t)(bb * 4 + hh) * 128 + (s0 >> 5)) * 6144 + dv * 32 + (s0 & 31);
            stg16(v0, pack8(a, b));
            const int j4 = s0 >> 2, j16 = s0 >> 4, r0 = s0 & 15;
            u16* v1 = reinterpret_cast<u16*>(big + BO_V + SZ_QKV) + (((size_t)(bb * 4 + hh) * 4) * 32 + (j4 >> 5)) * 6144 + dv * 32 + (j4 & 31);
            u16* v2 = reinterpret_cast<u16*>(big + BO_V + 2 * SZ_QKV) + (((size_t)(bb * 4 + hh) * 16 + r0) * 8 + (j16 >> 5)) * 6144 + dv * 32 + (j16 & 31);
#pragma unroll
            for (int r = 0; r < 4; ++r) stg4(v1 + (size_t)r * 32 * 6144, pk2(a[r], b[r]));
#pragma unroll
            for (int i = 0; i < 4; ++i) { stg2(v2 + (size_t)i * 8 * 6144, f2bf(a[i])); stg2(v2 + (size_t)(i + 4) * 8 * 6144, f2bf(b[i])); }
          }
        }
      }
  }
};

struct EpiMemKV {
  static constexpr bool PERM = true;
  char* ws;
  DI void operator()(const f32x4 (&acc)[2][2][4][2], const pg8::Unit& u, int wr, int wc, int fr, int fq) const {
#pragma unroll
    for (int bj = 0; bj < 2; ++bj) {
      const int c32 = u.pn * 256 + bj * 128 + wc * 32;
      const int layer = c32 >> 9, c = c32 & 511;
      const int h = (c & 255) >> 6, dd = (c & 63) + 8 * fq;
      u16* mk = reinterpret_cast<u16*>(ws + OFF_MK + layer * SZ_MK);
      u16* mvt = reinterpret_cast<u16*>(ws + OFF_MVT + layer * SZ_MK);
#pragma unroll
      for (int ai = 0; ai < 2; ++ai)
#pragma unroll
        for (int m = 0; m < 4; ++m) {
          const int row = u.pm * 256 + ai * 128 + wr * 64 + m * 16 + fr;
          const int bb = row >> 8, n = row & 255;
          const f32x4 a = acc[ai][bj][m][0], b = acc[ai][bj][m][1];
          if (c < 256) {
            stg16(mk + ((size_t)(bb * 4 + h) * 256 + n) * 64 + dd, pack8(a, b));
          } else {
            u16* vt = mvt + ((size_t)(bb * 4 + h) * 8 + (n >> 5)) * 2048 + dd * 32 + (n & 31);
#pragma unroll
            for (int i = 0; i < 4; ++i) { stg2(vt + i * 32, f2bf(a[i])); stg2(vt + (i + 4) * 32, f2bf(b[i])); }
          }
        }
    }
  }
};

struct EpiResid {
  static constexpr bool PERM = false;
  const float* xsrc; float* out; const float2* stat; const float* g; const float* b;
  DI void operator()(const f32x4 (&acc)[2][2][4][2], const pg8::Unit& u, int wr, int wc, int fr, int fq) const {
    const int col0 = u.pn * 256 + wc * 32 + 4 * fq;
    f32x4 gg[2][2], bb[2][2];
    if (stat) {
#pragma unroll
      for (int bj = 0; bj < 2; ++bj)
#pragma unroll
        for (int n = 0; n < 2; ++n) { gg[bj][n] = ldg4(g + col0 + bj * 128 + n * 16); bb[bj][n] = ldg4(b + col0 + bj * 128 + n * 16); }
    }
#pragma unroll
    for (int h4 = 0; h4 < 4; ++h4) {
      const int ai = h4 >> 1, m0 = (h4 & 1) * 2;
      f32x4 xv[2][2][2]; float2 st[2];
#pragma unroll
      for (int mm = 0; mm < 2; ++mm) {
        const int row = u.pm * 256 + ai * 128 + wr * 64 + (m0 + mm) * 16 + fr;
        st[mm] = stat ? ldg2(stat + row) : make_float2(0.f, 1.f);
#pragma unroll
        for (int bj = 0; bj < 2; ++bj)
#pragma unroll
          for (int n = 0; n < 2; ++n) xv[mm][bj][n] = ldg4(xsrc + (size_t)row * 1024 + col0 + bj * 128 + n * 16);
      }
#pragma unroll
      for (int mm = 0; mm < 2; ++mm) {
        const int row = u.pm * 256 + ai * 128 + wr * 64 + (m0 + mm) * 16 + fr;
#pragma unroll
        for (int bj = 0; bj < 2; ++bj)
#pragma unroll
          for (int n = 0; n < 2; ++n) {
            f32x4 x = xv[mm][bj][n];
            if (stat) x = (x - st[mm].x) * st[mm].y * gg[bj][n] + bb[bj][n];
            stg16f(out + (size_t)row * 1024 + col0 + bj * 128 + n * 16, x * ALPHA + acc[ai][bj][m0 + mm][n]);
          }
      }
    }
  }
};

struct EpiSwiGLU {
  static constexpr bool PERM = true;
  u16* h;
  DI void operator()(const f32x4 (&acc)[2][2][4][2], const pg8::Unit& u, int wr, int wc, int fr, int fq) const {
    const int j0 = u.pn * 128 + wc * 32 + 8 * fq;
#pragma unroll
    for (int ai = 0; ai < 2; ++ai)
#pragma unroll
      for (int m = 0; m < 4; ++m) {
        const int row = u.pm * 256 + ai * 128 + wr * 64 + m * 16 + fr;
        f32x4 o[2];
#pragma unroll
        for (int n = 0; n < 2; ++n)
#pragma unroll
          for (int i = 0; i < 4; ++i) { const float g = acc[ai][0][m][n][i], uu = acc[ai][1][m][n][i]; o[n][i] = g * __builtin_amdgcn_rcpf(1.f + __expf(-g)) * uu; }
        stg16(h + (size_t)row * DFF + j0, pack8(o[0], o[1]));
      }
  }
};

DI void ln_phase(const Ctx& cx, float* xio, const float* __restrict__ g, const float* __restrict__ b, u16* xb, float2* stat, bool write_f32) {
  const int lane = cx.tid & 63, gw = cx.bid * WPB + __builtin_amdgcn_readfirstlane(cx.tid >> 6), nw = cx.nb * WPB;
  float4 gg[4], bb[4];
  for (int i = 0; i < 4; ++i) { gg[i] = *reinterpret_cast<const float4*>(g + (i * 64 + lane) * 4); bb[i] = *reinterpret_cast<const float4*>(b + (i * 64 + lane) * 4); }
  constexpr int RB = 4;
  for (int r0 = gw * RB; r0 < T; r0 += nw * RB) {
    float4 v[RB][4]; float s[RB], q[RB];
#pragma unroll
    for (int k = 0; k < RB; ++k) {
      const float4* row = reinterpret_cast<const float4*>(xio + (size_t)(r0 + k) * 1024);
      s[k] = 0.f;
#pragma unroll
      for (int i = 0; i < 4; ++i) { v[k][i] = row[i * 64 + lane]; s[k] += v[k][i].x + v[k][i].y + v[k][i].z + v[k][i].w; }
    }
#pragma unroll
    for (int k = 0; k < RB; ++k) s[k] = wave_sum(s[k]) * (1.f / 1024.f);
#pragma unroll
    for (int k = 0; k < RB; ++k) {
      q[k] = 0.f;
#pragma unroll
      for (int i = 0; i < 4; ++i) { float a = v[k][i].x - s[k], b2 = v[k][i].y - s[k], c = v[k][i].z - s[k], d = v[k][i].w - s[k]; q[k] += a * a + b2 * b2 + c * c + d * d; }
    }
#pragma unroll
    for (int k = 0; k < RB; ++k) q[k] = rsqrtf(wave_sum(q[k]) * (1.f / 1024.f) + LN_EPS);
    if (lane < RB) { float2 sv; sv.x = lane == 0 ? s[0] : lane == 1 ? s[1] : lane == 2 ? s[2] : s[3]; sv.y = lane == 0 ? q[0] : lane == 1 ? q[1] : lane == 2 ? q[2] : q[3]; stat[r0 + lane] = sv; }
#pragma unroll
    for (int k = 0; k < RB; ++k) {
      float4* row = reinterpret_cast<float4*>(xio + (size_t)(r0 + k) * 1024);
#pragma unroll
      for (int i = 0; i < 4; ++i) {
        float4 o;
        o.x = (v[k][i].x - s[k]) * q[k] * gg[i].x + bb[i].x; o.y = (v[k][i].y - s[k]) * q[k] * gg[i].y + bb[i].y;
        o.z = (v[k][i].z - s[k]) * q[k] * gg[i].z + bb[i].z; o.w = (v[k][i].w - s[k]) * q[k] * gg[i].w + bb[i].w;
        if (write_f32) row[i * 64 + lane] = o;
        *reinterpret_cast<uint2*>(xb + (size_t)(r0 + k) * 1024 + (i * 64 + lane) * 4) = make_uint2(pk2(o.x, o.y), pk2(o.z, o.w));
      }
    }
  }
}

template <int NDT> struct AttState { f32x16 o[NDT]; float m, l; };
template <int NDT> DI void att_init(AttState<NDT>& st) {
#pragma unroll
  for (int d = 0; d < NDT; ++d)
#pragma unroll
    for (int r = 0; r < 16; ++r) st.o[d][r] = 0.f;
  st.m = -1e30f; st.l = 0.f;
}
DI int pi_swap(int i) { return (i & 0x13) | ((i & 4) << 1) | ((i & 8) >> 1); }

template <int NDT> struct Frags { bf16x8 k[4]; bf16x8 v[NDT == 2 ? 4 : 1]; unsigned w; };
template <int NDT> DI void att_load(Frags<NDT>& f, const u16* krow, const u16* vt) {
#pragma unroll
  for (int c = 0; c < 4; ++c) f.k[c] = ld8(krow + c * 16);
  if (NDT == 2) {
#pragma unroll
    for (int d = 0; d < 2; ++d)
#pragma unroll
      for (int c = 0; c < 2; ++c) f.v[d * 2 + c] = ld8(vt + d * 1024 + c * 16);
  }
}
template <int NDT, class MaskP>
DI void att_compute(AttState<NDT>& st, const bf16x8 (&qf)[4], const Frags<NDT>& f, const u16* vt, const MaskP& maskp) {
  constexpr float CS = 0.18033688011112042f;
  f32x16 s;
#pragma unroll
  for (int r = 0; r < 16; ++r) s[r] = 0.f;
#pragma unroll
  for (int c = 0; c < 4; ++c) s = mfma32(f.k[c], qf[c], s);
  float mx = fmaxf(fmaxf(s[0], s[1]), s[2]);
#pragma unroll
  for (int r = 3; r < 15; r += 2) mx = fmaxf(fmaxf(mx, s[r]), s[r + 1]);
  mx = fmaxf(mx, s[15]);
  mx = red32_max(mx);
  constexpr float DEFER = 8.0f / CS;
  const bool upd = mx > st.m + DEFER;
  if (__any(upd)) {
    const float mnew = upd ? mx : st.m;
    const float alpha = __builtin_amdgcn_exp2f((st.m - mnew) * CS);
    st.l *= alpha; st.m = mnew;
#pragma unroll
    for (int d = 0; d < NDT; ++d)
#pragma unroll
      for (int r = 0; r < 16; ++r) st.o[d][r] *= alpha;
  }
  const float nb = -st.m * CS;
  float ps = 0.f;
#pragma unroll
  for (int r = 0; r < 16; ++r) { s[r] = maskp(r, __builtin_amdgcn_exp2f(fmaf(s[r], CS, nb))); ps += s[r]; }
  st.l += ps;
  bf16x8 pf[2];
#pragma unroll
  for (int c = 0; c < 2; ++c) {
    u32x4 t;
#pragma unroll
    for (int j = 0; j < 4; ++j) t[j] = pk2(s[8 * c + 2 * j], s[8 * c + 2 * j + 1]);
    pf[c] = __builtin_bit_cast(bf16x8, t);
  }
  if (NDT == 2) {
#pragma unroll
    for (int d = 0; d < 2; ++d)
#pragma unroll
      for (int c = 0; c < 2; ++c) st.o[d] = mfma32(f.v[d * 2 + c], pf[c], st.o[d]);
  } else {
    __builtin_amdgcn_sched_barrier(0);
#pragma unroll
    for (int d = 0; d < NDT; ++d) {
      if (d > 0 && (d & 1) == 0) __builtin_amdgcn_sched_barrier(0);
#pragma unroll
      for (int c = 0; c < 2; ++c) st.o[d] = mfma32(ld8(vt + d * 1024 + c * 16), pf[c], st.o[d]);
    }
  }
}
DI float mask_bit(unsigned w, int bit, float p) { int m; asm("v_bfe_i32 %0, %1, %2, 1" : "=v"(m) : "v"(w), "n"(bit)); return __uint_as_float(__float_as_uint(p) & (unsigned)m); }
template <int NDT, class KP, class VP, class WP, class MK>
DI void att_range(AttState<NDT>& st, const bf16x8 (&qf)[4], int k0, int k1, const KP& kp, const VP& vp, const WP& wp, const MK& mk) {
  if (NDT == 2) {
    Frags<NDT> f0, f1, f2;
    att_load<NDT>(f0, kp(k0), vp(k0)); f0.w = wp(k0);
    f1 = f0; f2 = f0;
    if (k0 + 1 <= k1) { att_load<NDT>(f1, kp(k0 + 1), vp(k0 + 1)); f1.w = wp(k0 + 1); }
#pragma unroll 1
    for (int kt = k0; kt <= k1; kt += 3) {
      if (kt + 2 <= k1) { att_load<NDT>(f2, kp(kt + 2), vp(kt + 2)); f2.w = wp(kt + 2); }
      att_compute<NDT>(st, qf, f0, vp(kt), mk(kt, f0.w));
      if (kt + 1 > k1) break;
      if (kt + 3 <= k1) { att_load<NDT>(f0, kp(kt + 3), vp(kt + 3)); f0.w = wp(kt + 3); }
      att_compute<NDT>(st, qf, f1, vp(kt + 1), mk(kt + 1, f1.w));
      if (kt + 2 > k1) break;
      if (kt + 4 <= k1) { att_load<NDT>(f1, kp(kt + 4), vp(kt + 4)); f1.w = wp(kt + 4); }
      att_compute<NDT>(st, qf, f2, vp(kt + 2), mk(kt + 2, f2.w));
    }
  } else {
    Frags<NDT> cur;
    att_load<NDT>(cur, kp(k0), vp(k0)); cur.w = wp(k0);
#pragma unroll 1
    for (int kt = k0; kt <= k1; ++kt) {
      Frags<NDT> nxt = cur;
      if (kt < k1) { att_load<NDT>(nxt, kp(kt + 1), vp(kt + 1)); nxt.w = wp(kt + 1); }
      att_compute<NDT>(st, qf, cur, vp(kt), mk(kt, cur.w));
      cur = nxt;
    }
  }
}

template <int NDT> DI void att_store(AttState<NDT>& st, u16* orow, int hf) {
  const float lt = red32_sum(st.l);
  const float inv = 1.f / lt;
#pragma unroll
  for (int d = 0; d < NDT; ++d)
#pragma unroll
    for (int g = 0; g < 4; ++g) {
      uint2 v = make_uint2(pk2(st.o[d][4 * g] * inv, st.o[d][4 * g + 1] * inv), pk2(st.o[d][4 * g + 2] * inv, st.o[d][4 * g + 3] * inv));
      *reinterpret_cast<uint2*>(orow + d * 32 + 8 * g + 4 * hf) = v;
    }
}

DI void load_q(bf16x8 (&qf)[4], const u16* qrow, int hf) {
#pragma unroll
  for (int c = 0; c < 4; ++c) qf[c] = ld8(qrow + c * 16 + 8 * hf);
}

DI void mem_att_unit(char* ws, int layer, int kind, int u, int lane) {
  const int qt = u & 127, bh = u >> 7, b = bh >> 2, hm = bh & 3;
  const int ql = lane & 31, hf = lane >> 5, tq = qt * 32 + ql;
  const u16* QM = reinterpret_cast<const u16*>(ws + OFF_BIG + (kind == 1 ? BO_QM_B : BO_QM_AC));
  const u16* MK = reinterpret_cast<const u16*>(ws + OFF_MK + layer * SZ_MK);
  const u16* MVT = reinterpret_cast<const u16*>(ws + OFF_MVT + layer * SZ_MK);
  bf16x8 qf[4]; load_q(qf, QM + ((size_t)bh * S + tq) * 64, hf);
  AttState<2> st; att_init(st);
  const int pk = pi_swap(ql);
  const u16* kb = MK + ((size_t)bh * 256 + pk) * 64 + 8 * hf;
  const u16* vb = MVT + ((size_t)bh * 8) * 2048 + ql * 32 + 8 * hf;
  int klast = 7; asm volatile("" : "+s"(klast));
  att_range<2>(st, qf, 0, klast,
               [kb](int kt) { return kb + kt * 2048; }, [vb](int kt) { return vb + kt * 2048; },
               [](int) { return 0u; }, [](int, unsigned) { return [](int, float p) { return p; }; });
  u16* mix = reinterpret_cast<u16*>(ws + OFF_MIX);
  att_store<2>(st, mix + (size_t)(b * S + tq) * 1024 + 768 + hm * 64, hf);
}

DI void dsa_att_unit(char* ws, int bh, int qt, int lane) {
  const int b = bh / 12, h = bh % 12;
  const int ql = lane & 31, hf = lane >> 5, tq = qt * 32 + ql;
  char* big = ws + OFF_BIG;
  const u16* Q = reinterpret_cast<const u16*>(big + BO_Q);
  const u16* K = reinterpret_cast<const u16*>(big + BO_K);
  const u16* VT = reinterpret_cast<const u16*>(big + BO_V);
  const unsigned* BM = reinterpret_cast<const unsigned*>(big + BO_BM) + (size_t)(b * S + tq) * 128;
  bf16x8 qf[4]; load_q(qf, Q + ((size_t)bh * S + tq) * 64, hf);
  AttState<2> st; att_init(st);
  const int pk = pi_swap(ql);
  const u16* kb = K + ((size_t)bh * S + pk) * 64 + 8 * hf;
  const u16* vb = VT + ((size_t)bh * 128) * 2048 + ql * 32 + 8 * hf;
  const int sh = 8 * hf;
  att_range<2>(st, qf, 0, qt,
               [kb](int kt) { return kb + kt * 2048; }, [vb](int kt) { return vb + kt * 2048; },
               [BM](int kt) { return ldg32(BM + kt); },
               [sh](int, unsigned w) { const unsigned ws_ = w >> sh; return [ws_](int r, float p) { return mask_bit(ws_, 16 * (r >> 3) + (r & 7), p); }; });
  u16* mix = reinterpret_cast<u16*>(ws + OFF_MIX);
  att_store<2>(st, mix + (size_t)(b * S + tq) * 1024 + h * 64, hf);
}

DI void moba_att_unit(char* ws, int bh, int qt, int lane) {
  const int b = bh / 12, h = bh % 12;
  const int ql = lane & 31, hf = lane >> 5, tq = qt * 32 + ql;
  char* big = ws + OFF_BIG;
  const u16* Q = reinterpret_cast<const u16*>(big + BO_Q);
  const u16* K = reinterpret_cast<const u16*>(big + BO_K);
  const u16* VT = reinterpret_cast<const u16*>(big + BO_V);
  const float* KM = reinterpret_cast<const float*>(ws + OFF_KMEAN) + (size_t)bh * 16 * 64;
  const u16* qrow = Q + ((size_t)bh * S + tq) * 64;
  bf16x8 qf[4]; load_q(qf, qrow, hf);
  const int own = qt >> 3;
  unsigned selmask = 0u;
  {
    float b0 = -3e38f, b1 = -3e38f, b2 = -3e38f; int i0 = -1, i1 = -1, i2 = -1;
    for (int n = 0; n < own; ++n) {
      float g = 0.f;
      for (int d8 = 0; d8 < 8; ++d8) {
        const u32x4 qq = *reinterpret_cast<const u32x4*>(qrow + d8 * 8);
        const float4 ka = *reinterpret_cast<const float4*>(KM + n * 64 + d8 * 8);
        const float4 kb = *reinterpret_cast<const float4*>(KM + n * 64 + d8 * 8 + 4);
        g += __uint_as_float(qq[0] << 16) * ka.x + __uint_as_float(qq[0] & 0xffff0000u) * ka.y
           + __uint_as_float(qq[1] << 16) * ka.z + __uint_as_float(qq[1] & 0xffff0000u) * ka.w
           + __uint_as_float(qq[2] << 16) * kb.x + __uint_as_float(qq[2] & 0xffff0000u) * kb.y
           + __uint_as_float(qq[3] << 16) * kb.z + __uint_as_float(qq[3] & 0xffff0000u) * kb.w;
      }
      if (g > b0) { b2 = b1; i2 = i1; b1 = b0; i1 = i0; b0 = g; i0 = n; }
      else if (g > b1) { b2 = b1; i2 = i1; b1 = g; i1 = n; }
      else if (g > b2) { b2 = g; i2 = n; }
    }
    if (i0 >= 0) selmask |= 1u << i0;
    if (i1 >= 0) selmask |= 1u << i1;
    if (i2 >= 0) selmask |= 1u << i2;
  }
  AttState<2> st; att_init(st);
  const int pk = pi_swap(ql);
  const u16* kb = K + ((size_t)bh * S + pk) * 64 + 8 * hf;
  const u16* vb = VT + ((size_t)bh * 128) * 2048 + ql * 32 + 8 * hf;
  for (int n = 0; n < own; ++n) {
    const unsigned minew = ((selmask >> n) & 1u) ? 0xffffffffu : 0u;
    if (!__any(minew != 0u)) continue;
    att_range<2>(st, qf, n * 8, n * 8 + 7,
                 [kb](int kt) { return kb + kt * 2048; }, [vb](int kt) { return vb + kt * 2048; },
                 [minew](int) { return minew; }, [](int, unsigned w) { return [w](int, float p) { return w != 0u ? p : 0.f; }; });
  }
  att_range<2>(st, qf, own * 8, qt,
               [kb](int kt) { return kb + kt * 2048; }, [vb](int kt) { return vb + kt * 2048; },
               [](int) { return 0u; },
               [hf, tq](int kt, unsigned) { const int dq = tq - (kt * 32 + 8 * hf); return [dq](int r, float p) { return 16 * (r >> 3) + (r & 7) <= dq ? p : 0.f; }; });
  u16* mix = reinterpret_cast<u16*>(ws + OFF_MIX);
  att_store<2>(st, mix + (size_t)(b * S + tq) * 1024 + h * 64, hf);
}

template <bool DSA>
DI void blk_att_unit(char* ws, char* smem, int wid, int lane, int bh, int Qb) {
  typedef __attribute__((address_space(3))) unsigned char* lds_p;
  typedef __attribute__((address_space(3))) unsigned* lds_u32p;
  constexpr int D = 6, R = 8, SLOT = 10240;
  lds_p lds = (lds_p)smem;
  const int b = bh / 12, h = bh % 12;
  const int ql = lane & 31, hf = lane >> 5, qt = Qb * 8 + wid, tq = qt * 32 + ql, nkt = Qb * 8 + 8;
  char* big = ws + OFF_BIG;
  const u16* Q = reinterpret_cast<const u16*>(big + BO_Q);
  const u16* K = reinterpret_cast<const u16*>(big + BO_K);
  const u16* VT = reinterpret_cast<const u16*>(big + BO_V);
  const u16* qrow = Q + ((size_t)bh * S + tq) * 64;
  bf16x8 qf[4]; load_q(qf, qrow, hf);
  unsigned selmask = 0u;
  if (!DSA) {
    const u16* KMB = reinterpret_cast<const u16*>(ws + OFF_KMEANB) + (size_t)bh * 16 * 64 + 8 * hf;
    f32x16 ga, gb;
#pragma unroll
    for (int r = 0; r < 16; ++r) { ga[r] = 0.f; gb[r] = 0.f; }
#pragma unroll
    for (int c = 0; c < 4; ++c) {
      ga = mfma32(ld8(KMB + (ql & 15) * 64 + c * 16), qf[c], ga);
      gb = mfma32(ld8(KMB + ((ql & 15) ^ 4) * 64 + c * 16), qf[c], gb);
    }
    float b0 = -3e38f, b1 = -3e38f, b2 = -3e38f; int i0 = -1, i1 = -1, i2 = -1;
#pragma unroll
    for (int r = 0; r < 8; ++r) {
#pragma unroll
      for (int t = 0; t < 2; ++t) {
        const int n = ((r & 3) + 8 * (r >> 2) + 4 * hf) ^ (4 * t);
        const float g = (n < Qb) ? (t == 0 ? ga[r] : gb[r]) : -3e38f;
        const bool c0 = g > b0, c1 = g > b1, c2 = g > b2;
        const float nb2 = c1 ? b1 : (c2 ? g : b2); const int ni2 = c1 ? i1 : (c2 ? n : i2);
        const float nb1 = c0 ? b0 : (c1 ? g : b1); const int ni1 = c0 ? i0 : (c1 ? n : i1);
        const float nb0 = c0 ? g : b0;             const int ni0 = c0 ? n : i0;
        b0 = nb0; b1 = nb1; b2 = nb2; i0 = ni0; i1 = ni1; i2 = ni2;
      }
    }
    if (b0 > -1e38f) selmask |= 1u << i0;
    if (b1 > -1e38f) selmask |= 1u << i1;
    if (b2 > -1e38f) selmask |= 1u << i2;
  }
  const char* src;
  {
    const int p = (wid & 3) * 64 + lane;
    if (wid < 4) { const int r = p >> 3, lc = (p & 7) ^ ((r >> 1) & 7); src = reinterpret_cast<const char*>(K + ((size_t)bh * S + r) * 64 + lc * 8); }
    else { const int d = p >> 2, lc = (p & 3) ^ ((d >> 2) & 3); src = reinterpret_cast<const char*>(VT + (size_t)bh * 128 * 2048 + d * 32 + lc * 8); }
  }
  const char* msrc = big + BO_BM + ((size_t)(b * S + Qb * 256 + ((wid & 3) * 64 + lane)) * 128) * 4;
  const unsigned ldsw = (unsigned)wid * 1024u, ldsm = 8192u + (unsigned)wid * 256u;
#define BA_ISSUE(kt_) do { const unsigned _sb = (unsigned)(((kt_) & (R - 1)) * SLOT); \
    __builtin_amdgcn_global_load_lds((const unsigned*)(src + (size_t)(kt_) * 4096), (lds_u32p)(lds + _sb + ldsw), 16, 0, 0); \
    if (DSA) __builtin_amdgcn_global_load_lds((const unsigned*)(msrc + (size_t)(kt_) * 4), (lds_u32p)(lds + _sb + ldsm), 4, 0, 0); } while (0)
#define BA_WAIT(n) asm volatile("s_waitcnt vmcnt(" #n ")" ::: "memory")
  int koff[4], voff[4];
  {
    const int kr = pi_swap(ql);
#pragma unroll
    for (int c = 0; c < 4; ++c) koff[c] = kr * 128 + (((2 * c + hf) ^ ((kr >> 1) & 7)) << 4);
#pragma unroll
    for (int dt = 0; dt < 2; ++dt)
#pragma unroll
      for (int c = 0; c < 2; ++c) { const int d = dt * 32 + ql; voff[dt * 2 + c] = 4096 + d * 64 + (((2 * c + hf) ^ ((d >> 2) & 3)) << 4); }
  }
  const int moff = 8192 + (wid * 32 + ql) * 4;
  AttState<2> st; att_init(st);
  asm volatile("" :: "v"(qf[0]), "v"(qf[1]), "v"(qf[2]), "v"(qf[3]));
  __builtin_amdgcn_s_barrier();
#pragma unroll
  for (int i = 0; i < D; ++i) BA_ISSUE(i);
  for (int kt = 0; kt < nkt; ++kt) {
    if (kt + D < nkt) BA_ISSUE(kt + D);
    int rem = nkt - 1 - kt; rem = rem > D ? D : rem;
    if (DSA) {
      switch (rem) { case 6: BA_WAIT(12); break; case 5: BA_WAIT(10); break; case 4: BA_WAIT(8); break; case 3: BA_WAIT(6); break;
                     case 2: BA_WAIT(4); break; case 1: BA_WAIT(2); break; default: BA_WAIT(0); break; }
    } else {
      switch (rem) { case 6: BA_WAIT(6); break; case 5: BA_WAIT(5); break; case 4: BA_WAIT(4); break; case 3: BA_WAIT(3); break;
                     case 2: BA_WAIT(2); break; case 1: BA_WAIT(1); break; default: BA_WAIT(0); break; }
    }
    __builtin_amdgcn_s_barrier();
    if (kt > qt) continue;
    unsigned wmask = 0xffffffffu;
    if (!DSA && kt < Qb * 8) {
      wmask = ((selmask >> (kt >> 3)) & 1u) ? 0xffffffffu : 0u;
      if (!__any(wmask != 0u)) continue;
    }
    lds_p img = lds + (kt & (R - 1)) * SLOT;
    Frags<2> f;
#pragma unroll
    for (int c = 0; c < 4; ++c) f.k[c] = *(const __attribute__((address_space(3))) bf16x8*)(img + koff[c]);
#pragma unroll
    for (int c = 0; c < 4; ++c) f.v[c] = *(const __attribute__((address_space(3))) bf16x8*)(img + voff[c]);
    if (DSA) {
      const unsigned w_ = (*(const __attribute__((address_space(3))) unsigned*)(img + moff)) >> (8 * hf);
      att_compute<2>(st, qf, f, nullptr, [w_](int r, float p) { return mask_bit(w_, 16 * (r >> 3) + (r & 7), p); });
    } else if (kt < Qb * 8) {
      att_compute<2>(st, qf, f, nullptr, [wmask](int, float p) { return wmask != 0u ? p : 0.f; });
    } else {
      const int dq = tq - (kt * 32 + 8 * hf);
      att_compute<2>(st, qf, f, nullptr, [dq](int r, float p) { return 16 * (r >> 3) + (r & 7) <= dq ? p : 0.f; });
    }
  }
#undef BA_ISSUE
#undef BA_WAIT
  u16* mix = reinterpret_cast<u16*>(ws + OFF_MIX);
  att_store<2>(st, mix + (size_t)(b * S + tq) * 1024 + h * 64, hf);
}

DI void dil_att_unit(char* ws, int u, int lane) {
  const int r16 = u & 15, T0 = (u >> 4) & 7, bhh = u >> 7, b = bhh >> 2, hh = bhh & 3;
  const int ql = lane & 31, hf = lane >> 5;
  const int tq = T0 * 512 + 16 * ql + r16;
  char* big = ws + OFF_BIG;
  const u16* Q = reinterpret_cast<const u16*>(big + BO_Q);
  const u16* K = reinterpret_cast<const u16*>(big + BO_K);
  AttState<6> st; att_init(st);
  const int pk = pi_swap(ql);
  for (int g = 0; g < 3; ++g) {
    const int sh = 2 * g, dil = 1 << sh, r = r16 & (dil - 1);
    const int bh = b * 12 + 4 * g + hh;
    bf16x8 qf[4];
    load_q(qf, Q + ((size_t)bh * S + tq) * 64, hf);
    const int jq = tq >> sh;
    const int jmin = (T0 * 512 + r16) >> sh, jmax = (T0 * 512 + 496 + r16) >> sh;
    int k0 = jmin - 128; k0 = k0 < 0 ? 0 : k0 >> 5;
    const u16* Vg = reinterpret_cast<const u16*>(big + BO_V + (size_t)g * SZ_QKV) + ((size_t)(bhh * dil + r) * (128 >> sh)) * 6144 + ql * 32 + 8 * hf;
    const u16* Kg = K + ((size_t)bh * S + r) * 64 + 8 * hf;
    att_range<6>(st, qf, k0, jmax >> 5,
                 [Kg, pk, sh](int jt) { return Kg + ((size_t)((jt * 32 + pk) << sh)) * 64; },
                 [Vg](int jt) { return Vg + (size_t)jt * 6144; },
                 [](int) { return 0u; },
                 [hf, jq](int jt, unsigned) { const int dq = jq - (jt * 32 + 8 * hf); return [dq](int rr, float p) { return (unsigned)(dq - (16 * (rr >> 3) + (rr & 7))) <= 128u ? p : 0.f; }; });
  }
  u16* mix = reinterpret_cast<u16*>(ws + OFF_MIX);
  att_store<6>(st, mix + (size_t)(b * S + tq) * 1024 + hh * 192, hf);
}

DI void ki_prep_phase(const Ctx& cx, char* ws, const float* g, const float* bta) {
  const int lane = cx.tid & 63, gw = cx.bid * WPB + __builtin_amdgcn_readfirstlane(cx.tid >> 6), nw = cx.nb * WPB;
  const float* raw = reinterpret_cast<const float*>(ws + OFF_BIG + BO_KIRAW);
  u16* kib = reinterpret_cast<u16*>(ws + OFF_BIG + BO_KIB);
  const float* cs = reinterpret_cast<const float*>(ws + OFF_COS);
  const float* sn = reinterpret_cast<const float*>(ws + OFF_SIN);
  const float gg = g[lane], bb = bta[lane];
  constexpr int RB = 4;
  for (int r0 = gw * RB; r0 < T; r0 += nw * RB) {
    float v[RB], c[RB], s[RB];
#pragma unroll
    for (int k = 0; k < RB; ++k) {
      v[k] = raw[(size_t)(r0 + k) * 64 + lane];
      c[k] = cs[(r0 + k) * 8 + (lane & 7)]; s[k] = sn[(r0 + k) * 8 + (lane & 7)];
    }
    float mu[RB], d[RB], rs[RB];
#pragma unroll
    for (int k = 0; k < RB; ++k) mu[k] = wave_sum(v[k]) * (1.f / 64.f);
#pragma unroll
    for (int k = 0; k < RB; ++k) { d[k] = v[k] - mu[k]; rs[k] = rsqrtf(wave_sum(d[k] * d[k]) * (1.f / 64.f) + LN_EPS); }
#pragma unroll
    for (int k = 0; k < RB; ++k) {
      float y = d[k] * rs[k] * gg + bb;
      const float py = sx<8>(y);
      if (lane < 16) y = lane < 8 ? y * c[k] - py * s[k] : y * c[k] + py * s[k];
      kib[(size_t)(r0 + k) * 64 + rope_pos(lane)] = f2bf(y);
    }
  }
}

DI float relu1(float x) { return __builtin_amdgcn_fmed3f(x, 0.f, 3.0e38f); }
DI unsigned sortable(float f) { unsigned u = __float_as_uint(f); u = (u & 0x80000000u) ? ~u : (u | 0x80000000u); return u & ~((1u << SEL_LOW_BIT) - 1u); }

DI int wave_total(int v) {
  v += __builtin_amdgcn_update_dpp(0, v, 0x111, 0xf, 0xf, true);
  v += __builtin_amdgcn_update_dpp(0, v, 0x112, 0xf, 0xf, true);
  v += __builtin_amdgcn_update_dpp(0, v, 0x114, 0xf, 0xf, true);
  v += __builtin_amdgcn_update_dpp(0, v, 0x118, 0xf, 0xf, true);
  v += __builtin_amdgcn_update_dpp(0, v, 0x142, 0xa, 0xf, true);
  v += __builtin_amdgcn_update_dpp(0, v, 0x143, 0xc, 0xf, true);
  return __builtin_amdgcn_readlane(v, 63);
}

DI unsigned long long select256(const unsigned (&u)[64], int lane) {
  unsigned th = 0u;
  int g = 0;
  for (int bit = 31; bit >= SEL_LOW_BIT; --bit) {
    const unsigned c = th | (1u << bit);
    int cnt = 0;
#pragma unroll
    for (int r = 0; r < 64; r += 8)
      asm("v_cmp_le_u32 vcc, %1, %2\n\tv_addc_co_u32 %0, vcc, 0, %0, vcc\n\t"
          "v_cmp_le_u32 vcc, %1, %3\n\tv_addc_co_u32 %0, vcc, 0, %0, vcc\n\t"
          "v_cmp_le_u32 vcc, %1, %4\n\tv_addc_co_u32 %0, vcc, 0, %0, vcc\n\t"
          "v_cmp_le_u32 vcc, %1, %5\n\tv_addc_co_u32 %0, vcc, 0, %0, vcc\n\t"
          "v_cmp_le_u32 vcc, %1, %6\n\tv_addc_co_u32 %0, vcc, 0, %0, vcc\n\t"
          "v_cmp_le_u32 vcc, %1, %7\n\tv_addc_co_u32 %0, vcc, 0, %0, vcc\n\t"
          "v_cmp_le_u32 vcc, %1, %8\n\tv_addc_co_u32 %0, vcc, 0, %0, vcc\n\t"
          "v_cmp_le_u32 vcc, %1, %9\n\tv_addc_co_u32 %0, vcc, 0, %0, vcc"
          : "+v"(cnt) : "s"(c), "v"(u[r]), "v"(u[r + 1]), "v"(u[r + 2]), "v"(u[r + 3]), "v"(u[r + 4]), "v"(u[r + 5]), "v"(u[r + 6]), "v"(u[r + 7]) : "vcc");
    const int n = wave_total(cnt);
    if (n == 256) { th = c - 1u; g = 256; break; }
    if (n > 256) th = c; else g = n;
  }
  int need = th == 0u ? 0 : 256 - g;
  int mlo = 0, mhi = 0;
#pragma unroll
  for (int r = 0; r < 64; ++r) {
    const unsigned long long gt = __ballot(u[r] > th), eq = __ballot(u[r] == th);
    unsigned long long tk = 0ull;
    if (need > 0 && eq != 0ull) {
      const int pre = __builtin_amdgcn_mbcnt_hi((unsigned)(eq >> 32), __builtin_amdgcn_mbcnt_lo((unsigned)eq, 0u));
      tk = __ballot(u[r] == th && pre < need);
      need -= __popcll(tk);
    }
    const unsigned long long mv = gt | tk;
    asm volatile("s_nop 3\n\tv_writelane_b32 %0, %2, %4\n\tv_writelane_b32 %1, %3, %4" : "+v"(mlo), "+v"(mhi) : "s"((unsigned)mv), "s"((unsigned)(mv >> 32)), "n"(r));
  }
  return ((unsigned long long)(unsigned)mhi << 32) | (unsigned)mlo;
}

DI void dsa_select_block(char* ws, char* smem, int wid, int lane, int b, int t0, int gwave) {
  typedef __attribute__((address_space(3))) unsigned char* lds_p;
  lds_p lds = (lds_p)smem;
  char* big = ws + OFF_BIG;
  const u16* QI = reinterpret_cast<const u16*>(big + BO_QI);
  const char* kbase = big + BO_KIB + (size_t)b * S * 128;
  const float* WI = reinterpret_cast<const float*>(big + BO_WI);
  unsigned long long* BM = reinterpret_cast<unsigned long long*>(big + BO_BM);
  unsigned* scr = reinterpret_cast<unsigned*>(big + BO_SCR) + (size_t)gwave * 4096 + lane;
  const int tA = t0 + 2 * wid, nch = ((t0 + 15) >> 8) + 1;
  const int row = lane & 15, kq = lane >> 4, tid = wid * 64 + lane;
  const u16* qip = QI + ((size_t)(b * S + tA + (row >> 3)) * 8 + (row & 7)) * 64 + kq * 8;
  const bf16x8 qa0 = ld8(qip), qa1 = ld8(qip + 32);
  const float4 w = *reinterpret_cast<const float4*>(WI + (size_t)(b * S + tA + (kq >> 1)) * 8 + (kq & 1) * 4);
  unsigned soff[4];
#pragma unroll
  for (int i = 0; i < 4; ++i) { const int p = i * 512 + tid, r = p >> 3, lc = (p & 7) ^ ((r >> 1) & 7); soff[i] = (unsigned)(r * 128 + lc * 16); }
  const unsigned ldsw = (unsigned)wid * 1024u;
#define SEL_ISSUE(c, slot) do { _Pragma("unroll") for (int _i = 0; _i < 4; ++_i) \
    __builtin_amdgcn_global_load_lds((const unsigned*)(kbase + (size_t)(c) * 32768 + soff[_i]), (__attribute__((address_space(3))) unsigned*)(lds + (slot) * 32768 + _i * 8192 + ldsw), 16, 0, 0); } while (0)
#define SEL_WAIT(n) asm volatile("s_waitcnt vmcnt(" #n ")" ::: "memory")
  int boff[2];
#pragma unroll
  for (int kk = 0; kk < 2; ++kk) boff[kk] = row * 128 + (((kk * 4 + kq) ^ ((row >> 1) & 7)) << 4);
  asm volatile("" :: "v"(qa0), "v"(qa1), "v"(w.x), "v"(w.y), "v"(w.z), "v"(w.w));
  __builtin_amdgcn_s_barrier();
  SEL_ISSUE(0, 0);
  if (nch > 1) SEL_ISSUE(1, 1);
  unsigned u[64];
#pragma unroll
  for (int c = 0; c < 16; ++c) {
    if (c < nch) {
      if (c + 2 < nch) { SEL_ISSUE(c + 2, (c + 2) & 3); SEL_WAIT(8); }
      else if (c + 1 < nch) SEL_WAIT(4);
      else SEL_WAIT(0);
      __builtin_amdgcn_s_barrier();
      lds_p img = lds + (c & 3) * 32768;
#pragma unroll
      for (int rr = 0; rr < 4; ++rr) {
        const int r = c * 4 + rr;
        float sa[4], sb[4];
        bf16x8 kb0[4], kb1[4];
#pragma unroll
        for (int tt = 0; tt < 4; ++tt) {
          const int tile = rr * 4 + tt;
          kb0[tt] = *(const __attribute__((address_space(3))) bf16x8*)(img + tile * 2048 + boff[0]);
          kb1[tt] = *(const __attribute__((address_space(3))) bf16x8*)(img + tile * 2048 + boff[1]);
        }
        f32x4 cc[4];
#pragma unroll
        for (int tt = 0; tt < 4; ++tt) cc[tt] = mfma16(qa0, kb0[tt], f32x4{0.f, 0.f, 0.f, 0.f});
#pragma unroll
        for (int tt = 0; tt < 4; ++tt) cc[tt] = mfma16(qa1, kb1[tt], cc[tt]);
        float pp[4], ps[4];
#pragma unroll
        for (int tt = 0; tt < 4; ++tt) pp[tt] = w.x * relu1(cc[tt][0]) + w.y * relu1(cc[tt][1]) + w.z * relu1(cc[tt][2]) + w.w * relu1(cc[tt][3]);
#pragma unroll
        for (int tt = 0; tt < 4; ++tt) ps[tt] = sx<16>(pp[tt]);
#pragma unroll
        for (int tt = 0; tt < 4; ++tt) {
          const float pt = pp[tt] + ps[tt];
          const int iv = __builtin_bit_cast(int, pt); int iw = iv; asm volatile("" : "+v"(iw));
          auto sw = __builtin_amdgcn_permlane32_swap(iv, iw, false, false);
          sa[tt] = __builtin_bit_cast(float, (int)sw[0]); sb[tt] = __builtin_bit_cast(float, (int)sw[1]);
        }
        const float scA = kq == 0 ? sa[0] : kq == 1 ? sa[1] : kq == 2 ? sa[2] : sa[3];
        const float scB = kq == 0 ? sb[0] : kq == 1 ? sb[1] : kq == 2 ? sb[2] : sb[3];
        const int key = r * 64 + lane;
        u[r] = key <= tA ? sortable(scA) : 0u;
        stg4(scr + r * 64, key <= tA + 1 ? sortable(scB) : 0u);
      }
    } else {
#pragma unroll
      for (int rr = 0; rr < 4; ++rr) { u[c * 4 + rr] = 0u; stg4(scr + (c * 4 + rr) * 64, 0u); }
    }
  }
#undef SEL_ISSUE
#undef SEL_WAIT
  const unsigned long long mA = select256(u, lane);
  stg8(BM + (size_t)(b * S + tA) * 64 + lane, make_uint2((unsigned)mA, (unsigned)(mA >> 32)));
#pragma unroll
  for (int r = 0; r < 64; ++r) u[r] = ldg32(scr + r * 64);
  const unsigned long long mB = select256(u, lane);
  stg8(BM + (size_t)(b * S + tA + 1) * 64 + lane, make_uint2((unsigned)mB, (unsigned)(mB >> 32)));
}

DI void kmean_phase(const Ctx& cx, char* ws) {
  const int lane = cx.tid & 63, gw = cx.bid * WPB + __builtin_amdgcn_readfirstlane(cx.tid >> 6), nw = cx.nb * WPB;
  const u16* K = reinterpret_cast<const u16*>(ws + OFF_BIG + BO_K);
  float* KM = reinterpret_cast<float*>(ws + OFF_KMEAN);
  for (int u = gw; u < NB * 12 * 16; u += nw) {
    const int bh = u >> 4, blk = u & 15;
    const u16* kp = K + ((size_t)bh * S + blk * 256) * 64 + lane * 8;
    float acc[8];
#pragma unroll
    for (int j = 0; j < 8; ++j) acc[j] = 0.f;
#pragma unroll 8
    for (int i = 0; i < 32; ++i) {
      const u32x4 v = __builtin_bit_cast(u32x4, ld8(kp + i * 512));
#pragma unroll
      for (int j = 0; j < 4; ++j) { acc[2 * j] += __uint_as_float(v[j] << 16); acc[2 * j + 1] += __uint_as_float(v[j] & 0xffff0000u); }
    }
#pragma unroll
    for (int j = 0; j < 8; ++j) { float a = acc[j]; a += sx<8>(a); a += sx<16>(a); a = red32_sum(a); acc[j] = a * (1.f / 256.f); }
    if (lane < 8) {
      float* dst = KM + (size_t)u * 64 + lane * 8;
      *reinterpret_cast<float4*>(dst) = make_float4(acc[0], acc[1], acc[2], acc[3]);
      *reinterpret_cast<float4*>(dst + 4) = make_float4(acc[4], acc[5], acc[6], acc[7]);
      *reinterpret_cast<uint4*>(reinterpret_cast<u16*>(ws + OFF_KMEANB) + (size_t)u * 64 + lane * 8) =
          make_uint4(pk2(acc[0], acc[1]), pk2(acc[2], acc[3]), pk2(acc[4], acc[5]), pk2(acc[6], acc[7]));
    }
  }
}

DI void grid_barrier(unsigned* cnt, unsigned target, int tid) {
  asm volatile("s_waitcnt vmcnt(0)" ::: "memory");
  __syncthreads();
  if (tid == 0) {
    __builtin_amdgcn_fence(__ATOMIC_RELEASE, "agent");
    asm volatile("s_waitcnt vmcnt(0)" ::: "memory");
    __hip_atomic_fetch_add(cnt, 1u, __ATOMIC_RELAXED, __HIP_MEMORY_SCOPE_AGENT);
    while (__hip_atomic_load(cnt, __ATOMIC_RELAXED, __HIP_MEMORY_SCOPE_AGENT) < target) __builtin_amdgcn_s_sleep(1);
    __builtin_amdgcn_fence(__ATOMIC_ACQUIRE, "agent");
    asm volatile("s_waitcnt vmcnt(0)" ::: "memory");
  }
  __syncthreads();
}

#define XB_TMO      128
#define XB_XCNT(j)  (256  + 64 * (j))
#define XB_XSUB(j)  (1280 + 64 * (j))
#define XB_XGEN(j)  (2304 + 64 * (j))
#define XB_TOP      3328
#define XB_TOPGEN   3392
#define XB_SPIN_CAP (1u << 20)
DI unsigned xb_ld(unsigned* p) { return __hip_atomic_load(p, __ATOMIC_RELAXED, __HIP_MEMORY_SCOPE_AGENT); }
DI unsigned xb_add(unsigned* p, unsigned v) { return __hip_atomic_fetch_add(p, v, __ATOMIC_RELAXED, __HIP_MEMORY_SCOPE_AGENT); }
DI unsigned xb_xcc_id() { return (unsigned)__builtin_amdgcn_s_getreg((3 << 11) | 20) & 0xFu; }
#define XB_SPIN(cond, bar) do { unsigned _sp = 0; while (cond) { __builtin_amdgcn_s_sleep(1); \
    if ((++_sp & 255u) == 0u) { if (xb_ld(&(bar)[XB_TMO])) break; if (_sp > XB_SPIN_CAP) { atomicAdd(&(bar)[XB_TMO], 1u); break; } } } } while (0)
typedef volatile __attribute__((address_space(3))) unsigned* xb_lds_p;
DI void xcd_barrier_complete(unsigned* bar, unsigned x, unsigned G, unsigned& nloc, unsigned& nx) {
  unsigned sum, cnt, mine, sp = 0u;
  for (;;) {
    sum = 0u; cnt = 0u; mine = 0u;
#pragma unroll
    for (unsigned j = 0; j < 16; ++j) { const unsigned c = xb_ld(&bar[XB_XCNT(j)]); sum += c; cnt += (c > 0u) ? 1u : 0u; mine = (j == x) ? c : mine; }
    if (sum == G) break;
    __builtin_amdgcn_s_sleep(1);
    if ((++sp & 255u) == 0u) { if (xb_ld(&bar[XB_TMO])) break; if (sp > XB_SPIN_CAP) { atomicAdd(&bar[XB_TMO], 1u); break; } }
  }
  nloc = mine > 0u ? mine : 1u; nx = cnt > 0u ? cnt : 1u;
}
DI void xcd_barrier(unsigned* bar, unsigned x, xb_lds_p st, unsigned G, int tid) {
  asm volatile("s_waitcnt vmcnt(0)" ::: "memory");
  __syncthreads();
  if (tid == 0) {
    __builtin_amdgcn_s_waitcnt(0);
    unsigned nloc = st[0], nx = st[1];
    if (nloc == 0u) { xcd_barrier_complete(bar, x, G, nloc, nx); st[0] = nloc; st[1] = nx; }
    const unsigned old = xb_add(&bar[XB_XSUB(x)], 1u);
    const unsigned gen = old / nloc;
    if (old + 1u == (gen + 1u) * nloc) {
      __builtin_amdgcn_fence(__ATOMIC_RELEASE, "agent");
      asm volatile("s_waitcnt vmcnt(0)" ::: "memory");
      const unsigned og = xb_add(&bar[XB_TOP], 1u);
      const unsigned tg = og / nx;
      if (og + 1u == (tg + 1u) * nx) xb_add(&bar[XB_TOPGEN], 1u);
      else XB_SPIN(xb_ld(&bar[XB_TOPGEN]) == tg, bar);
      __builtin_amdgcn_fence(__ATOMIC_ACQUIRE, "agent");
      xb_add(&bar[XB_XGEN(x)], 1u);
      asm volatile("s_waitcnt vmcnt(0)" ::: "memory");
    } else {
      XB_SPIN(xb_ld(&bar[XB_XGEN(x)]) == gen, bar);
      __builtin_amdgcn_fence(__ATOMIC_ACQUIRE, "agent");
      asm volatile("s_waitcnt vmcnt(0)" ::: "memory");
    }
  }
  __syncthreads();
}

template <class Epi>
DI void run_gemm(const Ctx& cx, char* smem, const u16* A, const u16* Bt, int M, int N, int K, int crot, const Epi& epi) {
  pg8::StaticOrder so; so.init(M, N, cx.nb, (cx.bid + crot) % cx.nb);
  pg8::gemm_phase(cx.tid, (PG8_LAS unsigned char*)smem, pg8::Gemm{A, Bt, M, N, K}, so, epi);
}

__global__ void __launch_bounds__(NTHR, 2) fwd_kernel(Params p) {
  extern __shared__ __attribute__((aligned(16))) char smem[];
  cg::grid_group grid = cg::this_grid();
  bool first = true;
  const int wave_id = __builtin_amdgcn_readfirstlane(threadIdx.x >> 6);
  xb_lds_p xb_st = (xb_lds_p)(smem + LDS_BYTES);
  unsigned* xb_bar = reinterpret_cast<unsigned*>(p.ws + OFF_BAR);
  const unsigned xb_x = xb_xcc_id();
  if (threadIdx.x == 0) { xb_st[0] = 0u; xb_st[1] = 0u; (void)xb_add(&xb_bar[XB_XCNT(xb_x)], 1u); }
  __syncthreads();
  if (p.ph_lo == 0) {
    Ctx cx; cx.tid = threadIdx.x; cx.bid = blockIdx.x; cx.nb = gridDim.x;
    if (EN & 1) phase0(cx, p, p.ws, smem);
    if (XP0) phase0(cx, p, p.ws, smem);
    for (int i = 0; i < XSYNC; ++i) grid.sync();
    first = false;
  }
  bool rep_done = false;
  int nbar = 0;
  for (int ph = p.ph_lo < 1 ? 1 : p.ph_lo; ph < p.ph_hi; ++ph) {
    const int layer = (ph - 1) / 9, slot = (ph - 1) % 9;
    if (REP) { if (((REP >> slot) & 1) && ((REPL >> layer) & 1) && !rep_done) { rep_done = true; --ph; } else rep_done = false; }
    const int kind = layer % 3, jl = layer / 3;
    if ((slot == 1 && kind == 1) || (slot == 2 && kind != 0)) continue;
    if (!first) {
      if (nbar == 0) grid.sync();
      else xcd_barrier(reinterpret_cast<unsigned*>(p.ws + OFF_BAR), xb_x, xb_st, gridDim.x, (int)threadIdx.x);
      ++nbar;
    }
    first = false;
    typedef const Params __attribute__((address_space(4)))* KArgs;
    KArgs pp = (KArgs)__builtin_amdgcn_kernarg_segment_ptr();
    asm volatile("" : "+s"(pp));
    char* ws = pp->ws; float* outp = pp->out;
    Ctx cx; cx.bid = blockIdx.x; cx.nb = gridDim.x;
    int wid = wave_id;
    asm volatile("" : "+s"(ws), "+s"(outp), "+s"(wid), "+s"(cx.bid), "+s"(cx.nb));
    unsigned ones = ~0u; asm volatile("" : "+s"(ones));
    const int lane = __builtin_amdgcn_mbcnt_hi(ones, __builtin_amdgcn_mbcnt_lo(ones, 0u));
    cx.tid = wid * 64 + lane;
    const int gw = cx.bid * WPB + wid, nw = cx.nb * WPB;
    if (slot == 0 && (EN & 2)) {
      const int nmain = kind == 0 ? NMAIN_A : NMAIN_BC;
      run_gemm(cx, smem, reinterpret_cast<const u16*>(ws + OFF_XB), reinterpret_cast<const u16*>(ws + win_off(layer)), T, nmain, 1024, 0, EpiInProj{ws, kind});
      run_gemm(cx, smem, reinterpret_cast<const u16*>(ws + win_off(layer)) + (size_t)nmain * 1024, reinterpret_cast<const u16*>(ws + OFF_XB), 768, T, 1024, kind == 0 ? 0 : cx.nb / 2, EpiVt{ws, kind});
      if (layer == 0 && (EN & 2048))
        run_gemm(cx, smem, reinterpret_cast<const u16*>(ws + OFF_MEMN), reinterpret_cast<const u16*>(ws + OFF_WMKV), NB * NMEM, 4 * 512, 1024, cx.nb / 2, EpiMemKV{ws});
    } else if (slot == 1 && (EN & 4)) {
      if (kind == 0) ki_prep_phase(cx, ws, pp->idx_g + jl * 64, pp->idx_b + jl * 64);
      else kmean_phase(cx, ws);
    } else if (slot == 2 && (EN & 8)) {
      for (int v = cx.bid; v < NB * (S / 16); v += cx.nb) {
        const int b = v >> 8, idx = v & 255, j = (b & 1) ? 255 - idx : idx;
        dsa_select_block(ws, smem, wid, lane, b, j * 16, gw);
      }
    } else if (slot == 3) {
      if (EN & 128) for (int u = gw; u < NB * 4 * 128; u += nw) mem_att_unit(ws, layer, kind, u, lane);
      if (kind == 1 && (EN & 16)) {
        for (int u = gw; u < NB * 4 * 8 * 16; u += nw) dil_att_unit(ws, u, lane);
      } else {
        for (int k = 0; k * cx.nb < NB * 12 * 16; ++k) {
          const int v = k * cx.nb + ((k & 1) ? cx.nb - 1 - cx.bid : cx.bid);
          if (v >= NB * 12 * 16) continue;
          const int Qb = 15 - v / 96, bh = v % 96;
          if (kind == 0) { if (EN & 32) blk_att_unit<true>(ws, smem, wid, lane, bh, Qb); }
          else { if (EN & 64) blk_att_unit<false>(ws, smem, wid, lane, bh, Qb); }
        }
      }
    } else if (slot == 4 && (EN & 256)) {
      run_gemm(cx, smem, reinterpret_cast<const u16*>(ws + OFF_MIX), reinterpret_cast<const u16*>(ws + OFF_WOUT + layer * SZ_WOUT), T, 1024, 1024, 0, EpiResid{layer == 0 ? pp->x : outp, outp, layer == 0 ? nullptr : reinterpret_cast<const float2*>(ws + OFF_STAT), pp->ln2g + (layer - 1) * 1024, pp->ln2b + (layer - 1) * 1024});
    } else if (slot == 5) {
      ln_phase(cx, outp, pp->ln1g + layer * 1024, pp->ln1b + layer * 1024, reinterpret_cast<u16*>(ws + OFF_XB), reinterpret_cast<float2*>(ws + OFF_STAT), false);
    } else if (slot == 6 && (EN & 512)) {
      run_gemm(cx, smem, reinterpret_cast<const u16*>(ws + OFF_XB), reinterpret_cast<const u16*>(ws + OFF_WGU + layer * SZ_WGU), T, 2 * DFF, 1024, 0, EpiSwiGLU{reinterpret_cast<u16*>(ws + OFF_BIG + BO_H)});
    } else if (slot == 7 && (EN & 1024)) {
      run_gemm(cx, smem, reinterpret_cast<const u16*>(ws + OFF_BIG + BO_H), reinterpret_cast<const u16*>(ws + OFF_WDN + layer * SZ_WDN), T, 1024, DFF, 0, EpiResid{outp, outp, reinterpret_cast<const float2*>(ws + OFF_STAT), pp->ln1g + layer * 1024, pp->ln1b + layer * 1024});
    } else {
      ln_phase(cx, outp, pp->ln2g + layer * 1024, pp->ln2b + layer * 1024, reinterpret_cast<u16*>(ws + OFF_XB), reinterpret_cast<float2*>(ws + OFF_STAT), layer == DEPTH - 1);
    }
  }
}

extern "C" void kernel_launch(void* const* d_in, const int* in_sizes, int n_in, void* d_out, int out_size,
                              void* d_ws, size_t ws_size, hipStream_t stream) {
  static int grid_blocks = 0;
  if (!grid_blocks) {
    int dev = 0, cus = 0, per_cu = 0;
    (void)hipGetDevice(&dev);
    (void)hipDeviceGetAttribute(&cus, hipDeviceAttributeMultiprocessorCount, dev);
    if (hipFuncSetAttribute((const void*)fwd_kernel, hipFuncAttributeMaxDynamicSharedMemorySize, LDS_TOTAL) != hipSuccess)
      fprintf(stderr, "hipFuncSetAttribute(max dynamic LDS) failed\n");
    (void)hipOccupancyMaxActiveBlocksPerMultiprocessor(&per_cu, fwd_kernel, NTHR, LDS_TOTAL);
    if (per_cu < 1) fprintf(stderr, "occupancy query reports %d blocks per CU\n", per_cu);
    grid_blocks = cus;
  }
  if (ws_size < WS_NEED) fprintf(stderr, "workspace too small: %zu < %zu\n", ws_size, (size_t)WS_NEED);
  Params p{};
  p.x = (const float*)d_in[0]; p.mem = (const float*)d_in[1]; p.pos = (const int*)d_in[2];
  p.mem_g = (const float*)d_in[3]; p.mem_b = (const float*)d_in[4];
  p.w_in_a = (const float*)d_in[5]; p.idx_g = (const float*)d_in[6]; p.idx_b = (const float*)d_in[7];
  p.w_in_b = (const float*)d_in[8]; p.w_in_c = (const float*)d_in[9];
  p.w_mkv = (const float*)d_in[10]; p.w_out = (const float*)d_in[11];
  p.ln1g = (const float*)d_in[12]; p.ln1b = (const float*)d_in[13];
  p.w_gu = (const float*)d_in[14]; p.w_dn = (const float*)d_in[15];
  p.ln2g = (const float*)d_in[16]; p.ln2b = (const float*)d_in[17];
  p.out = (float*)d_out; p.ws = (char*)d_ws;
  for (int i = 0; i < 8; ++i) p.inv_freq[i] = (float)pow(500000.0, -(double)i / 8.0);
  const int NPH = 1 + DEPTH * 9;
#if SINGLE_LAUNCH
  (void)hipMemsetAsync((char*)d_ws + OFF_BAR, 0, (size_t)XCD_BAR_WORDS * 4, stream);
  p.ph_lo = 0; p.ph_hi = NPH;
  void* args[] = {&p};
  hipError_t e = hipLaunchCooperativeKernel((void*)fwd_kernel, dim3(grid_blocks), dim3(NTHR), args, LDS_TOTAL, stream);
  if (e != hipSuccess) fprintf(stderr, "cooperative launch failed: %s (grid %d)\n", hipGetErrorString(e), grid_blocks);
#else
  for (int ph = 0; ph < NPH; ++ph) {
    if (ph > 0) {
      const int layer = (ph - 1) / 9, slot = (ph - 1) % 9, kind = layer % 3;
      if ((slot == 1 && kind == 1) || (slot == 2 && kind != 0)) continue;
    }
    p.ph_lo = ph; p.ph_hi = ph + 1;
    hipLaunchKernelGGL(fwd_kernel, dim3(grid_blocks), dim3(NTHR), LDS_TOTAL, stream, p);
  }
#endif
}
```

```cpp
#include <hip/hip_runtime.h>
#include <hip/hip_cooperative_groups.h>
#include <cstdio>
#include <cmath>
namespace cg = cooperative_groups;

#ifndef EN
#define EN 0xFFFF
#endif
#ifndef SEL_LOW_BIT
#define SEL_LOW_BIT 8
#endif
#ifndef XSYNC
#define XSYNC 0
#endif
#ifndef XP0
#define XP0 0
#endif
#ifndef REP
#define REP 0
#endif
#ifndef REPL
#define REPL 15
#endif
#ifndef SINGLE_LAUNCH
#define SINGLE_LAUNCH 1
#endif

#define DI __device__ __forceinline__
typedef unsigned short u16;
using bf16x8 = __attribute__((ext_vector_type(8))) __bf16;
using bf2 = __attribute__((ext_vector_type(2))) __bf16;
using f32x4 = __attribute__((ext_vector_type(4))) float;
using f32x16 = __attribute__((ext_vector_type(16))) float;
using u32x4 = __attribute__((ext_vector_type(4))) unsigned;

constexpr int NB = 8, S = 4096, DM = 1024, T = NB * S, DEPTH = 4;
constexpr int NMEM = 256, DFF = 2816;
constexpr int NPAD_A = 3328, NPAD_BC = 2560;
constexpr int NMAIN_A = 2560, NMAIN_BC = 1792;
constexpr int NTHR = 512, WPB = 8;
constexpr int LDS_BYTES = 131072;
constexpr int LDS_TOTAL = LDS_BYTES + 16;
constexpr float ALPHA = 1.681792830507429f;
constexpr float LN_EPS = 1e-5f;

constexpr size_t SZ_WIN_A = (size_t)NPAD_A * 1024 * 2, SZ_WIN_BC = (size_t)NPAD_BC * 1024 * 2;
constexpr size_t OFF_WIN0 = 0;
constexpr size_t OFF_WIN1 = OFF_WIN0 + SZ_WIN_A;
constexpr size_t OFF_WIN2 = OFF_WIN1 + SZ_WIN_BC;
constexpr size_t OFF_WIN3 = OFF_WIN2 + SZ_WIN_BC;
constexpr size_t OFF_WMKV = OFF_WIN3 + SZ_WIN_A;
constexpr size_t SZ_WMKV = (size_t)512 * 1024 * 2;
constexpr size_t OFF_WOUT = OFF_WMKV + 4 * SZ_WMKV;
constexpr size_t SZ_WOUT = (size_t)1024 * 1024 * 2;
constexpr size_t OFF_WGU = OFF_WOUT + 4 * SZ_WOUT;
constexpr size_t SZ_WGU = (size_t)5632 * 1024 * 2;
constexpr size_t OFF_WDN = OFF_WGU + 4 * SZ_WGU;
constexpr size_t SZ_WDN = (size_t)1024 * 2816 * 2;
constexpr size_t OFF_XB = OFF_WDN + 4 * SZ_WDN;
constexpr size_t SZ_XB = (size_t)T * 1024 * 2;
constexpr size_t OFF_MIX = OFF_XB + SZ_XB;
constexpr size_t OFF_MEMN = OFF_MIX + SZ_XB;
constexpr size_t OFF_MK = OFF_MEMN + (size_t)2048 * 1024 * 2;
constexpr size_t SZ_MK = (size_t)8 * 4 * 256 * 64 * 2;
constexpr size_t OFF_MVT = OFF_MK + 4 * SZ_MK;
constexpr size_t OFF_COS = OFF_MVT + 4 * SZ_MK;
constexpr size_t OFF_SIN = OFF_COS + (size_t)T * 8 * 4;
constexpr size_t OFF_KMEAN = OFF_SIN + (size_t)T * 8 * 4;
constexpr size_t OFF_KMEANB = OFF_KMEAN + (size_t)8 * 12 * 16 * 64 * 4;
constexpr size_t OFF_BIG = OFF_KMEANB + (size_t)8 * 12 * 16 * 64 * 2;
constexpr size_t SZ_QKV = (size_t)T * 768 * 2;
constexpr size_t BO_Q = 0, BO_K = SZ_QKV, BO_V = 2 * SZ_QKV;
constexpr size_t BO_QM_AC = 3 * SZ_QKV, BO_QM_B = 5 * SZ_QKV;
constexpr size_t SZ_QM = (size_t)T * 256 * 2;
constexpr size_t BO_QI = BO_QM_AC + SZ_QM;
constexpr size_t BO_KIRAW = BO_QI + (size_t)T * 512 * 2;
constexpr size_t BO_KIB = BO_KIRAW + (size_t)T * 64 * 4;
constexpr size_t BO_WI = BO_KIB + (size_t)T * 64 * 2;
constexpr size_t BO_BM = BO_WI + (size_t)T * 8 * 4;
constexpr size_t BO_SCR = BO_BM + (size_t)T * 128 * 4;
constexpr size_t BO_H = 0;
constexpr size_t OFF_STAT = OFF_BIG + 5 * SZ_QKV + SZ_QM;
constexpr size_t OFF_BAR = OFF_STAT + (size_t)T * 8;
constexpr int XCD_BAR_WORDS = 3456;
constexpr size_t WS_NEED = OFF_BAR + (size_t)XCD_BAR_WORDS * 4;

struct Ctx { int tid, bid, nb; };

struct Params {
  const float* x; const float* mem; const int* pos; const float* mem_g; const float* mem_b;
  const float* w_in_a; const float* idx_g; const float* idx_b; const float* w_in_b; const float* w_in_c;
  const float* w_mkv; const float* w_out; const float* ln1g; const float* ln1b;
  const float* w_gu; const float* w_dn; const float* ln2g; const float* ln2b;
  float* out; char* ws;
  float inv_freq[8];
  int ph_lo, ph_hi;
};

DI unsigned pk2(float a, float b) { bf2 v; v[0] = (__bf16)a; v[1] = (__bf16)b; return __builtin_bit_cast(unsigned, v); }
DI u16 f2bf(float a) { return __builtin_bit_cast(u16, (__bf16)a); }
DI float bf2f(u16 b) { return __uint_as_float(((unsigned)b) << 16); }
typedef const bf16x8 __attribute__((address_space(1)))* gp_bf16x8;
typedef const unsigned __attribute__((address_space(1)))* gp_u32;
DI bf16x8 ld8(const u16* p) { return *((gp_bf16x8)(const void*)p); }
DI unsigned ldg32(const unsigned* p) { return *((gp_u32)(const void*)p); }
typedef unsigned u32x2v __attribute__((ext_vector_type(2)));
DI void stg16(void* p, uint4 v) { *((__attribute__((address_space(1))) u32x4*)p) = u32x4{v.x, v.y, v.z, v.w}; }
DI void stg16f(void* p, f32x4 v) { *((__attribute__((address_space(1))) f32x4*)p) = v; }
DI void stg8(void* p, uint2 v) { *((__attribute__((address_space(1))) u32x2v*)p) = u32x2v{v.x, v.y}; }
DI void stg4(void* p, unsigned v) { *((__attribute__((address_space(1))) unsigned*)p) = v; }
DI void stg2(void* p, u16 v) { *((__attribute__((address_space(1))) u16*)p) = v; }
DI f32x4 ldg4(const float* p) { return *((const __attribute__((address_space(1))) f32x4*)(const void*)p); }
typedef float f32x2v __attribute__((ext_vector_type(2)));
DI float2 ldg2(const float2* p) { const f32x2v v = *((const __attribute__((address_space(1))) f32x2v*)(const void*)p); return make_float2(v[0], v[1]); }
DI f32x4 mfma16(bf16x8 a, bf16x8 b, f32x4 c) { return __builtin_amdgcn_mfma_f32_16x16x32_bf16(a, b, c, 0, 0, 0); }
DI f32x16 mfma32(bf16x8 a, bf16x8 b, f32x16 c) { return __builtin_amdgcn_mfma_f32_32x32x16_bf16(a, b, c, 0, 0, 0); }
template <int M> DI float sx(float v) { return __builtin_bit_cast(float, __builtin_amdgcn_ds_swizzle(__builtin_bit_cast(int, v), (M << 10) | 0x1F)); }
DI float red32_sum(float v) { const int iv = __builtin_bit_cast(int, v); int iw = iv; asm volatile("" : "+v"(iw));
  auto r = __builtin_amdgcn_permlane32_swap(iv, iw, false, false); return __builtin_bit_cast(float, (int)r[0]) + __builtin_bit_cast(float, (int)r[1]); }
DI float red32_max(float v) { const int iv = __builtin_bit_cast(int, v); int iw = iv; asm volatile("" : "+v"(iw));
  auto r = __builtin_amdgcn_permlane32_swap(iv, iw, false, false); return fmaxf(__builtin_bit_cast(float, (int)r[0]), __builtin_bit_cast(float, (int)r[1])); }
DI float wave_sum(float v) { v += sx<1>(v); v += sx<2>(v); v += sx<4>(v); v += sx<8>(v); v += sx<16>(v); return red32_sum(v); }
DI size_t win_off(int layer) { return layer == 0 ? OFF_WIN0 : layer == 1 ? OFF_WIN1 : layer == 2 ? OFF_WIN2 : OFF_WIN3; }

DI int rope_pos(int c) { const int d = c & 63; return d < 16 ? (c & ~15) | (d & 3) | ((d & 4) << 1) | ((d & 8) >> 1) : c; }
DI int map_row(int kind, int c) {
  if (kind == 1) {
    if (c < 1536) return rope_pos(c);
    if (c < 2304) return NMAIN_A + (c - 1536);
    if (c < 2816) return 1792 + rope_pos(c - 2304);
    if (c < 2824) return 2368 + (c - 2816);
    if (c < 2888) return 2304 + (c - 2824);
    return 1536 + (c - 2888);
  }
  if (kind == 3) {
    if (c < 1536) return rope_pos(c);
    if (c < 2304) return NMAIN_BC + (c - 1536);
    return 1536 + (c - 2304);
  }
  if (kind == 2) {
    int isu = c >= DFF; int j = c - isu * DFF;
    return (j >> 7) * 256 + isu * 128 + (j & 127);
  }
  return c;
}

DI void conv_job(const Ctx& cx, const float* __restrict__ src, int Ks, int Ns, u16* __restrict__ dst, int kind, float* tile) {
  const int nnt = (Ns + 63) >> 6, nkt = Ks >> 8, tid = cx.tid;
  for (int t = cx.bid; t < nnt * nkt; t += cx.nb) {
    const int kt = t / nnt, nt = t % nnt;
    const int nn = tid & 63, n = nt * 64 + nn;
    float v[32];
#pragma unroll
    for (int i = 0; i < 32; ++i) { const int kk = i * 8 + (tid >> 6); v[i] = n < Ns ? src[(size_t)(kt * 256 + kk) * Ns + n] : 0.f; }
    __syncthreads();
#pragma unroll
    for (int i = 0; i < 32; ++i) tile[(i * 8 + (tid >> 6)) * 65 + nn] = v[i];
    __syncthreads();
#pragma unroll 4
    for (int i = 0; i < 16; ++i) {
      const int n2 = (tid >> 7) + 4 * i, k2 = tid & 127, nr = nt * 64 + n2;
      if (nr < Ns) {
        const int dr = map_row(kind, nr);
        *reinterpret_cast<unsigned*>(dst + (size_t)dr * Ks + kt * 256 + 2 * k2) = pk2(tile[(2 * k2) * 65 + n2], tile[(2 * k2 + 1) * 65 + n2]);
      }
    }
  }
}

DI void phase0(const Ctx& cx, const Params& p, char* ws, char* smem) {
  float* tile = reinterpret_cast<float*>(smem);
  for (int l = 0; l < DEPTH; ++l) {
    const int kind = l % 3, j = l / 3;
    const float* win = kind == 0 ? p.w_in_a + (size_t)j * 1024 * 3144 : kind == 1 ? p.w_in_b : p.w_in_c;
    conv_job(cx, win, 1024, kind == 0 ? 3144 : 2560, (u16*)(ws + win_off(l)), kind == 0 ? 1 : 3, tile);
    conv_job(cx, p.w_mkv + (size_t)l * 1024 * 512, 1024, 512, (u16*)(ws + OFF_WMKV + l * SZ_WMKV), 0, tile);
    conv_job(cx, p.w_out + (size_t)l * 1024 * 1024, 1024, 1024, (u16*)(ws + OFF_WOUT + l * SZ_WOUT), 0, tile);
    conv_job(cx, p.w_gu + (size_t)l * 1024 * 5632, 1024, 5632, (u16*)(ws + OFF_WGU + l * SZ_WGU), 2, tile);
    conv_job(cx, p.w_dn + (size_t)l * 2816 * 1024, 2816, 1024, (u16*)(ws + OFF_WDN + l * SZ_WDN), 0, tile);
  }
  const int gtid = cx.bid * NTHR + cx.tid, gn = cx.nb * NTHR;
  for (int l = 0; l < DEPTH; l += 3) {
    unsigned* d = reinterpret_cast<unsigned*>(ws + win_off(l) + (size_t)2376 * 1024 * 2);
    for (int i = gtid; i < (NMAIN_A - 2376) * 512; i += gn) d[i] = 0u;
  }
  {
    const float4* xs = reinterpret_cast<const float4*>(p.x);
    uint2* xd = reinterpret_cast<uint2*>(ws + OFF_XB);
    for (int i = gtid; i < T * 256; i += 4 * gn) {
      float4 v[4];
#pragma unroll
      for (int j = 0; j < 4; ++j) v[j] = xs[i + j * gn];
#pragma unroll
      for (int j = 0; j < 4; ++j) xd[i + j * gn] = make_uint2(pk2(v[j].x, v[j].y), pk2(v[j].z, v[j].w));
    }
  }
  {
    float* cs = reinterpret_cast<float*>(ws + OFF_COS); float* sn = reinterpret_cast<float*>(ws + OFF_SIN);
    for (int i = gtid; i < T * 8; i += gn) {
      int t = i >> 3, f = i & 7;
      float ang = (float)p.pos[t] * p.inv_freq[f];
      cs[i] = cosf(ang); sn[i] = sinf(ang);
    }
  }
  {
    const int lane = cx.tid & 63, gw = cx.bid * WPB + __builtin_amdgcn_readfirstlane(cx.tid >> 6), nw = cx.nb * WPB;
    u16* mn = reinterpret_cast<u16*>(ws + OFF_MEMN);
    for (int r = gw; r < NB * NMEM; r += nw) {
      const float4* src = reinterpret_cast<const float4*>(p.mem + (size_t)r * 1024);
      float4 v[4]; float s = 0.f;
      for (int i = 0; i < 4; ++i) { v[i] = src[i * 64 + lane]; s += v[i].x + v[i].y + v[i].z + v[i].w; }
      float mu = wave_sum(s) * (1.f / 1024.f);
      float q = 0.f;
      for (int i = 0; i < 4; ++i) { float a = v[i].x - mu, b = v[i].y - mu, c = v[i].z - mu, d = v[i].w - mu; q += a * a + b * b + c * c + d * d; }
      float rs = rsqrtf(wave_sum(q) * (1.f / 1024.f) + LN_EPS);
      for (int i = 0; i < 4; ++i) {
        int c = (i * 64 + lane) * 4;
        float4 g = *reinterpret_cast<const float4*>(p.mem_g + c), bb = *reinterpret_cast<const float4*>(p.mem_b + c);
        uint2 o = make_uint2(pk2((v[i].x - mu) * rs * g.x + bb.x, (v[i].y - mu) * rs * g.y + bb.y),
                             pk2((v[i].z - mu) * rs * g.z + bb.z, (v[i].w - mu) * rs * g.w + bb.w));
        *reinterpret_cast<uint2*>(mn + (size_t)r * 1024 + c) = o;
      }
    }
  }
}

namespace pg8 {
#define PG8_LAS __attribute__((address_space(3)))
typedef short s16x8 __attribute__((ext_vector_type(8)));
constexpr int BM = 256, BK = 64, HALF = 128, HTB = HALF * BK * 2, STAGE_BYTES = 8 * HTB, NXCD = 8, WGM = 8;
DI int lds_byte(int r, int c) { const int st = (r >> 4) * 2 + (c >> 5), rr = r & 15, cc = c & 31, ob = rr * 64 + cc * 2; return st * 1024 + (ob ^ (((ob >> 9) & 1) << 5)); }
DI void stage_rc(int b, int& R, int& C) { const int st = b / 1024, sb = b % 1024, swz = sb ^ (((sb >> 9) & 1) << 5); R = (st >> 1) * 16 + swz / 64; C = (st & 1) * 32 + (swz % 64) / 2; }
DI int perm32(int rho) { const int n = rho >> 4, i = rho & 15; return 8 * (i >> 2) + 4 * n + (i & 3); }
struct Unit { int pm, pn; };
struct Gemm { const u16* A; const u16* Bt; int M, N, K; };
struct StaticOrder {
  int nM, nN, nwg, G, c;
  DI void init(int M, int N, int G_, int c_) { nM = M / BM; nN = N / BM; nwg = nM * nN; G = G_; c = c_; }
  DI bool next(int i, Unit& u) const {
    const long L = (long)i * G + c; if (L >= nwg) return false;
    int wgid = (int)L; { const int q = nwg / NXCD, r = nwg % NXCD, xcd = wgid % NXCD, off = wgid / NXCD; wgid = (xcd < r ? xcd * (q + 1) : r * (q + 1) + (xcd - r) * q) + off; }
    const int nig = WGM * nN, gid = wgid / nig, fm = gid * WGM, gsz = (nM - fm) < WGM ? (nM - fm) : WGM;
    u.pm = fm + ((wgid % nig) % gsz); u.pn = (wgid % nig) / gsz; return true;
  }
};

template <class Epi>
DI void gemm_phase(int tid, PG8_LAS unsigned char* lds, const Gemm g, const StaticOrder& S, const Epi& E) {
  const int wid = __builtin_amdgcn_readfirstlane(tid >> 6), lane = tid & 63, wr = wid >> 2, wc = wid & 3, fr = lane & 15, fq = lane >> 4;
  const int K = g.K, nt = K / BK;
  unsigned voffA[2], voffB[2];
#pragma unroll
  for (int i = 0; i < 2; ++i) { int R, C; stage_rc(tid * 16 + i * 8192, R, C); const int Rb = Epi::PERM ? ((R & ~31) + perm32(R & 31)) : R;
    voffA[i] = (unsigned)(R * K + C) * 2u; voffB[i] = (unsigned)(Rb * K + C) * 2u; }
  const size_t kstep = (size_t)(BK * 2);
  const size_t hstep = (size_t)HALF * K * 2;
  const size_t tstep = 2 * hstep;
  const unsigned ldsw = (unsigned)wid * 1024u;
  const int aoff = lds_byte(wr * 64 + fr, fq * 8), boff = lds_byte(wc * 32 + fr, fq * 8);
#define PG8_SA(b, h) (((b) * 2 + (h)) * HTB)
#define PG8_SB(b, h) ((4 + (b) * 2 + (h)) * HTB)
#define PG8_STAGE(bufoff, gbase, voff) do { _Pragma("unroll") for (int _i = 0; _i < 2; ++_i) \
    __builtin_amdgcn_global_load_lds((const unsigned*)((const char*)(gbase) + (voff)[_i]), (PG8_LAS unsigned*)(lds + (bufoff) + ldsw + _i * 8192), 16, 0, 0); } while (0)
#define PG8_LDA(dst, b, h) do { _Pragma("unroll") for (int m = 0; m < 4; ++m) _Pragma("unroll") for (int k = 0; k < 2; ++k) dst[m][k] = *(const PG8_LAS s16x8*)(lds + PG8_SA(b, h) + aoff + m * 2048 + k * 1024); } while (0)
#define PG8_LDB(dst, b, h) do { _Pragma("unroll") for (int n = 0; n < 2; ++n) _Pragma("unroll") for (int k = 0; k < 2; ++k) dst[n][k] = *(const PG8_LAS s16x8*)(lds + PG8_SB(b, h) + boff + n * 2048 + k * 1024); } while (0)
#define PG8_MMA(ai, bj, At, Bt) do { __builtin_amdgcn_s_setprio(1); _Pragma("unroll") for (int m = 0; m < 4; ++m) _Pragma("unroll") for (int n = 0; n < 2; ++n) _Pragma("unroll") for (int k = 0; k < 2; ++k) \
    acc[ai][bj][m][n] = __builtin_amdgcn_mfma_f32_16x16x32_bf16(__builtin_bit_cast(bf16x8, Bt[n][k]), __builtin_bit_cast(bf16x8, At[m][k]), acc[ai][bj][m][n], 0, 0, 0); __builtin_amdgcn_s_setprio(0); } while (0)
#define PG8_WAIT_V(n) asm volatile("s_waitcnt vmcnt(" #n ")" ::: "memory")
#define PG8_WAIT_L(n) asm volatile("s_waitcnt lgkmcnt(" #n ")" ::: "memory")
#define PG8_BAR __builtin_amdgcn_s_barrier()
#define PG8_SCHED __builtin_amdgcn_sched_barrier(0)
  Unit cur, nxt; int ui = 0;
  if (!S.next(0, cur)) return;
  f32x4 acc[2][2][4][2];
#pragma unroll
  for (int a = 0; a < 2; ++a)
#pragma unroll
    for (int b = 0; b < 2; ++b)
#pragma unroll
      for (int m = 0; m < 4; ++m)
#pragma unroll
        for (int n = 0; n < 2; ++n) acc[a][b][m][n] = (f32x4){0.f, 0.f, 0.f, 0.f};
  s16x8 At[4][2], B0[2][2], B1[2][2];
  const char* cA = (const char*)g.A + (size_t)cur.pm * tstep; const char* cB = (const char*)g.Bt + (size_t)cur.pn * tstep;
  PG8_STAGE(PG8_SB(0, 0), cB, voffB); PG8_STAGE(PG8_SA(0, 0), cA, voffA); PG8_STAGE(PG8_SB(0, 1), cB + hstep, voffB); PG8_STAGE(PG8_SA(0, 1), cA + hstep, voffA);
  if (wr == 1) PG8_BAR;
  PG8_WAIT_V(4); PG8_BAR;
  PG8_STAGE(PG8_SB(1, 0), cB + kstep, voffB); PG8_STAGE(PG8_SA(1, 0), cA + kstep, voffA); PG8_STAGE(PG8_SB(1, 1), cB + hstep + kstep, voffB);
  PG8_WAIT_V(6); PG8_BAR;
  for (;;) {
    const bool has_next = S.next(ui + 1, nxt);
    const char* nA = has_next ? (const char*)g.A + (size_t)nxt.pm * tstep : cA; const char* nB = has_next ? (const char*)g.Bt + (size_t)nxt.pn * tstep : cB;
    for (int t = 0; t < nt; t += 2) {
      const bool last = (t == nt - 2);
      const char* a1 = cA + (size_t)(t + 1) * kstep;
      const char* a2 = last ? nA : cA + (size_t)(t + 2) * kstep; const char* b2 = last ? nB : cB + (size_t)(t + 2) * kstep;
      const char* a3 = a2 + kstep; const char* b3 = b2 + kstep;
      PG8_LDB(B0, 0, 0); PG8_SCHED; PG8_LDA(At, 0, 0); PG8_STAGE(PG8_SA(1, 1), a1 + hstep, voffA);
      PG8_WAIT_L(8); PG8_BAR; PG8_WAIT_L(0); PG8_MMA(0, 0, At, B0); PG8_BAR; PG8_SCHED;
      PG8_LDB(B1, 0, 1); PG8_STAGE(PG8_SB(0, 0), b2, voffB);
      PG8_BAR; PG8_WAIT_L(0); PG8_MMA(0, 1, At, B1); PG8_BAR;
      PG8_LDA(At, 0, 1); PG8_STAGE(PG8_SA(0, 0), a2, voffA);
      PG8_BAR; PG8_WAIT_L(0); PG8_MMA(1, 0, At, B0); PG8_BAR; PG8_SCHED;
      PG8_STAGE(PG8_SB(0, 1), b2 + hstep, voffB);
      PG8_WAIT_V(6); PG8_BAR; PG8_MMA(1, 1, At, B1); PG8_BAR;
      PG8_LDB(B0, 1, 0); PG8_SCHED; PG8_LDA(At, 1, 0); PG8_STAGE(PG8_SA(0, 1), a2 + hstep, voffA);
      PG8_WAIT_L(8); PG8_BAR; PG8_WAIT_L(0); PG8_MMA(0, 0, At, B0); PG8_BAR; PG8_SCHED;
      PG8_LDB(B1, 1, 1); PG8_STAGE(PG8_SB(1, 0), b3, voffB);
      PG8_BAR; PG8_WAIT_L(0); PG8_MMA(0, 1, At, B1); PG8_BAR;
      PG8_LDA(At, 1, 1); PG8_STAGE(PG8_SA(1, 0), a3, voffA);
      PG8_BAR; PG8_WAIT_L(0); PG8_MMA(1, 0, At, B0); PG8_BAR; PG8_SCHED;
      PG8_STAGE(PG8_SB(1, 1), b3 + hstep, voffB);
      PG8_WAIT_V(6); PG8_BAR; PG8_MMA(1, 1, At, B1); PG8_BAR;
    }
    E(acc, cur, wr, wc, fr, fq);
    if (!has_next) break;
#pragma unroll
    for (int a = 0; a < 2; ++a)
#pragma unroll
      for (int b = 0; b < 2; ++b)
#pragma unroll
        for (int m = 0; m < 4; ++m)
#pragma unroll
          for (int n = 0; n < 2; ++n) acc[a][b][m][n] = (f32x4){0.f, 0.f, 0.f, 0.f};
    cur = nxt; cA = nA; cB = nB; ++ui;
  }
  PG8_WAIT_V(0);
  if (wr == 0) PG8_BAR;
  PG8_BAR;
#undef PG8_SA
#undef PG8_SB
#undef PG8_STAGE
#undef PG8_LDA
#undef PG8_LDB
#undef PG8_MMA
#undef PG8_WAIT_V
#undef PG8_WAIT_L
#undef PG8_BAR
#undef PG8_SCHED
}
}

DI uint4 pack8(const f32x4& a, const f32x4& b) { return make_uint4(pk2(a[0], a[1]), pk2(a[2], a[3]), pk2(b[0], b[1]), pk2(b[2], b[3])); }

struct EpiInProj {
  static constexpr bool PERM = true;
  char* ws; int kind;
  DI void operator()(const f32x4 (&acc)[2][2][4][2], const pg8::Unit& u, int wr, int wc, int fr, int fq) const {
    char* big = ws + OFF_BIG;
    const float* cs = reinterpret_cast<const float*>(ws + OFF_COS);
    const float* sn = reinterpret_cast<const float*>(ws + OFF_SIN);
#pragma unroll
    for (int bj = 0; bj < 2; ++bj) {
      const int c32 = u.pn * 256 + bj * 128 + wc * 32;
      const int dd = (c32 & 63) + 8 * fq;
      if (c32 < 2304) {
        int sel, h;
        if (c32 < 768) { sel = 0; h = c32 >> 6; }
        else if (c32 < 1536) { sel = 1; h = (c32 - 768) >> 6; }
        else if (c32 < 1792) { sel = 2; h = (c32 - 1536) >> 6; }
        else { sel = 3; h = (c32 - 1792) >> 6; }
        const bool rope = sel != 2 && (c32 & 63) == 0 && fq < 2;
        f32x4 rc[2][4], rsn[2][4];
        if (rope) {
#pragma unroll
          for (int ai = 0; ai < 2; ++ai)
#pragma unroll
            for (int m = 0; m < 4; ++m) {
              const int row = u.pm * 256 + ai * 128 + wr * 64 + m * 16 + fr;
              rc[ai][m] = ldg4(cs + row * 8 + 4 * fq); rsn[ai][m] = ldg4(sn + row * 8 + 4 * fq);
            }
        }
#pragma unroll
        for (int ai = 0; ai < 2; ++ai)
#pragma unroll
          for (int m = 0; m < 4; ++m) {
            const int row = u.pm * 256 + ai * 128 + wr * 64 + m * 16 + fr;
            f32x4 a = acc[ai][bj][m][0], b = acc[ai][bj][m][1];
            if (rope) {
              const f32x4 na = a * rc[ai][m] - b * rsn[ai][m], nb = b * rc[ai][m] + a * rsn[ai][m];
              a = na; b = nb;
            }
            const int bb = row >> 12, s_ = row & 4095;
            size_t off;
            if (sel == 0) off = BO_Q + (((size_t)(bb * 12 + h) * S + s_) * 64 + dd) * 2;
            else if (sel == 1) off = BO_K + (((size_t)(bb * 12 + h) * S + s_) * 64 + dd) * 2;
            else if (sel == 2) off = (kind == 1 ? BO_QM_B : BO_QM_AC) + (((size_t)(bb * 4 + h) * S + s_) * 64 + dd) * 2;
            else off = BO_QI + (((size_t)row * 8 + h) * 64 + dd) * 2;
            stg16(big + off, pack8(a, b));
          }
      } else if (c32 < 2368) {
#pragma unroll
        for (int ai = 0; ai < 2; ++ai)
#pragma unroll
          for (int m = 0; m < 4; ++m) {
            const int row = u.pm * 256 + ai * 128 + wr * 64 + m * 16 + fr;
            float* dst = reinterpret_cast<float*>(big + BO_KIRAW) + (size_t)row * 64 + (c32 - 2304) + 8 * fq;
            stg16f(dst, acc[ai][bj][m][0]);
            stg16f(dst + 4, acc[ai][bj][m][1]);
          }
      } else if (c32 < 2400) {
        if (fq == 0) {
#pragma unroll
          for (int ai = 0; ai < 2; ++ai)
#pragma unroll
            for (int m = 0; m < 4; ++m) {
              const int row = u.pm * 256 + ai * 128 + wr * 64 + m * 16 + fr;
              float* dst = reinterpret_cast<float*>(big + BO_WI) + (size_t)row * 8;
              stg16f(dst, acc[ai][bj][m][0] * 0.04419417382415922f);
              stg16f(dst + 4, acc[ai][bj][m][1] * 0.04419417382415922f);
            }
        }
      }
    }
  }
};

struct EpiVt {
  static constexpr bool PERM = true;
  char* ws; int kind;
  DI void operator()(const f32x4 (&acc)[2][2][4][2], const pg8::Unit& u, int wr, int wc, int fr, int fq) const {
    char* big = ws + OFF_BIG;
#pragma unroll
    for (int ai = 0; ai < 2; ++ai)
#pragma unroll
      for (int m = 0; m < 4; ++m) {
        const int cv = u.pm * 256 + ai * 128 + wr * 64 + m * 16 + fr;
#pragma unroll
        for (int bj = 0; bj < 2; ++bj) {
          const int tok0 = u.pn * 256 + bj * 128 + wc * 32 + 8 * fq;
          const int bb = tok0 >> 12, s0 = tok0 & 4095;
          const f32x4 a = acc[ai][bj][m][0], b = acc[ai][bj][m][1];
          if (kind != 1) {
            const int h = cv >> 6, d = cv & 63;
            u16* vt = reinterpret_cast<u16*>(big + BO_V) + ((size_t)(bb * 12 + h) * 128 + (s0 >> 5)) * 2048 + d * 32 + (s0 & 31);
            stg16(vt, pack8(a, b));
          } else {
            const int hh = cv / 192, dv = cv % 192;
            u16* v0 = reinterpret_cast<u16*>(big + BO_V) + ((size_t)(bb * 4 + hh) * 128 + (s0 >> 5)) * 6144 + dv * 32 + (s0 & 31);
            stg16(v0, pack8(a, b));
            const int j4 = s0 >> 2, j16 = s0 >> 4, r0 = s0 & 15;
            u16* v1 = reinterpret_cast<u16*>(big + BO_V + SZ_QKV) + (((size_t)(bb * 4 + hh) * 4) * 32 + (j4 >> 5)) * 6144 + dv * 32 + (j4 & 31);
            u16* v2 = reinterpret_cast<u16*>(big + BO_V + 2 * SZ_QKV) + (((size_t)(bb * 4 + hh) * 16 + r0) * 8 + (j16 >> 5)) * 6144 + dv * 32 + (j16 & 31);
#pragma unroll
            for (int r = 0; r < 4; ++r) stg4(v1 + (size_t)r * 32 * 6144, pk2(a[r], b[r]));
#pragma unroll
            for (int i = 0; i < 4; ++i) { stg2(v2 + (size_t)i * 8 * 6144, f2bf(a[i])); stg2(v2 + (size_t)(i + 4) * 8 * 6144, f2bf(b[i])); }
          }
        }
      }
  }
};

struct EpiMemKV {
  static constexpr bool PERM = true;
  char* ws;
  DI void operator()(const f32x4 (&acc)[2][2][4][2], const pg8::Unit& u, int wr, int wc, int fr, int fq) const {
#pragma unroll
    for (int bj = 0; bj < 2; ++bj) {
      const int c32 = u.pn * 256 + bj * 128 + wc * 32;
      const int layer = c32 >> 9, c = c32 & 511;
      const int h = (c & 255) >> 6, dd = (c & 63) + 8 * fq;
      u16* mk = reinterpret_cast<u16*>(ws + OFF_MK + layer * SZ_MK);
      u16* mvt = reinterpret_cast<u16*>(ws + OFF_MVT + layer * SZ_MK);
#pragma unroll
      for (int ai = 0; ai < 2; ++ai)
#pragma unroll
        for (int m = 0; m < 4; ++m) {
          const int row = u.pm * 256 + ai * 128 + wr * 64 + m * 16 + fr;
          const int bb = row >> 8, n = row & 255;
          const f32x4 a = acc[ai][bj][m][0], b = acc[ai][bj][m][1];
          if (c < 256) {
            stg16(mk + ((size_t)(bb * 4 + h) * 256 + n) * 64 + dd, pack8(a, b));
          } else {
            u16* vt = mvt + ((size_t)(bb * 4 + h) * 8 + (n >> 5)) * 2048 + dd * 32 + (n & 31);
#pragma unroll
            for (int i = 0; i < 4; ++i) { stg2(vt + i * 32, f2bf(a[i])); stg2(vt + (i + 4) * 32, f2bf(b[i])); }
          }
        }
    }
  }
};

struct EpiResid {
  static constexpr bool PERM = false;
  const float* xsrc; float* out; const float2* stat; const float* g; const float* b;
  DI void operator()(const f32x4 (&acc)[2][2][4][2], const pg8::Unit& u, int wr, int wc, int fr, int fq) const {
    const int col0 = u.pn * 256 + wc * 32 + 4 * fq;
    f32x4 gg[2][2], bb[2][2];
    if (stat) {
#pragma unroll
      for (int bj = 0; bj < 2; ++bj)
#pragma unroll
        for (int n = 0; n < 2; ++n) { gg[bj][n] = ldg4(g + col0 + bj * 128 + n * 16); bb[bj][n] = ldg4(b + col0 + bj * 128 + n * 16); }
    }
#pragma unroll
    for (int h4 = 0; h4 < 4; ++h4) {
      const int ai = h4 >> 1, m0 = (h4 & 1) * 2;
      f32x4 xv[2][2][2]; float2 st[2];
#pragma unroll
      for (int mm = 0; mm < 2; ++mm) {
        const int row = u.pm * 256 + ai * 128 + wr * 64 + (m0 + mm) * 16 + fr;
        st[mm] = stat ? ldg2(stat + row) : make_float2(0.f, 1.f);
#pragma unroll
        for (int bj = 0; bj < 2; ++bj)
#pragma unroll
          for (int n = 0; n < 2; ++n) xv[mm][bj][n] = ldg4(xsrc + (size_t)row * 1024 + col0 + bj * 128 + n * 16);
      }
#pragma unroll
      for (int mm = 0; mm < 2; ++mm) {
        const int row = u.pm * 256 + ai * 128 + wr * 64 + (m0 + mm) * 16 + fr;
#pragma unroll
        for (int bj = 0; bj < 2; ++bj)
#pragma unroll
          for (int n = 0; n < 2; ++n) {
            f32x4 x = xv[mm][bj][n];
            if (stat) x = (x - st[mm].x) * st[mm].y * gg[bj][n] + bb[bj][n];
            stg16f(out + (size_t)row * 1024 + col0 + bj * 128 + n * 16, x * ALPHA + acc[ai][bj][m0 + mm][n]);
          }
      }
    }
  }
};

struct EpiSwiGLU {
  static constexpr bool PERM = true;
  u16* h;
  DI void operator()(const f32x4 (&acc)[2][2][4][2], const pg8::Unit& u, int wr, int wc, int fr, int fq) const {
    const int j0 = u.pn * 128 + wc * 32 + 8 * fq;
#pragma unroll
    for (int ai = 0; ai < 2; ++ai)
#pragma unroll
      for (int m = 0; m < 4; ++m) {
        const int row = u.pm * 256 + ai * 128 + wr * 64 + m * 16 + fr;
        f32x4 o[2];
#pragma unroll
        for (int n = 0; n < 2; ++n)
#pragma unroll
          for (int i = 0; i < 4; ++i) { const float g = acc[ai][0][m][n][i], uu = acc[ai][1][m][n][i]; o[n][i] = g * __builtin_amdgcn_rcpf(1.f + __expf(-g)) * uu; }
        stg16(h + (size_t)row * DFF + j0, pack8(o[0], o[1]));
      }
  }
};

DI void ln_phase(const Ctx& cx, float* xio, const float* __restrict__ g, const float* __restrict__ b, u16* xb, float2* stat, bool write_f32) {
  const int lane = cx.tid & 63, gw = cx.bid * WPB + __builtin_amdgcn_readfirstlane(cx.tid >> 6), nw = cx.nb * WPB;
  float4 gg[4], bb[4];
  for (int i = 0; i < 4; ++i) { gg[i] = *reinterpret_cast<const float4*>(g + (i * 64 + lane) * 4); bb[i] = *reinterpret_cast<const float4*>(b + (i * 64 + lane) * 4); }
  constexpr int RB = 4;
  for (int r0 = gw * RB; r0 < T; r0 += nw * RB) {
    float4 v[RB][4]; float s[RB], q[RB];
#pragma unroll
    for (int k = 0; k < RB; ++k) {
      const float4* row = reinterpret_cast<const float4*>(xio + (size_t)(r0 + k) * 1024);
      s[k] = 0.f;
#pragma unroll
      for (int i = 0; i < 4; ++i) { v[k][i] = row[i * 64 + lane]; s[k] += v[k][i].x + v[k][i].y + v[k][i].z + v[k][i].w; }
    }
#pragma unroll
    for (int k = 0; k < RB; ++k) s[k] = wave_sum(s[k]) * (1.f / 1024.f);
#pragma unroll
    for (int k = 0; k < RB; ++k) {
      q[k] = 0.f;
#pragma unroll
      for (int i = 0; i < 4; ++i) { float a = v[k][i].x - s[k], b2 = v[k][i].y - s[k], c = v[k][i].z - s[k], d = v[k][i].w - s[k]; q[k] += a * a + b2 * b2 + c * c + d * d; }
    }
#pragma unroll
    for (int k = 0; k < RB; ++k) q[k] = rsqrtf(wave_sum(q[k]) * (1.f / 1024.f) + LN_EPS);
    if (lane < RB) { float2 sv; sv.x = lane == 0 ? s[0] : lane == 1 ? s[1] : lane == 2 ? s[2] : s[3]; sv.y = lane == 0 ? q[0] : lane == 1 ? q[1] : lane == 2 ? q[2] : q[3]; stat[r0 + lane] = sv; }
#pragma unroll
    for (int k = 0; k < RB; ++k) {
      float4* row = reinterpret_cast<float4*>(xio + (size_t)(r0 + k) * 1024);
#pragma unroll
      for (int i = 0; i < 4; ++i) {
        float4 o;
        o.x = (v[k][i].x - s[k]) * q[k] * gg[i].x + bb[i].x; o.y = (v[k][i].y - s[k]) * q[k] * gg[i].y + bb[i].y;
        o.z = (v[k][i].z - s[k]) * q[k] * gg[i].z + bb[i].z; o.w = (v[k][i].w - s[k]) * q[k] * gg[i].w + bb[i].w;
        if (write_f32) row[i * 64 + lane] = o;
        *reinterpret_cast<uint2*>(xb + (size_t)(r0 + k) * 1024 + (i * 64 + lane) * 4) = make_uint2(pk2(o.x, o.y), pk2(o.z, o.w));
      }
    }
  }
}

template <int NDT> struct AttState { f32x16 o[NDT]; float m, l; };
template <int NDT> DI void att_init(AttState<NDT>& st) {
#pragma unroll
  for (int d = 0; d < NDT; ++d)
#pragma unroll
    for (int r = 0; r < 16; ++r) st.o[d][r] = 0.f;
  st.m = -1e30f; st.l = 0.f;
}
DI int pi_swap(int i) { return (i & 0x13) | ((i & 4) << 1) | ((i & 8) >> 1); }

template <int NDT> struct Frags { bf16x8 k[4]; bf16x8 v[NDT == 2 ? 4 : 1]; unsigned w; };
template <int NDT> DI void att_load(Frags<NDT>& f, const u16* krow, const u16* vt) {
#pragma unroll
  for (int c = 0; c < 4; ++c) f.k[c] = ld8(krow + c * 16);
  if (NDT == 2) {
#pragma unroll
    for (int d = 0; d < 2; ++d)
#pragma unroll
      for (int c = 0; c < 2; ++c) f.v[d * 2 + c] = ld8(vt + d * 1024 + c * 16);
  }
}
template <int NDT, class MaskP>
DI void att_compute(AttState<NDT>& st, const bf16x8 (&qf)[4], const Frags<NDT>& f, const u16* vt, const MaskP& maskp) {
  constexpr float CS = 0.18033688011112042f;
  f32x16 s;
#pragma unroll
  for (int r = 0; r < 16; ++r) s[r] = 0.f;
#pragma unroll
  for (int c = 0; c < 4; ++c) s = mfma32(f.k[c], qf[c], s);
  float mx = fmaxf(fmaxf(s[0], s[1]), s[2]);
#pragma unroll
  for (int r = 3; r < 15; r += 2) mx = fmaxf(fmaxf(mx, s[r]), s[r + 1]);
  mx = fmaxf(mx, s[15]);
  mx = red32_max(mx);
  constexpr float DEFER = 8.0f / CS;
  const bool upd = mx > st.m + DEFER;
  if (__any(upd)) {
    const float mnew = upd ? mx : st.m;
    const float alpha = __builtin_amdgcn_exp2f((st.m - mnew) * CS);
    st.l *= alpha; st.m = mnew;
#pragma unroll
    for (int d = 0; d < NDT; ++d)
#pragma unroll
      for (int r = 0; r < 16; ++r) st.o[d][r] *= alpha;
  }
  const float nb = -st.m * CS;
  float ps = 0.f;
#pragma unroll
  for (int r = 0; r < 16; ++r) { s[r] = maskp(r, __builtin_amdgcn_exp2f(fmaf(s[r], CS, nb))); ps += s[r]; }
  st.l += ps;
  bf16x8 pf[2];
#pragma unroll
  for (int c = 0; c < 2; ++c) {
    u32x4 t;
#pragma unroll
    for (int j = 0; j < 4; ++j) t[j] = pk2(s[8 * c + 2 * j], s[8 * c + 2 * j + 1]);
    pf[c] = __builtin_bit_cast(bf16x8, t);
  }
  if (NDT == 2) {
#pragma unroll
    for (int d = 0; d < 2; ++d)
#pragma unroll
      for (int c = 0; c < 2; ++c) st.o[d] = mfma32(f.v[d * 2 + c], pf[c], st.o[d]);
  } else {
#pragma unroll
    for (int hb = 0; hb < 2; ++hb) {
      bf16x8 va[6];
#pragma unroll
      for (int i = 0; i < 6; ++i) va[i] = ld8(vt + (hb * 3 + (i >> 1)) * 1024 + (i & 1) * 16);
      asm volatile("" : "+v"(va[0]), "+v"(va[1]), "+v"(va[2]), "+v"(va[3]), "+v"(va[4]), "+v"(va[5]));
#pragma unroll
      for (int i = 0; i < 6; ++i) st.o[hb * 3 + (i >> 1)] = mfma32(va[i], pf[i & 1], st.o[hb * 3 + (i >> 1)]);
    }
  }
}
DI float mask_bit(unsigned w, int bit, float p) { int m; asm("v_bfe_i32 %0, %1, %2, 1" : "=v"(m) : "v"(w), "n"(bit)); return __uint_as_float(__float_as_uint(p) & (unsigned)m); }
template <int NDT, class KP, class VP, class WP, class MK>
DI void att_range(AttState<NDT>& st, const bf16x8 (&qf)[4], int k0, int k1, const KP& kp, const VP& vp, const WP& wp, const MK& mk) {
  if (NDT == 2) {
    Frags<NDT> f0, f1, f2;
    att_load<NDT>(f0, kp(k0), vp(k0)); f0.w = wp(k0);
    f1 = f0; f2 = f0;
    if (k0 + 1 <= k1) { att_load<NDT>(f1, kp(k0 + 1), vp(k0 + 1)); f1.w = wp(k0 + 1); }
#pragma unroll 1
    for (int kt = k0; kt <= k1; kt += 3) {
      if (kt + 2 <= k1) { att_load<NDT>(f2, kp(kt + 2), vp(kt + 2)); f2.w = wp(kt + 2); }
      att_compute<NDT>(st, qf, f0, vp(kt), mk(kt, f0.w));
      if (kt + 1 > k1) break;
      if (kt + 3 <= k1) { att_load<NDT>(f0, kp(kt + 3), vp(kt + 3)); f0.w = wp(kt + 3); }
      att_compute<NDT>(st, qf, f1, vp(kt + 1), mk(kt + 1, f1.w));
      if (kt + 2 > k1) break;
      if (kt + 4 <= k1) { att_load<NDT>(f1, kp(kt + 4), vp(kt + 4)); f1.w = wp(kt + 4); }
      att_compute<NDT>(st, qf, f2, vp(kt + 2), mk(kt + 2, f2.w));
    }
  } else {
#pragma unroll 1
    for (int kt = k0; kt <= k1; ++kt) {
      Frags<NDT> cur;
      att_load<NDT>(cur, kp(kt), vp(kt)); cur.w = wp(kt);
      att_compute<NDT>(st, qf, cur, vp(kt), mk(kt, cur.w));
    }
  }
}

template <int NDT> DI void att_store(AttState<NDT>& st, u16* orow, int hf) {
  const float lt = red32_sum(st.l);
  const float inv = 1.f / lt;
#pragma unroll
  for (int d = 0; d < NDT; ++d)
#pragma unroll
    for (int g = 0; g < 4; ++g) {
      uint2 v = make_uint2(pk2(st.o[d][4 * g] * inv, st.o[d][4 * g + 1] * inv), pk2(st.o[d][4 * g + 2] * inv, st.o[d][4 * g + 3] * inv));
      *reinterpret_cast<uint2*>(orow + d * 32 + 8 * g + 4 * hf) = v;
    }
}

DI void load_q(bf16x8 (&qf)[4], const u16* qrow, int hf) {
#pragma unroll
  for (int c = 0; c < 4; ++c) qf[c] = ld8(qrow + c * 16 + 8 * hf);
}

DI void mem_att_unit(char* ws, int layer, int kind, int u, int lane) {
  const int qt = u & 127, bh = u >> 7, b = bh >> 2, hm = bh & 3;
  const int ql = lane & 31, hf = lane >> 5, tq = qt * 32 + ql;
  const u16* QM = reinterpret_cast<const u16*>(ws + OFF_BIG + (kind == 1 ? BO_QM_B : BO_QM_AC));
  const u16* MK = reinterpret_cast<const u16*>(ws + OFF_MK + layer * SZ_MK);
  const u16* MVT = reinterpret_cast<const u16*>(ws + OFF_MVT + layer * SZ_MK);
  bf16x8 qf[4]; load_q(qf, QM + ((size_t)bh * S + tq) * 64, hf);
  AttState<2> st; att_init(st);
  const int pk = pi_swap(ql);
  const u16* kb = MK + ((size_t)bh * 256 + pk) * 64 + 8 * hf;
  const u16* vb = MVT + ((size_t)bh * 8) * 2048 + ql * 32 + 8 * hf;
  int klast = 7; asm volatile("" : "+s"(klast));
  att_range<2>(st, qf, 0, klast,
               [kb](int kt) { return kb + kt * 2048; }, [vb](int kt) { return vb + kt * 2048; },
               [](int) { return 0u; }, [](int, unsigned) { return [](int, float p) { return p; }; });
  u16* mix = reinterpret_cast<u16*>(ws + OFF_MIX);
  att_store<2>(st, mix + (size_t)(b * S + tq) * 1024 + 768 + hm * 64, hf);
}

DI void dsa_att_unit(char* ws, int bh, int qt, int lane) {
  const int b = bh / 12, h = bh % 12;
  const int ql = lane & 31, hf = lane >> 5, tq = qt * 32 + ql;
  char* big = ws + OFF_BIG;
  const u16* Q = reinterpret_cast<const u16*>(big + BO_Q);
  const u16* K = reinterpret_cast<const u16*>(big + BO_K);
  const u16* VT = reinterpret_cast<const u16*>(big + BO_V);
  const unsigned* BM = reinterpret_cast<const unsigned*>(big + BO_BM) + (size_t)(b * S + tq) * 128;
  bf16x8 qf[4]; load_q(qf, Q + ((size_t)bh * S + tq) * 64, hf);
  AttState<2> st; att_init(st);
  const int pk = pi_swap(ql);
  const u16* kb = K + ((size_t)bh * S + pk) * 64 + 8 * hf;
  const u16* vb = VT + ((size_t)bh * 128) * 2048 + ql * 32 + 8 * hf;
  const int sh = 8 * hf;
  att_range<2>(st, qf, 0, qt,
               [kb](int kt) { return kb + kt * 2048; }, [vb](int kt) { return vb + kt * 2048; },
               [BM](int kt) { return ldg32(BM + kt); },
               [sh](int, unsigned w) { const unsigned ws_ = w >> sh; return [ws_](int r, float p) { return mask_bit(ws_, 16 * (r >> 3) + (r & 7), p); }; });
  u16* mix = reinterpret_cast<u16*>(ws + OFF_MIX);
  att_store<2>(st, mix + (size_t)(b * S + tq) * 1024 + h * 64, hf);
}

DI void moba_att_unit(char* ws, int bh, int qt, int lane) {
  const int b = bh / 12, h = bh % 12;
  const int ql = lane & 31, hf = lane >> 5, tq = qt * 32 + ql;
  char* big = ws + OFF_BIG;
  const u16* Q = reinterpret_cast<const u16*>(big + BO_Q);
  const u16* K = reinterpret_cast<const u16*>(big + BO_K);
  const u16* VT = reinterpret_cast<const u16*>(big + BO_V);
  const float* KM = reinterpret_cast<const float*>(ws + OFF_KMEAN) + (size_t)bh * 16 * 64;
  const u16* qrow = Q + ((size_t)bh * S + tq) * 64;
  bf16x8 qf[4]; load_q(qf, qrow, hf);
  const int own = qt >> 3;
  unsigned selmask = 0u;
  {
    float b0 = -3e38f, b1 = -3e38f, b2 = -3e38f; int i0 = -1, i1 = -1, i2 = -1;
    for (int n = 0; n < own; ++n) {
      float g = 0.f;
      for (int d8 = 0; d8 < 8; ++d8) {
        const u32x4 qq = *reinterpret_cast<const u32x4*>(qrow + d8 * 8);
        const float4 ka = *reinterpret_cast<const float4*>(KM + n * 64 + d8 * 8);
        const float4 kb = *reinterpret_cast<const float4*>(KM + n * 64 + d8 * 8 + 4);
        g += __uint_as_float(qq[0] << 16) * ka.x + __uint_as_float(qq[0] & 0xffff0000u) * ka.y
           + __uint_as_float(qq[1] << 16) * ka.z + __uint_as_float(qq[1] & 0xffff0000u) * ka.w
           + __uint_as_float(qq[2] << 16) * kb.x + __uint_as_float(qq[2] & 0xffff0000u) * kb.y
           + __uint_as_float(qq[3] << 16) * kb.z + __uint_as_float(qq[3] & 0xffff0000u) * kb.w;
      }
      if (g > b0) { b2 = b1; i2 = i1; b1 = b0; i1 = i0; b0 = g; i0 = n; }
      else if (g > b1) { b2 = b1; i2 = i1; b1 = g; i1 = n; }
      else if (g > b2) { b2 = g; i2 = n; }
    }
    if (i0 >= 0) selmask |= 1u << i0;
    if (i1 >= 0) selmask |= 1u << i1;
    if (i2 >= 0) selmask |= 1u << i2;
  }
  AttState<2> st; att_init(st);
  const int pk = pi_swap(ql);
  const u16* kb = K + ((size_t)bh * S + pk) * 64 + 8 * hf;
  const u16* vb = VT + ((size_t)bh * 128) * 2048 + ql * 32 + 8 * hf;
  for (int n = 0; n < own; ++n) {
    const unsigned minew = ((selmask >> n) & 1u) ? 0xffffffffu : 0u;
    if (!__any(minew != 0u)) continue;
    att_range<2>(st, qf, n * 8, n * 8 + 7,
                 [kb](int kt) { return kb + kt * 2048; }, [vb](int kt) { return vb + kt * 2048; },
                 [minew](int) { return minew; }, [](int, unsigned w) { return [w](int, float p) { return w != 0u ? p : 0.f; }; });
  }
  att_range<2>(st, qf, own * 8, qt,
               [kb](int kt) { return kb + kt * 2048; }, [vb](int kt) { return vb + kt * 2048; },
               [](int) { return 0u; },
               [hf, tq](int kt, unsigned) { const int dq = tq - (kt * 32 + 8 * hf); return [dq](int r, float p) { return 16 * (r >> 3) + (r & 7) <= dq ? p : 0.f; }; });
  u16* mix = reinterpret_cast<u16*>(ws + OFF_MIX);
  att_store<2>(st, mix + (size_t)(b * S + tq) * 1024 + h * 64, hf);
}

template <bool DSA>
DI void blk_att_unit(char* ws, char* smem, int wid, int lane, int bh, int Qb) {
  typedef __attribute__((address_space(3))) unsigned char* lds_p;
  typedef __attribute__((address_space(3))) unsigned* lds_u32p;
  constexpr int D = 6, R = 8, SLOT = 10240;
  lds_p lds = (lds_p)smem;
  const int b = bh / 12, h = bh % 12;
  const int ql = lane & 31, hf = lane >> 5, qt = Qb * 8 + wid, tq = qt * 32 + ql, nkt = Qb * 8 + 8;
  char* big = ws + OFF_BIG;
  const u16* Q = reinterpret_cast<const u16*>(big + BO_Q);
  const u16* K = reinterpret_cast<const u16*>(big + BO_K);
  const u16* VT = reinterpret_cast<const u16*>(big + BO_V);
  const u16* qrow = Q + ((size_t)bh * S + tq) * 64;
  bf16x8 qf[4]; load_q(qf, qrow, hf);
  unsigned selmask = 0u;
  if (!DSA) {
    const u16* KMB = reinterpret_cast<const u16*>(ws + OFF_KMEANB) + (size_t)bh * 16 * 64 + 8 * hf;
    f32x16 ga, gb;
#pragma unroll
    for (int r = 0; r < 16; ++r) { ga[r] = 0.f; gb[r] = 0.f; }
#pragma unroll
    for (int c = 0; c < 4; ++c) {
      ga = mfma32(ld8(KMB + (ql & 15) * 64 + c * 16), qf[c], ga);
      gb = mfma32(ld8(KMB + ((ql & 15) ^ 4) * 64 + c * 16), qf[c], gb);
    }
    float b0 = -3e38f, b1 = -3e38f, b2 = -3e38f; int i0 = -1, i1 = -1, i2 = -1;
#pragma unroll
    for (int r = 0; r < 8; ++r) {
#pragma unroll
      for (int t = 0; t < 2; ++t) {
        const int n = ((r & 3) + 8 * (r >> 2) + 4 * hf) ^ (4 * t);
        const float g = (n < Qb) ? (t == 0 ? ga[r] : gb[r]) : -3e38f;
        const bool c0 = g > b0, c1 = g > b1, c2 = g > b2;
        const float nb2 = c1 ? b1 : (c2 ? g : b2); const int ni2 = c1 ? i1 : (c2 ? n : i2);
        const float nb1 = c0 ? b0 : (c1 ? g : b1); const int ni1 = c0 ? i0 : (c1 ? n : i1);
        const float nb0 = c0 ? g : b0;             const int ni0 = c0 ? n : i0;
        b0 = nb0; b1 = nb1; b2 = nb2; i0 = ni0; i1 = ni1; i2 = ni2;
      }
    }
    if (b0 > -1e38f) selmask |= 1u << i0;
    if (b1 > -1e38f) selmask |= 1u << i1;
    if (b2 > -1e38f) selmask |= 1u << i2;
  }
  const char* src;
  {
    const int p = (wid & 3) * 64 + lane;
    if (wid < 4) { const int r = p >> 3, lc = (p & 7) ^ ((r >> 1) & 7); src = reinterpret_cast<const char*>(K + ((size_t)bh * S + r) * 64 + lc * 8); }
    else { const int d = p >> 2, lc = (p & 3) ^ ((d >> 2) & 3); src = reinterpret_cast<const char*>(VT + (size_t)bh * 128 * 2048 + d * 32 + lc * 8); }
  }
  const char* msrc = big + BO_BM + ((size_t)(b * S + Qb * 256 + ((wid & 3) * 64 + lane)) * 128) * 4;
  const unsigned ldsw = (unsigned)wid * 1024u, ldsm = 8192u + (unsigned)wid * 256u;
#define BA_ISSUE(kt_) do { const unsigned _sb = (unsigned)(((kt_) & (R - 1)) * SLOT); \
    __builtin_amdgcn_global_load_lds((const unsigned*)(src + (size_t)(kt_) * 4096), (lds_u32p)(lds + _sb + ldsw), 16, 0, 0); \
    if (DSA) __builtin_amdgcn_global_load_lds((const unsigned*)(msrc + (size_t)(kt_) * 4), (lds_u32p)(lds + _sb + ldsm), 4, 0, 0); } while (0)
#define BA_WAIT(n) asm volatile("s_waitcnt vmcnt(" #n ")" ::: "memory")
  int koff[4], voff[4];
  {
    const int kr = pi_swap(ql);
#pragma unroll
    for (int c = 0; c < 4; ++c) koff[c] = kr * 128 + (((2 * c + hf) ^ ((kr >> 1) & 7)) << 4);
#pragma unroll
    for (int dt = 0; dt < 2; ++dt)
#pragma unroll
      for (int c = 0; c < 2; ++c) { const int d = dt * 32 + ql; voff[dt * 2 + c] = 4096 + d * 64 + (((2 * c + hf) ^ ((d >> 2) & 3)) << 4); }
  }
  const int moff = 8192 + (wid * 32 + ql) * 4;
  AttState<2> st; att_init(st);
  asm volatile("" :: "v"(qf[0]), "v"(qf[1]), "v"(qf[2]), "v"(qf[3]));
  __builtin_amdgcn_s_barrier();
#pragma unroll
  for (int i = 0; i < D; ++i) BA_ISSUE(i);
  for (int kt = 0; kt < nkt; ++kt) {
    if (kt + D < nkt) BA_ISSUE(kt + D);
    int rem = nkt - 1 - kt; rem = rem > D ? D : rem;
    if (DSA) {
      switch (rem) { case 6: BA_WAIT(12); break; case 5: BA_WAIT(10); break; case 4: BA_WAIT(8); break; case 3: BA_WAIT(6); break;
                     case 2: BA_WAIT(4); break; case 1: BA_WAIT(2); break; default: BA_WAIT(0); break; }
    } else {
      switch (rem) { case 6: BA_WAIT(6); break; case 5: BA_WAIT(5); break; case 4: BA_WAIT(4); break; case 3: BA_WAIT(3); break;
                     case 2: BA_WAIT(2); break; case 1: BA_WAIT(1); break; default: BA_WAIT(0); break; }
    }
    __builtin_amdgcn_s_barrier();
    if (kt > qt) continue;
    unsigned wmask = 0xffffffffu;
    if (!DSA && kt < Qb * 8) {
      wmask = ((selmask >> (kt >> 3)) & 1u) ? 0xffffffffu : 0u;
      if (!__any(wmask != 0u)) continue;
    }
    lds_p img = lds + (kt & (R - 1)) * SLOT;
    Frags<2> f;
#pragma unroll
    for (int c = 0; c < 4; ++c) f.k[c] = *(const __attribute__((address_space(3))) bf16x8*)(img + koff[c]);
#pragma unroll
    for (int c = 0; c < 4; ++c) f.v[c] = *(const __attribute__((address_space(3))) bf16x8*)(img + voff[c]);
    if (DSA) {
      const unsigned w_ = (*(const __attribute__((address_space(3))) unsigned*)(img + moff)) >> (8 * hf);
      att_compute<2>(st, qf, f, nullptr, [w_](int r, float p) { return mask_bit(w_, 16 * (r >> 3) + (r & 7), p); });
    } else if (kt < Qb * 8) {
      att_compute<2>(st, qf, f, nullptr, [wmask](int, float p) { return wmask != 0u ? p : 0.f; });
    } else {
      const int dq = tq - (kt * 32 + 8 * hf);
      att_compute<2>(st, qf, f, nullptr, [dq](int r, float p) { return 16 * (r >> 3) + (r & 7) <= dq ? p : 0.f; });
    }
  }
#undef BA_ISSUE
#undef BA_WAIT
  u16* mix = reinterpret_cast<u16*>(ws + OFF_MIX);
  att_store<2>(st, mix + (size_t)(b * S + tq) * 1024 + h * 64, hf);
}

DI void dil_att_unit(char* ws, int u, int lane) {
  const int r16 = u & 15, T0 = (u >> 4) & 7, bhh = u >> 7, b = bhh >> 2, hh = bhh & 3;
  const int ql = lane & 31, hf = lane >> 5;
  const int tq = T0 * 512 + 16 * ql + r16;
  char* big = ws + OFF_BIG;
  const u16* Q = reinterpret_cast<const u16*>(big + BO_Q);
  const u16* K = reinterpret_cast<const u16*>(big + BO_K);
  AttState<6> st; att_init(st);
  const int pk = pi_swap(ql);
  for (int g = 0; g < 3; ++g) {
    const int sh = 2 * g, dil = 1 << sh, r = r16 & (dil - 1);
    const int bh = b * 12 + 4 * g + hh;
    bf16x8 qf[4];
    load_q(qf, Q + ((size_t)bh * S + tq) * 64, hf);
    const int jq = tq >> sh;
    const int jmin = (T0 * 512 + r16) >> sh, jmax = (T0 * 512 + 496 + r16) >> sh;
    int k0 = jmin - 128; k0 = k0 < 0 ? 0 : k0 >> 5;
    const u16* Vg = reinterpret_cast<const u16*>(big + BO_V + (size_t)g * SZ_QKV) + ((size_t)(bhh * dil + r) * (128 >> sh)) * 6144 + ql * 32 + 8 * hf;
    const u16* Kg = K + ((size_t)bh * S + r) * 64 + 8 * hf;
    att_range<6>(st, qf, k0, jmax >> 5,
                 [Kg, pk, sh](int jt) { return Kg + ((size_t)((jt * 32 + pk) << sh)) * 64; },
                 [Vg](int jt) { return Vg + (size_t)jt * 6144; },
                 [](int) { return 0u; },
                 [hf, jq](int jt, unsigned) { const int dq = jq - (jt * 32 + 8 * hf); return [dq](int rr, float p) { return (unsigned)(dq - (16 * (rr >> 3) + (rr & 7))) <= 128u ? p : 0.f; }; });
  }
  u16* mix = reinterpret_cast<u16*>(ws + OFF_MIX);
  att_store<6>(st, mix + (size_t)(b * S + tq) * 1024 + hh * 192, hf);
}

DI void ki_prep_phase(const Ctx& cx, char* ws, const float* g, const float* bta) {
  const int lane = cx.tid & 63, gw = cx.bid * WPB + __builtin_amdgcn_readfirstlane(cx.tid >> 6), nw = cx.nb * WPB;
  const float* raw = reinterpret_cast<const float*>(ws + OFF_BIG + BO_KIRAW);
  u16* kib = reinterpret_cast<u16*>(ws + OFF_BIG + BO_KIB);
  const float* cs = reinterpret_cast<const float*>(ws + OFF_COS);
  const float* sn = reinterpret_cast<const float*>(ws + OFF_SIN);
  const float gg = g[lane], bb = bta[lane];
  constexpr int RB = 4;
  for (int r0 = gw * RB; r0 < T; r0 += nw * RB) {
    float v[RB], c[RB], s[RB];
#pragma unroll
    for (int k = 0; k < RB; ++k) {
      v[k] = raw[(size_t)(r0 + k) * 64 + lane];
      c[k] = cs[(r0 + k) * 8 + (lane & 7)]; s[k] = sn[(r0 + k) * 8 + (lane & 7)];
    }
    float mu[RB], d[RB], rs[RB];
#pragma unroll
    for (int k = 0; k < RB; ++k) mu[k] = wave_sum(v[k]) * (1.f / 64.f);
#pragma unroll
    for (int k = 0; k < RB; ++k) { d[k] = v[k] - mu[k]; rs[k] = rsqrtf(wave_sum(d[k] * d[k]) * (1.f / 64.f) + LN_EPS); }
#pragma unroll
    for (int k = 0; k < RB; ++k) {
      float y = d[k] * rs[k] * gg + bb;
      const float py = sx<8>(y);
      if (lane < 16) y = lane < 8 ? y * c[k] - py * s[k] : y * c[k] + py * s[k];
      kib[(size_t)(r0 + k) * 64 + rope_pos(lane)] = f2bf(y);
    }
  }
}

DI float relu1(float x) { return __builtin_amdgcn_fmed3f(x, 0.f, 3.0e38f); }
DI unsigned sortable(float f) { unsigned u = __float_as_uint(f); u = (u & 0x80000000u) ? ~u : (u | 0x80000000u); return u & ~((1u << SEL_LOW_BIT) - 1u); }

DI int wave_total(int v) {
  v += __builtin_amdgcn_update_dpp(0, v, 0x111, 0xf, 0xf, true);
  v += __builtin_amdgcn_update_dpp(0, v, 0x112, 0xf, 0xf, true);
  v += __builtin_amdgcn_update_dpp(0, v, 0x114, 0xf, 0xf, true);
  v += __builtin_amdgcn_update_dpp(0, v, 0x118, 0xf, 0xf, true);
  v += __builtin_amdgcn_update_dpp(0, v, 0x142, 0xa, 0xf, true);
  v += __builtin_amdgcn_update_dpp(0, v, 0x143, 0xc, 0xf, true);
  return __builtin_amdgcn_readlane(v, 63);
}

DI unsigned long long select256(const unsigned (&u)[64], int lane) {
  unsigned th = 0u;
  int g = 0;
  for (int bit = 31; bit >= SEL_LOW_BIT; --bit) {
    const unsigned c = th | (1u << bit);
    int cnt = 0;
#pragma unroll
    for (int r = 0; r < 64; r += 8)
      asm("v_cmp_le_u32 vcc, %1, %2\n\tv_addc_co_u32 %0, vcc, 0, %0, vcc\n\t"
          "v_cmp_le_u32 vcc, %1, %3\n\tv_addc_co_u32 %0, vcc, 0, %0, vcc\n\t"
          "v_cmp_le_u32 vcc, %1, %4\n\tv_addc_co_u32 %0, vcc, 0, %0, vcc\n\t"
          "v_cmp_le_u32 vcc, %1, %5\n\tv_addc_co_u32 %0, vcc, 0, %0, vcc\n\t"
          "v_cmp_le_u32 vcc, %1, %6\n\tv_addc_co_u32 %0, vcc, 0, %0, vcc\n\t"
          "v_cmp_le_u32 vcc, %1, %7\n\tv_addc_co_u32 %0, vcc, 0, %0, vcc\n\t"
          "v_cmp_le_u32 vcc, %1, %8\n\tv_addc_co_u32 %0, vcc, 0, %0, vcc\n\t"
          "v_cmp_le_u32 vcc, %1, %9\n\tv_addc_co_u32 %0, vcc, 0, %0, vcc"
          : "+v"(cnt) : "s"(c), "v"(u[r]), "v"(u[r + 1]), "v"(u[r + 2]), "v"(u[r + 3]), "v"(u[r + 4]), "v"(u[r + 5]), "v"(u[r + 6]), "v"(u[r + 7]) : "vcc");
    const int n = wave_total(cnt);
    if (n == 256) { th = c - 1u; g = 256; break; }
    if (n > 256) th = c; else g = n;
  }
  int need = th == 0u ? 0 : 256 - g;
  int mlo = 0, mhi = 0;
#pragma unroll
  for (int r = 0; r < 64; ++r) {
    const unsigned long long gt = __ballot(u[r] > th), eq = __ballot(u[r] == th);
    unsigned long long tk = 0ull;
    if (need > 0 && eq != 0ull) {
      const int pre = __builtin_amdgcn_mbcnt_hi((unsigned)(eq >> 32), __builtin_amdgcn_mbcnt_lo((unsigned)eq, 0u));
      tk = __ballot(u[r] == th && pre < need);
      need -= __popcll(tk);
    }
    const unsigned long long mv = gt | tk;
    asm volatile("s_nop 3\n\tv_writelane_b32 %0, %2, %4\n\tv_writelane_b32 %1, %3, %4" : "+v"(mlo), "+v"(mhi) : "s"((unsigned)mv), "s"((unsigned)(mv >> 32)), "n"(r));
  }
  return ((unsigned long long)(unsigned)mhi << 32) | (unsigned)mlo;
}

DI void dsa_select_block(char* ws, char* smem, int wid, int lane, int b, int t0, int gwave) {
  typedef __attribute__((address_space(3))) unsigned char* lds_p;
  lds_p lds = (lds_p)smem;
  char* big = ws + OFF_BIG;
  const u16* QI = reinterpret_cast<const u16*>(big + BO_QI);
  const char* kbase = big + BO_KIB + (size_t)b * S * 128;
  const float* WI = reinterpret_cast<const float*>(big + BO_WI);
  unsigned long long* BM = reinterpret_cast<unsigned long long*>(big + BO_BM);
  unsigned* scr = reinterpret_cast<unsigned*>(big + BO_SCR) + (size_t)gwave * 4096 + lane;
  const int tA = t0 + 2 * wid, nch = ((t0 + 15) >> 8) + 1;
  const int row = lane & 15, kq = lane >> 4, tid = wid * 64 + lane;
  const u16* qip = QI + ((size_t)(b * S + tA + (row >> 3)) * 8 + (row & 7)) * 64 + kq * 8;
  const bf16x8 qa0 = ld8(qip), qa1 = ld8(qip + 32);
  const float4 w = *reinterpret_cast<const float4*>(WI + (size_t)(b * S + tA + (kq >> 1)) * 8 + (kq & 1) * 4);
  unsigned soff[4];
#pragma unroll
  for (int i = 0; i < 4; ++i) { const int p = i * 512 + tid, r = p >> 3, lc = (p & 7) ^ ((r >> 1) & 7); soff[i] = (unsigned)(r * 128 + lc * 16); }
  const unsigned ldsw = (unsigned)wid * 1024u;
#define SEL_ISSUE(c, slot) do { _Pragma("unroll") for (int _i = 0; _i < 4; ++_i) \
    __builtin_amdgcn_global_load_lds((const unsigned*)(kbase + (size_t)(c) * 32768 + soff[_i]), (__attribute__((address_space(3))) unsigned*)(lds + (slot) * 32768 + _i * 8192 + ldsw), 16, 0, 0); } while (0)
#define SEL_WAIT(n) asm volatile("s_waitcnt vmcnt(" #n ")" ::: "memory")
  int boff[2];
#pragma unroll
  for (int kk = 0; kk < 2; ++kk) boff[kk] = row * 128 + (((kk * 4 + kq) ^ ((row >> 1) & 7)) << 4);
  asm volatile("" :: "v"(qa0), "v"(qa1), "v"(w.x), "v"(w.y), "v"(w.z), "v"(w.w));
  __builtin_amdgcn_s_barrier();
  SEL_ISSUE(0, 0);
  if (nch > 1) SEL_ISSUE(1, 1);
  unsigned u[64];
#pragma unroll
  for (int c = 0; c < 16; ++c) {
    if (c < nch) {
      if (c + 2 < nch) { SEL_ISSUE(c + 2, (c + 2) & 3); SEL_WAIT(8); }
      else if (c + 1 < nch) SEL_WAIT(4);
      else SEL_WAIT(0);
      __builtin_amdgcn_s_barrier();
      lds_p img = lds + (c & 3) * 32768;
#pragma unroll
      for (int rr = 0; rr < 4; ++rr) {
        const int r = c * 4 + rr;
        float sa[4], sb[4];
        bf16x8 kb0[4], kb1[4];
#pragma unroll
        for (int tt = 0; tt < 4; ++tt) {
          const int tile = rr * 4 + tt;
          kb0[tt] = *(const __attribute__((address_space(3))) bf16x8*)(img + tile * 2048 + boff[0]);
          kb1[tt] = *(const __attribute__((address_space(3))) bf16x8*)(img + tile * 2048 + boff[1]);
        }
        f32x4 cc[4];
#pragma unroll
        for (int tt = 0; tt < 4; ++tt) cc[tt] = mfma16(qa0, kb0[tt], f32x4{0.f, 0.f, 0.f, 0.f});
#pragma unroll
        for (int tt = 0; tt < 4; ++tt) cc[tt] = mfma16(qa1, kb1[tt], cc[tt]);
        float pp[4], ps[4];
#pragma unroll
        for (int tt = 0; tt < 4; ++tt) pp[tt] = w.x * relu1(cc[tt][0]) + w.y * relu1(cc[tt][1]) + w.z * relu1(cc[tt][2]) + w.w * relu1(cc[tt][3]);
#pragma unroll
        for (int tt = 0; tt < 4; ++tt) ps[tt] = sx<16>(pp[tt]);
#pragma unroll
        for (int tt = 0; tt < 4; ++tt) {
          const float pt = pp[tt] + ps[tt];
          const int iv = __builtin_bit_cast(int, pt); int iw = iv; asm volatile("" : "+v"(iw));
          auto sw = __builtin_amdgcn_permlane32_swap(iv, iw, false, false);
          sa[tt] = __builtin_bit_cast(float, (int)sw[0]); sb[tt] = __builtin_bit_cast(float, (int)sw[1]);
        }
        const float scA = kq == 0 ? sa[0] : kq == 1 ? sa[1] : kq == 2 ? sa[2] : sa[3];
        const float scB = kq == 0 ? sb[0] : kq == 1 ? sb[1] : kq == 2 ? sb[2] : sb[3];
        const int key = r * 64 + lane;
        u[r] = key <= tA ? sortable(scA) : 0u;
        stg4(scr + r * 64, key <= tA + 1 ? sortable(scB) : 0u);
      }
    } else {
#pragma unroll
      for (int rr = 0; rr < 4; ++rr) { u[c * 4 + rr] = 0u; stg4(scr + (c * 4 + rr) * 64, 0u); }
    }
  }
#undef SEL_ISSUE
#undef SEL_WAIT
  const unsigned long long mA = select256(u, lane);
  stg8(BM + (size_t)(b * S + tA) * 64 + lane, make_uint2((unsigned)mA, (unsigned)(mA >> 32)));
#pragma unroll
  for (int r = 0; r < 64; ++r) u[r] = ldg32(scr + r * 64);
  const unsigned long long mB = select256(u, lane);
  stg8(BM + (size_t)(b * S + tA + 1) * 64 + lane, make_uint2((unsigned)mB, (unsigned)(mB >> 32)));
}

DI void kmean_phase(const Ctx& cx, char* ws) {
  const int lane = cx.tid & 63, gw = cx.bid * WPB + __builtin_amdgcn_readfirstlane(cx.tid >> 6), nw = cx.nb * WPB;
  const u16* K = reinterpret_cast<const u16*>(ws + OFF_BIG + BO_K);
  float* KM = reinterpret_cast<float*>(ws + OFF_KMEAN);
  for (int u = gw; u < NB * 12 * 16; u += nw) {
    const int bh = u >> 4, blk = u & 15;
    const u16* kp = K + ((size_t)bh * S + blk * 256) * 64 + lane * 8;
    float acc[8];
#pragma unroll
    for (int j = 0; j < 8; ++j) acc[j] = 0.f;
#pragma unroll 8
    for (int i = 0; i < 32; ++i) {
      const u32x4 v = __builtin_bit_cast(u32x4, ld8(kp + i * 512));
#pragma unroll
      for (int j = 0; j < 4; ++j) { acc[2 * j] += __uint_as_float(v[j] << 16); acc[2 * j + 1] += __uint_as_float(v[j] & 0xffff0000u); }
    }
#pragma unroll
    for (int j = 0; j < 8; ++j) { float a = acc[j]; a += sx<8>(a); a += sx<16>(a); a = red32_sum(a); acc[j] = a * (1.f / 256.f); }
    if (lane < 8) {
      float* dst = KM + (size_t)u * 64 + lane * 8;
      *reinterpret_cast<float4*>(dst) = make_float4(acc[0], acc[1], acc[2], acc[3]);
      *reinterpret_cast<float4*>(dst + 4) = make_float4(acc[4], acc[5], acc[6], acc[7]);
      *reinterpret_cast<uint4*>(reinterpret_cast<u16*>(ws + OFF_KMEANB) + (size_t)u * 64 + lane * 8) =
          make_uint4(pk2(acc[0], acc[1]), pk2(acc[2], acc[3]), pk2(acc[4], acc[5]), pk2(acc[6], acc[7]));
    }
  }
}

DI void grid_barrier(unsigned* cnt, unsigned target, int tid) {
  asm volatile("s_waitcnt vmcnt(0)" ::: "memory");
  __syncthreads();
  if (tid == 0) {
    __builtin_amdgcn_fence(__ATOMIC_RELEASE, "agent");
    asm volatile("s_waitcnt vmcnt(0)" ::: "memory");
    __hip_atomic_fetch_add(cnt, 1u, __ATOMIC_RELAXED, __HIP_MEMORY_SCOPE_AGENT);
    while (__hip_atomic_load(cnt, __ATOMIC_RELAXED, __HIP_MEMORY_SCOPE_AGENT) < target) __builtin_amdgcn_s_sleep(1);
    __builtin_amdgcn_fence(__ATOMIC_ACQUIRE, "agent");
    asm volatile("s_waitcnt vmcnt(0)" ::: "memory");
  }
  __syncthreads();
}

#define XB_TMO      128
#define XB_XCNT(j)  (256  + 64 * (j))
#define XB_XSUB(j)  (1280 + 64 * (j))
#define XB_XGEN(j)  (2304 + 64 * (j))
#define XB_TOP      3328
#define XB_TOPGEN   3392
#define XB_SPIN_CAP (1u << 20)
DI unsigned xb_ld(unsigned* p) { return __hip_atomic_load(p, __ATOMIC_RELAXED, __HIP_MEMORY_SCOPE_AGENT); }
DI unsigned xb_add(unsigned* p, unsigned v) { return __hip_atomic_fetch_add(p, v, __ATOMIC_RELAXED, __HIP_MEMORY_SCOPE_AGENT); }
DI unsigned xb_xcc_id() { return (unsigned)__builtin_amdgcn_s_getreg((3 << 11) | 20) & 0xFu; }
#define XB_SPIN(cond, bar) do { unsigned _sp = 0; while (cond) { __builtin_amdgcn_s_sleep(1); \
    if ((++_sp & 255u) == 0u) { if (xb_ld(&(bar)[XB_TMO])) break; if (_sp > XB_SPIN_CAP) { atomicAdd(&(bar)[XB_TMO], 1u); break; } } } } while (0)
typedef volatile __attribute__((address_space(3))) unsigned* xb_lds_p;
DI void xcd_barrier_complete(unsigned* bar, unsigned x, unsigned G, unsigned& nloc, unsigned& nx) {
  unsigned sum, cnt, mine, sp = 0u;
  for (;;) {
    sum = 0u; cnt = 0u; mine = 0u;
#pragma unroll
    for (unsigned j = 0; j < 16; ++j) { const unsigned c = xb_ld(&bar[XB_XCNT(j)]); sum += c; cnt += (c > 0u) ? 1u : 0u; mine = (j == x) ? c : mine; }
    if (sum == G) break;
    __builtin_amdgcn_s_sleep(1);
    if ((++sp & 255u) == 0u) { if (xb_ld(&bar[XB_TMO])) break; if (sp > XB_SPIN_CAP) { atomicAdd(&bar[XB_TMO], 1u); break; } }
  }
  nloc = mine > 0u ? mine : 1u; nx = cnt > 0u ? cnt : 1u;
}
DI void xcd_barrier(unsigned* bar, unsigned x, xb_lds_p st, unsigned G, int tid) {
  asm volatile("s_waitcnt vmcnt(0)" ::: "memory");
  __syncthreads();
  if (tid == 0) {
    __builtin_amdgcn_s_waitcnt(0);
    unsigned nloc = st[0], nx = st[1];
    if (nloc == 0u) { xcd_barrier_complete(bar, x, G, nloc, nx); st[0] = nloc; st[1] = nx; }
    const unsigned old = xb_add(&bar[XB_XSUB(x)], 1u);
    const unsigned gen = old / nloc;
    if (old + 1u == (gen + 1u) * nloc) {
      __builtin_amdgcn_fence(__ATOMIC_RELEASE, "agent");
      asm volatile("s_waitcnt vmcnt(0)" ::: "memory");
      const unsigned og = xb_add(&bar[XB_TOP], 1u);
      const unsigned tg = og / nx;
      if (og + 1u == (tg + 1u) * nx) xb_add(&bar[XB_TOPGEN], 1u);
      else XB_SPIN(xb_ld(&bar[XB_TOPGEN]) == tg, bar);
      __builtin_amdgcn_fence(__ATOMIC_ACQUIRE, "agent");
      xb_add(&bar[XB_XGEN(x)], 1u);
      asm volatile("s_waitcnt vmcnt(0)" ::: "memory");
    } else {
      XB_SPIN(xb_ld(&bar[XB_XGEN(x)]) == gen, bar);
      __builtin_amdgcn_fence(__ATOMIC_ACQUIRE, "agent");
      asm volatile("s_waitcnt vmcnt(0)" ::: "memory");
    }
  }
  __syncthreads();
}

template <class Epi>
DI void run_gemm(const Ctx& cx, char* smem, const u16* A, const u16* Bt, int M, int N, int K, int crot, const Epi& epi) {
  pg8::StaticOrder so; so.init(M, N, cx.nb, (cx.bid + crot) % cx.nb);
  pg8::gemm_phase(cx.tid, (PG8_LAS unsigned char*)smem, pg8::Gemm{A, Bt, M, N, K}, so, epi);
}

__global__ void __launch_bounds__(NTHR, 2) fwd_kernel(Params p) {
  extern __shared__ __attribute__((aligned(16))) char smem[];
  cg::grid_group grid = cg::this_grid();
  bool first = true;
  const int wave_id = __builtin_amdgcn_readfirstlane(threadIdx.x >> 6);
  xb_lds_p xb_st = (xb_lds_p)(smem + LDS_BYTES);
  unsigned* xb_bar = reinterpret_cast<unsigned*>(p.ws + OFF_BAR);
  const unsigned xb_x = xb_xcc_id();
  if (threadIdx.x == 0) { xb_st[0] = 0u; xb_st[1] = 0u; (void)xb_add(&xb_bar[XB_XCNT(xb_x)], 1u); }
  __syncthreads();
  if (p.ph_lo == 0) {
    Ctx cx; cx.tid = threadIdx.x; cx.bid = blockIdx.x; cx.nb = gridDim.x;
    if (EN & 1) phase0(cx, p, p.ws, smem);
    if (XP0) phase0(cx, p, p.ws, smem);
    for (int i = 0; i < XSYNC; ++i) grid.sync();
    first = false;
  }
  bool rep_done = false;
  int nbar = 0;
  for (int ph = p.ph_lo < 1 ? 1 : p.ph_lo; ph < p.ph_hi; ++ph) {
    const int layer = (ph - 1) / 9, slot = (ph - 1) % 9;
    if (REP) { if (((REP >> slot) & 1) && ((REPL >> layer) & 1) && !rep_done) { rep_done = true; --ph; } else rep_done = false; }
    const int kind = layer % 3, jl = layer / 3;
    if ((slot == 1 && kind == 1) || (slot == 2 && kind != 0)) continue;
    if (!first) {
      if (nbar == 0) grid.sync();
      else xcd_barrier(reinterpret_cast<unsigned*>(p.ws + OFF_BAR), xb_x, xb_st, gridDim.x, (int)threadIdx.x);
      ++nbar;
    }
    first = false;
    typedef const Params __attribute__((address_space(4)))* KArgs;
    KArgs pp = (KArgs)__builtin_amdgcn_kernarg_segment_ptr();
    asm volatile("" : "+s"(pp));
    char* ws = pp->ws; float* outp = pp->out;
    Ctx cx; cx.bid = blockIdx.x; cx.nb = gridDim.x;
    int wid = wave_id;
    asm volatile("" : "+s"(ws), "+s"(outp), "+s"(wid), "+s"(cx.bid), "+s"(cx.nb));
    unsigned ones = ~0u; asm volatile("" : "+s"(ones));
    const int lane = __builtin_amdgcn_mbcnt_hi(ones, __builtin_amdgcn_mbcnt_lo(ones, 0u));
    cx.tid = wid * 64 + lane;
    const int gw = cx.bid * WPB + wid, nw = cx.nb * WPB;
    if (slot == 0 && (EN & 2)) {
      const int nmain = kind == 0 ? NMAIN_A : NMAIN_BC;
      run_gemm(cx, smem, reinterpret_cast<const u16*>(ws + OFF_XB), reinterpret_cast<const u16*>(ws + win_off(layer)), T, nmain, 1024, 0, EpiInProj{ws, kind});
      run_gemm(cx, smem, reinterpret_cast<const u16*>(ws + win_off(layer)) + (size_t)nmain * 1024, reinterpret_cast<const u16*>(ws + OFF_XB), 768, T, 1024, kind == 0 ? 0 : cx.nb / 2, EpiVt{ws, kind});
      if (layer == 0 && (EN & 2048))
        run_gemm(cx, smem, reinterpret_cast<const u16*>(ws + OFF_MEMN), reinterpret_cast<const u16*>(ws + OFF_WMKV), NB * NMEM, 4 * 512, 1024, cx.nb / 2, EpiMemKV{ws});
    } else if (slot == 1 && (EN & 4)) {
      if (kind == 0) ki_prep_phase(cx, ws, pp->idx_g + jl * 64, pp->idx_b + jl * 64);
      else kmean_phase(cx, ws);
    } else if (slot == 2 && (EN & 8)) {
      for (int v = cx.bid; v < NB * (S / 16); v += cx.nb) {
        const int b = v >> 8, idx = v & 255, j = (b & 1) ? 255 - idx : idx;
        dsa_select_block(ws, smem, wid, lane, b, j * 16, gw);
      }
    } else if (slot == 3) {
      if (EN & 128) for (int u = gw; u < NB * 4 * 128; u += nw) mem_att_unit(ws, layer, kind, u, lane);
      if (kind == 1 && (EN & 16)) {
        for (int u = gw; u < NB * 4 * 8 * 16; u += nw) dil_att_unit(ws, u, lane);
      } else {
        for (int k = 0; k * cx.nb < NB * 12 * 16; ++k) {
          const int v = k * cx.nb + ((k & 1) ? cx.nb - 1 - cx.bid : cx.bid);
          if (v >= NB * 12 * 16) continue;
          const int Qb = 15 - v / 96, bh = v % 96;
          if (kind == 0) { if (EN & 32) blk_att_unit<true>(ws, smem, wid, lane, bh, Qb); }
          else { if (EN & 64) blk_att_unit<false>(ws, smem, wid, lane, bh, Qb); }
        }
      }
    } else if (slot == 4 && (EN & 256)) {
      run_gemm(cx, smem, reinterpret_cast<const u16*>(ws + OFF_MIX), reinterpret_cast<const u16*>(ws + OFF_WOUT + layer * SZ_WOUT), T, 1024, 1024, 0, EpiResid{layer == 0 ? pp->x : outp, outp, layer == 0 ? nullptr : reinterpret_cast<const float2*>(ws + OFF_STAT), pp->ln2g + (layer - 1) * 1024, pp->ln2b + (layer - 1) * 1024});
    } else if (slot == 5) {
      ln_phase(cx, outp, pp->ln1g + layer * 1024, pp->ln1b + layer * 1024, reinterpret_cast<u16*>(ws + OFF_XB), reinterpret_cast<float2*>(ws + OFF_STAT), false);
    } else if (slot == 6 && (EN & 512)) {
      run_gemm(cx, smem, reinterpret_cast<const u16*>(ws + OFF_XB), reinterpret_cast<const u16*>(ws + OFF_WGU + layer * SZ_WGU), T, 2 * DFF, 1024, 0, EpiSwiGLU{reinterpret_cast<u16*>(ws + OFF_BIG + BO_H)});
    } else if (slot == 7 && (EN & 1024)) {
      run_gemm(cx, smem, reinterpret_cast<const u16*>(ws + OFF_BIG + BO_H), reinterpret_cast<const u16*>(ws + OFF_WDN + layer * SZ_WDN), T, 1024, DFF, 0, EpiResid{outp, outp, reinterpret_cast<const float2*>(ws + OFF_STAT), pp->ln1g + layer * 1024, pp->ln1b + layer * 1024});
    } else {
      ln_phase(cx, outp, pp->ln2g + layer * 1024, pp->ln2b + layer * 1024, reinterpret_cast<u16*>(ws + OFF_XB), reinterpret_cast<float2*>(ws + OFF_STAT), layer == DEPTH - 1);
    }
  }
}

extern "C" void kernel_launch(void* const* d_in, const int* in_sizes, int n_in, void* d_out, int out_size,
                              void* d_ws, size_t ws_size, hipStream_t stream) {
  static int grid_blocks = 0;
  if (!grid_blocks) {
    int dev = 0, cus = 0, per_cu = 0;
    (void)hipGetDevice(&dev);
    (void)hipDeviceGetAttribute(&cus, hipDeviceAttributeMultiprocessorCount, dev);
    if (hipFuncSetAttribute((const void*)fwd_kernel, hipFuncAttributeMaxDynamicSharedMemorySize, LDS_TOTAL) != hipSuccess)
      fprintf(stderr, "hipFuncSetAttribute(max dynamic LDS) failed\n");
    (void)hipOccupancyMaxActiveBlocksPerMultiprocessor(&per_cu, fwd_kernel, NTHR, LDS_TOTAL);
    if (per_cu < 1) fprintf(stderr, "occupancy query reports %d blocks per CU\n", per_cu);
    grid_blocks = cus;
  }
  if (ws_size < WS_NEED) fprintf(stderr, "workspace too small: %zu < %zu\n", ws_size, (size_t)WS_NEED);
  Params p{};
  p.x = (const float*)d_in[0]; p.mem = (const float*)d_in[1]; p.pos = (const int*)d_in[2];
  p.mem_g = (const float*)d_in[3]; p.mem_b = (const float*)d_in[4];
  p.w_in_a = (const float*)d_in[5]; p.idx_g = (const float*)d_in[6]; p.idx_b = (const float*)d_in[7];
  p.w_in_b = (const float*)d_in[8]; p.w_in_c = (const float*)d_in[9];
  p.w_mkv = (const float*)d_in[10]; p.w_out = (const float*)d_in[11];
  p.ln1g = (const float*)d_in[12]; p.ln1b = (const float*)d_in[13];
  p.w_gu = (const float*)d_in[14]; p.w_dn = (const float*)d_in[15];
  p.ln2g = (const float*)d_in[16]; p.ln2b = (const float*)d_in[17];
  p.out = (float*)d_out; p.ws = (char*)d_ws;
  for (int i = 0; i < 8; ++i) p.inv_freq[i] = (float)pow(500000.0, -(double)i / 8.0);
  const int NPH = 1 + DEPTH * 9;
#if SINGLE_LAUNCH
  (void)hipMemsetAsync((char*)d_ws + OFF_BAR, 0, (size_t)XCD_BAR_WORDS * 4, stream);
  p.ph_lo = 0; p.ph_hi = NPH;
  void* args[] = {&p};
  hipError_t e = hipLaunchCooperativeKernel((void*)fwd_kernel, dim3(grid_blocks), dim3(NTHR), args, LDS_TOTAL, stream);
  if (e != hipSuccess) fprintf(stderr, "cooperative launch failed: %s (grid %d)\n", hipGetErrorString(e), grid_blocks);
#else
  for (int ph = 0; ph < NPH; ++ph) {
    if (ph > 0) {
      const int layer = (ph - 1) / 9, slot = (ph - 1) % 9, kind = layer % 3;
      if ((slot == 1 && kind == 1) || (slot == 2 && kind != 0)) continue;
    }
    p.ph_lo = ph; p.ph_hi = ph + 1;
    hipLaunchKernelGGL(fwd_kernel, dim3(grid_blocks), dim3(NTHR), LDS_TOTAL, stream, p);
  }
#endif
}
```

```cpp
#include <hip/hip_runtime.h>
#include <hip/hip_cooperative_groups.h>
#include <cstdio>
#include <cmath>
namespace cg = cooperative_groups;

#ifndef EN
#define EN 0xFFFF
#endif
#ifndef SEL_LOW_BIT
#define SEL_LOW_BIT 8
#endif
#ifndef XSYNC
#define XSYNC 0
#endif
#ifndef XP0
#define XP0 0
#endif
#ifndef REP
#define REP 0
#endif
#ifndef REPL
#define REPL 15
#endif
#ifndef SINGLE_LAUNCH
#define SINGLE_LAUNCH 1
#endif

#define DI __device__ __forceinline__
typedef unsigned short u16;
using bf16x8 = __attribute__((ext_vector_type(8))) __bf16;
using bf2 = __attribute__((ext_vector_type(2))) __bf16;
using f32x4 = __attribute__((ext_vector_type(4))) float;
using f32x16 = __attribute__((ext_vector_type(16))) float;
using u32x4 = __attribute__((ext_vector_type(4))) unsigned;

constexpr int NB = 8, S = 4096, DM = 1024, T = NB * S, DEPTH = 4;
constexpr int NMEM = 256, DFF = 2816;
constexpr int NPAD_A = 3328, NPAD_BC = 2560;
constexpr int NMAIN_A = 2560, NMAIN_BC = 1792;
constexpr int NTHR = 512, WPB = 8;
constexpr int LDS_BYTES = 131072;
constexpr int LDS_TOTAL = LDS_BYTES + 16;
constexpr float ALPHA = 1.681792830507429f;
constexpr float LN_EPS = 1e-5f;

constexpr size_t SZ_WIN_A = (size_t)NPAD_A * 1024 * 2, SZ_WIN_BC = (size_t)NPAD_BC * 1024 * 2;
constexpr size_t OFF_WIN0 = 0;
constexpr size_t OFF_WIN1 = OFF_WIN0 + SZ_WIN_A;
constexpr size_t OFF_WIN2 = OFF_WIN1 + SZ_WIN_BC;
constexpr size_t OFF_WIN3 = OFF_WIN2 + SZ_WIN_BC;
constexpr size_t OFF_WMKV = OFF_WIN3 + SZ_WIN_A;
constexpr size_t SZ_WMKV = (size_t)512 * 1024 * 2;
constexpr size_t OFF_WOUT = OFF_WMKV + 4 * SZ_WMKV;
constexpr size_t SZ_WOUT = (size_t)1024 * 1024 * 2;
constexpr size_t OFF_WGU = OFF_WOUT + 4 * SZ_WOUT;
constexpr size_t SZ_WGU = (size_t)5632 * 1024 * 2;
constexpr size_t OFF_WDN = OFF_WGU + 4 * SZ_WGU;
constexpr size_t SZ_WDN = (size_t)1024 * 2816 * 2;
constexpr size_t OFF_XB = OFF_WDN + 4 * SZ_WDN;
constexpr size_t SZ_XB = (size_t)T * 1024 * 2;
constexpr size_t OFF_MIX = OFF_XB + SZ_XB;
constexpr size_t OFF_MEMN = OFF_MIX + SZ_XB;
constexpr size_t OFF_MK = OFF_MEMN + (size_t)2048 * 1024 * 2;
constexpr size_t SZ_MK = (size_t)8 * 4 * 256 * 64 * 2;
constexpr size_t OFF_MVT = OFF_MK + 4 * SZ_MK;
constexpr size_t OFF_COS = OFF_MVT + 4 * SZ_MK;
constexpr size_t OFF_SIN = OFF_COS + (size_t)T * 8 * 4;
constexpr size_t OFF_KMEAN = OFF_SIN + (size_t)T * 8 * 4;
constexpr size_t OFF_KMEANB = OFF_KMEAN + (size_t)8 * 12 * 16 * 64 * 4;
constexpr size_t OFF_BIG = OFF_KMEANB + (size_t)8 * 12 * 16 * 64 * 2;
constexpr size_t SZ_QKV = (size_t)T * 768 * 2;
constexpr size_t BO_Q = 0, BO_K = SZ_QKV, BO_V = 2 * SZ_QKV;
constexpr size_t BO_QM_AC = 3 * SZ_QKV, BO_QM_B = 5 * SZ_QKV;
constexpr size_t SZ_QM = (size_t)T * 256 * 2;
constexpr size_t BO_QI = BO_QM_AC + SZ_QM;
constexpr size_t BO_KIRAW = BO_QI + (size_t)T * 512 * 2;
constexpr size_t BO_KIB = BO_KIRAW + (size_t)T * 64 * 4;
constexpr size_t BO_WI = BO_KIB + (size_t)T * 64 * 2;
constexpr size_t BO_BM = BO_WI + (size_t)T * 8 * 4;
constexpr size_t BO_SCR = BO_BM + (size_t)T * 128 * 4;
constexpr size_t BO_H = 0;
constexpr size_t OFF_STAT = OFF_BIG + 5 * SZ_QKV + SZ_QM;
constexpr size_t OFF_BAR = OFF_STAT + (size_t)T * 8;
constexpr int XCD_BAR_WORDS = 3456;
constexpr size_t WS_NEED = OFF_BAR + (size_t)XCD_BAR_WORDS * 4;

struct Ctx { int tid, bid, nb; };

struct Params {
  const float* x; const float* mem; const int* pos; const float* mem_g; const float* mem_b;
  const float* w_in_a; const float* idx_g; const float* idx_b; const float* w_in_b; const float* w_in_c;
  const float* w_mkv; const float* w_out; const float* ln1g; const float* ln1b;
  const float* w_gu; const float* w_dn; const float* ln2g; const float* ln2b;
  float* out; char* ws;
  float inv_freq[8];
  int ph_lo, ph_hi;
};

DI unsigned pk2(float a, float b) { bf2 v; v[0] = (__bf16)a; v[1] = (__bf16)b; return __builtin_bit_cast(unsigned, v); }
DI u16 f2bf(float a) { return __builtin_bit_cast(u16, (__bf16)a); }
DI float bf2f(u16 b) { return __uint_as_float(((unsigned)b) << 16); }
typedef const bf16x8 __attribute__((address_space(1)))* gp_bf16x8;
typedef const unsigned __attribute__((address_space(1)))* gp_u32;
DI bf16x8 ld8(const u16* p) { return *((gp_bf16x8)(const void*)p); }
DI unsigned ldg32(const unsigned* p) { return *((gp_u32)(const void*)p); }
typedef unsigned u32x2v __attribute__((ext_vector_type(2)));
DI void stg16(void* p, uint4 v) { *((__attribute__((address_space(1))) u32x4*)p) = u32x4{v.x, v.y, v.z, v.w}; }
DI void stg16f(void* p, f32x4 v) { *((__attribute__((address_space(1))) f32x4*)p) = v; }
DI void stg8(void* p, uint2 v) { *((__attribute__((address_space(1))) u32x2v*)p) = u32x2v{v.x, v.y}; }
DI void stg4(void* p, unsigned v) { *((__attribute__((address_space(1))) unsigned*)p) = v; }
DI void stg2(void* p, u16 v) { *((__attribute__((address_space(1))) u16*)p) = v; }
DI f32x4 ldg4(const float* p) { return *((const __attribute__((address_space(1))) f32x4*)(const void*)p); }
typedef float f32x2v __attribute__((ext_vector_type(2)));
DI float2 ldg2(const float2* p) { const f32x2v v = *((const __attribute__((address_space(1))) f32x2v*)(const void*)p); return make_float2(v[0], v[1]); }
DI f32x4 mfma16(bf16x8 a, bf16x8 b, f32x4 c) { return __builtin_amdgcn_mfma_f32_16x16x32_bf16(a, b, c, 0, 0, 0); }
DI f32x16 mfma32(bf16x8 a, bf16x8 b, f32x16 c) { return __builtin_amdgcn_mfma_f32_32x32x16_bf16(a, b, c, 0, 0, 0); }
template <int M> DI float sx(float v) { return __builtin_bit_cast(float, __builtin_amdgcn_ds_swizzle(__builtin_bit_cast(int, v), (M << 10) | 0x1F)); }
DI float red32_sum(float v) { const int iv = __builtin_bit_cast(int, v); int iw = iv; asm volatile("" : "+v"(iw));
  auto r = __builtin_amdgcn_permlane32_swap(iv, iw, false, false); return __builtin_bit_cast(float, (int)r[0]) + __builtin_bit_cast(float, (int)r[1]); }
DI float red32_max(float v) { const int iv = __builtin_bit_cast(int, v); int iw = iv; asm volatile("" : "+v"(iw));
  auto r = __builtin_amdgcn_permlane32_swap(iv, iw, false, false); return fmaxf(__builtin_bit_cast(float, (int)r[0]), __builtin_bit_cast(float, (int)r[1])); }
DI float wave_sum(float v) { v += sx<1>(v); v += sx<2>(v); v += sx<4>(v); v += sx<8>(v); v += sx<16>(v); return red32_sum(v); }
DI size_t win_off(int layer) { return layer == 0 ? OFF_WIN0 : layer == 1 ? OFF_WIN1 : layer == 2 ? OFF_WIN2 : OFF_WIN3; }

DI int rope_pos(int c) { const int d = c & 63; return d < 16 ? (c & ~15) | (d & 3) | ((d & 4) << 1) | ((d & 8) >> 1) : c; }
DI int map_row(int kind, int c) {
  if (kind == 1) {
    if (c < 1536) return rope_pos(c);
    if (c < 2304) return NMAIN_A + (c - 1536);
    if (c < 2816) return 1792 + rope_pos(c - 2304);
    if (c < 2824) return 2368 + (c - 2816);
    if (c < 2888) return 2304 + (c - 2824);
    return 1536 + (c - 2888);
  }
  if (kind == 3) {
    if (c < 1536) return rope_pos(c);
    if (c < 2304) return NMAIN_BC + (c - 1536);
    return 1536 + (c - 2304);
  }
  if (kind == 2) {
    int isu = c >= DFF; int j = c - isu * DFF;
    return (j >> 7) * 256 + isu * 128 + (j & 127);
  }
  return c;
}

DI void conv_job(const Ctx& cx, const float* __restrict__ src, int Ks, int Ns, u16* __restrict__ dst, int kind, float* tile) {
  const int nnt = (Ns + 63) >> 6, nkt = Ks >> 8, tid = cx.tid;
  for (int t = cx.bid; t < nnt * nkt; t += cx.nb) {
    const int kt = t / nnt, nt = t % nnt;
    const int nn = tid & 63, n = nt * 64 + nn;
    float v[32];
#pragma unroll
    for (int i = 0; i < 32; ++i) { const int kk = i * 8 + (tid >> 6); v[i] = n < Ns ? src[(size_t)(kt * 256 + kk) * Ns + n] : 0.f; }
    __syncthreads();
#pragma unroll
    for (int i = 0; i < 32; ++i) tile[(i * 8 + (tid >> 6)) * 65 + nn] = v[i];
    __syncthreads();
#pragma unroll 4
    for (int i = 0; i < 16; ++i) {
      const int n2 = (tid >> 7) + 4 * i, k2 = tid & 127, nr = nt * 64 + n2;
      if (nr < Ns) {
        const int dr = map_row(kind, nr);
        *reinterpret_cast<unsigned*>(dst + (size_t)dr * Ks + kt * 256 + 2 * k2) = pk2(tile[(2 * k2) * 65 + n2], tile[(2 * k2 + 1) * 65 + n2]);
      }
    }
  }
}

DI void phase0(const Ctx& cx, const Params& p, char* ws, char* smem) {
  float* tile = reinterpret_cast<float*>(smem);
  for (int l = 0; l < DEPTH; ++l) {
    const int kind = l % 3, j = l / 3;
    const float* win = kind == 0 ? p.w_in_a + (size_t)j * 1024 * 3144 : kind == 1 ? p.w_in_b : p.w_in_c;
    conv_job(cx, win, 1024, kind == 0 ? 3144 : 2560, (u16*)(ws + win_off(l)), kind == 0 ? 1 : 3, tile);
    conv_job(cx, p.w_mkv + (size_t)l * 1024 * 512, 1024, 512, (u16*)(ws + OFF_WMKV + l * SZ_WMKV), 0, tile);
    conv_job(cx, p.w_out + (size_t)l * 1024 * 1024, 1024, 1024, (u16*)(ws + OFF_WOUT + l * SZ_WOUT), 0, tile);
    conv_job(cx, p.w_gu + (size_t)l * 1024 * 5632, 1024, 5632, (u16*)(ws + OFF_WGU + l * SZ_WGU), 2, tile);
    conv_job(cx, p.w_dn + (size_t)l * 2816 * 1024, 2816, 1024, (u16*)(ws + OFF_WDN + l * SZ_WDN), 0, tile);
  }
  const int gtid = cx.bid * NTHR + cx.tid, gn = cx.nb * NTHR;
  for (int l = 0; l < DEPTH; l += 3) {
    unsigned* d = reinterpret_cast<unsigned*>(ws + win_off(l) + (size_t)2376 * 1024 * 2);
    for (int i = gtid; i < (NMAIN_A - 2376) * 512; i += gn) d[i] = 0u;
  }
  {
    const float4* xs = reinterpret_cast<const float4*>(p.x);
    uint2* xd = reinterpret_cast<uint2*>(ws + OFF_XB);
    for (int i = gtid; i < T * 256; i += 4 * gn) {
      float4 v[4];
#pragma unroll
      for (int j = 0; j < 4; ++j) v[j] = xs[i + j * gn];
#pragma unroll
      for (int j = 0; j < 4; ++j) xd[i + j * gn] = make_uint2(pk2(v[j].x, v[j].y), pk2(v[j].z, v[j].w));
    }
  }
  {
    float* cs = reinterpret_cast<float*>(ws + OFF_COS); float* sn = reinterpret_cast<float*>(ws + OFF_SIN);
    for (int i = gtid; i < T * 8; i += gn) {
      int t = i >> 3, f = i & 7;
      float ang = (float)p.pos[t] * p.inv_freq[f];
      cs[i] = cosf(ang); sn[i] = sinf(ang);
    }
  }
  {
    const int lane = cx.tid & 63, gw = cx.bid * WPB + __builtin_amdgcn_readfirstlane(cx.tid >> 6), nw = cx.nb * WPB;
    u16* mn = reinterpret_cast<u16*>(ws + OFF_MEMN);
    for (int r = gw; r < NB * NMEM; r += nw) {
      const float4* src = reinterpret_cast<const float4*>(p.mem + (size_t)r * 1024);
      float4 v[4]; float s = 0.f;
      for (int i = 0; i < 4; ++i) { v[i] = src[i * 64 + lane]; s += v[i].x + v[i].y + v[i].z + v[i].w; }
      float mu = wave_sum(s) * (1.f / 1024.f);
      float q = 0.f;
      for (int i = 0; i < 4; ++i) { float a = v[i].x - mu, b = v[i].y - mu, c = v[i].z - mu, d = v[i].w - mu; q += a * a + b * b + c * c + d * d; }
      float rs = rsqrtf(wave_sum(q) * (1.f / 1024.f) + LN_EPS);
      for (int i = 0; i < 4; ++i) {
        int c = (i * 64 + lane) * 4;
        float4 g = *reinterpret_cast<const float4*>(p.mem_g + c), bb = *reinterpret_cast<const float4*>(p.mem_b + c);
        uint2 o = make_uint2(pk2((v[i].x - mu) * rs * g.x + bb.x, (v[i].y - mu) * rs * g.y + bb.y),
                             pk2((v[i].z - mu) * rs * g.z + bb.z, (v[i].w - mu) * rs * g.w + bb.w));
        *reinterpret_cast<uint2*>(mn + (size_t)r * 1024 + c) = o;
      }
    }
  }
}

namespace pg8 {
#define PG8_LAS __attribute__((address_space(3)))
typedef short s16x8 __attribute__((ext_vector_type(8)));
constexpr int BM = 256, BK = 64, HALF = 128, HTB = HALF * BK * 2, STAGE_BYTES = 8 * HTB, NXCD = 8, WGM = 8;
DI int lds_byte(int r, int c) { const int st = (r >> 4) * 2 + (c >> 5), rr = r & 15, cc = c & 31, ob = rr * 64 + cc * 2; return st * 1024 + (ob ^ (((ob >> 9) & 1) << 5)); }
DI void stage_rc(int b, int& R, int& C) { const int st = b / 1024, sb = b % 1024, swz = sb ^ (((sb >> 9) & 1) << 5); R = (st >> 1) * 16 + swz / 64; C = (st & 1) * 32 + (swz % 64) / 2; }
DI int perm32(int rho) { const int n = rho >> 4, i = rho & 15; return 8 * (i >> 2) + 4 * n + (i & 3); }
struct Unit { int pm, pn; };
struct Gemm { const u16* A; const u16* Bt; int M, N, K; };
struct StaticOrder {
  int nM, nN, nwg, G, c;
  DI void init(int M, int N, int G_, int c_) { nM = M / BM; nN = N / BM; nwg = nM * nN; G = G_; c = c_; }
  DI bool next(int i, Unit& u) const {
    const long L = (long)i * G + c; if (L >= nwg) return false;
    int wgid = (int)L; { const int q = nwg / NXCD, r = nwg % NXCD, xcd = wgid % NXCD, off = wgid / NXCD; wgid = (xcd < r ? xcd * (q + 1) : r * (q + 1) + (xcd - r) * q) + off; }
    const int nig = WGM * nN, gid = wgid / nig, fm = gid * WGM, gsz = (nM - fm) < WGM ? (nM - fm) : WGM;
    u.pm = fm + ((wgid % nig) % gsz); u.pn = (wgid % nig) / gsz; return true;
  }
};

template <class Epi>
DI void gemm_phase(int tid, PG8_LAS unsigned char* lds, const Gemm g, const StaticOrder& S, const Epi& E) {
  const int wid = __builtin_amdgcn_readfirstlane(tid >> 6), lane = tid & 63, wr = wid >> 2, wc = wid & 3, fr = lane & 15, fq = lane >> 4;
  const int K = g.K, nt = K / BK;
  unsigned voffA[2], voffB[2];
#pragma unroll
  for (int i = 0; i < 2; ++i) { int R, C; stage_rc(tid * 16 + i * 8192, R, C); const int Rb = Epi::PERM ? ((R & ~31) + perm32(R & 31)) : R;
    voffA[i] = (unsigned)(R * K + C) * 2u; voffB[i] = (unsigned)(Rb * K + C) * 2u; }
  const size_t kstep = (size_t)(BK * 2);
  const size_t hstep = (size_t)HALF * K * 2;
  const size_t tstep = 2 * hstep;
  const unsigned ldsw = (unsigned)wid * 1024u;
  const int aoff = lds_byte(wr * 64 + fr, fq * 8), boff = lds_byte(wc * 32 + fr, fq * 8);
#define PG8_SA(b, h) (((b) * 2 + (h)) * HTB)
#define PG8_SB(b, h) ((4 + (b) * 2 + (h)) * HTB)
#define PG8_STAGE(bufoff, gbase, voff) do { _Pragma("unroll") for (int _i = 0; _i < 2; ++_i) \
    __builtin_amdgcn_global_load_lds((const unsigned*)((const char*)(gbase) + (voff)[_i]), (PG8_LAS unsigned*)(lds + (bufoff) + ldsw + _i * 8192), 16, 0, 0); } while (0)
#define PG8_LDA(dst, b, h) do { _Pragma("unroll") for (int m = 0; m < 4; ++m) _Pragma("unroll") for (int k = 0; k < 2; ++k) dst[m][k] = *(const PG8_LAS s16x8*)(lds + PG8_SA(b, h) + aoff + m * 2048 + k * 1024); } while (0)
#define PG8_LDB(dst, b, h) do { _Pragma("unroll") for (int n = 0; n < 2; ++n) _Pragma("unroll") for (int k = 0; k < 2; ++k) dst[n][k] = *(const PG8_LAS s16x8*)(lds + PG8_SB(b, h) + boff + n * 2048 + k * 1024); } while (0)
#define PG8_MMA(ai, bj, At, Bt) do { __builtin_amdgcn_s_setprio(1); _Pragma("unroll") for (int m = 0; m < 4; ++m) _Pragma("unroll") for (int n = 0; n < 2; ++n) _Pragma("unroll") for (int k = 0; k < 2; ++k) \
    acc[ai][bj][m][n] = __builtin_amdgcn_mfma_f32_16x16x32_bf16(__builtin_bit_cast(bf16x8, Bt[n][k]), __builtin_bit_cast(bf16x8, At[m][k]), acc[ai][bj][m][n], 0, 0, 0); __builtin_amdgcn_s_setprio(0); } while (0)
#define PG8_WAIT_V(n) asm volatile("s_waitcnt vmcnt(" #n ")" ::: "memory")
#define PG8_WAIT_L(n) asm volatile("s_waitcnt lgkmcnt(" #n ")" ::: "memory")
#define PG8_BAR __builtin_amdgcn_s_barrier()
#define PG8_SCHED __builtin_amdgcn_sched_barrier(0)
  Unit cur, nxt; int ui = 0;
  if (!S.next(0, cur)) return;
  f32x4 acc[2][2][4][2];
#pragma unroll
  for (int a = 0; a < 2; ++a)
#pragma unroll
    for (int b = 0; b < 2; ++b)
#pragma unroll
      for (int m = 0; m < 4; ++m)
#pragma unroll
        for (int n = 0; n < 2; ++n) acc[a][b][m][n] = (f32x4){0.f, 0.f, 0.f, 0.f};
  s16x8 At[4][2], B0[2][2], B1[2][2];
  const char* cA = (const char*)g.A + (size_t)cur.pm * tstep; const char* cB = (const char*)g.Bt + (size_t)cur.pn * tstep;
  PG8_STAGE(PG8_SB(0, 0), cB, voffB); PG8_STAGE(PG8_SA(0, 0), cA, voffA); PG8_STAGE(PG8_SB(0, 1), cB + hstep, voffB); PG8_STAGE(PG8_SA(0, 1), cA + hstep, voffA);
  if (wr == 1) PG8_BAR;
  PG8_WAIT_V(4); PG8_BAR;
  PG8_STAGE(PG8_SB(1, 0), cB + kstep, voffB); PG8_STAGE(PG8_SA(1, 0), cA + kstep, voffA); PG8_STAGE(PG8_SB(1, 1), cB + hstep + kstep, voffB);
  PG8_WAIT_V(6); PG8_BAR;
  for (;;) {
    const bool has_next = S.next(ui + 1, nxt);
    const char* nA = has_next ? (const char*)g.A + (size_t)nxt.pm * tstep : cA; const char* nB = has_next ? (const char*)g.Bt + (size_t)nxt.pn * tstep : cB;
    for (int t = 0; t < nt; t += 2) {
      const bool last = (t == nt - 2);
      const char* a1 = cA + (size_t)(t + 1) * kstep;
      const char* a2 = last ? nA : cA + (size_t)(t + 2) * kstep; const char* b2 = last ? nB : cB + (size_t)(t + 2) * kstep;
      const char* a3 = a2 + kstep; const char* b3 = b2 + kstep;
      PG8_LDB(B0, 0, 0); PG8_SCHED; PG8_LDA(At, 0, 0); PG8_STAGE(PG8_SA(1, 1), a1 + hstep, voffA);
      PG8_WAIT_L(8); PG8_BAR; PG8_WAIT_L(0); PG8_MMA(0, 0, At, B0); PG8_BAR; PG8_SCHED;
      PG8_LDB(B1, 0, 1); PG8_STAGE(PG8_SB(0, 0), b2, voffB);
      PG8_BAR; PG8_WAIT_L(0); PG8_MMA(0, 1, At, B1); PG8_BAR;
      PG8_LDA(At, 0, 1); PG8_STAGE(PG8_SA(0, 0), a2, voffA);
      PG8_BAR; PG8_WAIT_L(0); PG8_MMA(1, 0, At, B0); PG8_BAR; PG8_SCHED;
      PG8_STAGE(PG8_SB(0, 1), b2 + hstep, voffB);
      PG8_WAIT_V(6); PG8_BAR; PG8_MMA(1, 1, At, B1); PG8_BAR;
      PG8_LDB(B0, 1, 0); PG8_SCHED; PG8_LDA(At, 1, 0); PG8_STAGE(PG8_SA(0, 1), a2 + hstep, voffA);
      PG8_WAIT_L(8); PG8_BAR; PG8_WAIT_L(0); PG8_MMA(0, 0, At, B0); PG8_BAR; PG8_SCHED;
      PG8_LDB(B1, 1, 1); PG8_STAGE(PG8_SB(1, 0), b3, voffB);
      PG8_BAR; PG8_WAIT_L(0); PG8_MMA(0, 1, At, B1); PG8_BAR;
      PG8_LDA(At, 1, 1); PG8_STAGE(PG8_SA(1, 0), a3, voffA);
      PG8_BAR; PG8_WAIT_L(0); PG8_MMA(1, 0, At, B0); PG8_BAR; PG8_SCHED;
      PG8_STAGE(PG8_SB(1, 1), b3 + hstep, voffB);
      PG8_WAIT_V(6); PG8_BAR; PG8_MMA(1, 1, At, B1); PG8_BAR;
    }
    E(acc, cur, wr, wc, fr, fq);
    if (!has_next) break;
#pragma unroll
    for (int a = 0; a < 2; ++a)
#pragma unroll
      for (int b = 0; b < 2; ++b)
#pragma unroll
        for (int m = 0; m < 4; ++m)
#pragma unroll
          for (int n = 0; n < 2; ++n) acc[a][b][m][n] = (f32x4){0.f, 0.f, 0.f, 0.f};
    cur = nxt; cA = nA; cB = nB; ++ui;
  }
  PG8_WAIT_V(0);
  if (wr == 0) PG8_BAR;
  PG8_BAR;
#undef PG8_SA
#undef PG8_SB
#undef PG8_STAGE
#undef PG8_LDA
#undef PG8_LDB
#undef PG8_MMA
#undef PG8_WAIT_V
#undef PG8_WAIT_L
#undef PG8_BAR
#undef PG8_SCHED
}
}

DI uint4 pack8(const f32x4& a, const f32x4& b) { return make_uint4(pk2(a[0], a[1]), pk2(a[2], a[3]), pk2(b[0], b[1]), pk2(b[2], b[3])); }

struct EpiInProj {
  static constexpr bool PERM = true;
  char* ws; int kind;
  DI void operator()(const f32x4 (&acc)[2][2][4][2], const pg8::Unit& u, int wr, int wc, int fr, int fq) const {
    char* big = ws + OFF_BIG;
    const float* cs = reinterpret_cast<const float*>(ws + OFF_COS);
    const float* sn = reinterpret_cast<const float*>(ws + OFF_SIN);
#pragma unroll
    for (int bj = 0; bj < 2; ++bj) {
      const int c32 = u.pn * 256 + bj * 128 + wc * 32;
      const int dd = (c32 & 63) + 8 * fq;
      if (c32 < 2304) {
        int sel, h;
        if (c32 < 768) { sel = 0; h = c32 >> 6; }
        else if (c32 < 1536) { sel = 1; h = (c32 - 768) >> 6; }
        else if (c32 < 1792) { sel = 2; h = (c32 - 1536) >> 6; }
        else { sel = 3; h = (c32 - 1792) >> 6; }
        const bool rope = sel != 2 && (c32 & 63) == 0 && fq < 2;
        f32x4 rc[2][4], rsn[2][4];
        if (rope) {
#pragma unroll
          for (int ai = 0; ai < 2; ++ai)
#pragma unroll
            for (int m = 0; m < 4; ++m) {
              const int row = u.pm * 256 + ai * 128 + wr * 64 + m * 16 + fr;
              rc[ai][m] = ldg4(cs + row * 8 + 4 * fq); rsn[ai][m] = ldg4(sn + row * 8 + 4 * fq);
            }
        }
#pragma unroll
        for (int ai = 0; ai < 2; ++ai)
#pragma unroll
          for (int m = 0; m < 4; ++m) {
            const int row = u.pm * 256 + ai * 128 + wr * 64 + m * 16 + fr;
            f32x4 a = acc[ai][bj][m][0], b = acc[ai][bj][m][1];
            if (rope) {
              const f32x4 na = a * rc[ai][m] - b * rsn[ai][m], nb = b * rc[ai][m] + a * rsn[ai][m];
              a = na; b = nb;
            }
            const int bb = row >> 12, s_ = row & 4095;
            size_t off;
            if (sel == 0) off = BO_Q + (((size_t)(bb * 12 + h) * S + s_) * 64 + dd) * 2;
            else if (sel == 1) off = BO_K + (((size_t)(bb * 12 + h) * S + s_) * 64 + dd) * 2;
            else if (sel == 2) off = (kind == 1 ? BO_QM_B : BO_QM_AC) + (((size_t)(bb * 4 + h) * S + s_) * 64 + dd) * 2;
            else off = BO_QI + (((size_t)row * 8 + h) * 64 + dd) * 2;
            stg16(big + off, pack8(a, b));
          }
      } else if (c32 < 2368) {
#pragma unroll
        for (int ai = 0; ai < 2; ++ai)
#pragma unroll
          for (int m = 0; m < 4; ++m) {
            const int row = u.pm * 256 + ai * 128 + wr * 64 + m * 16 + fr;
            float* dst = reinterpret_cast<float*>(big + BO_KIRAW) + (size_t)row * 64 + (c32 - 2304) + 8 * fq;
            stg16f(dst, acc[ai][bj][m][0]);
            stg16f(dst + 4, acc[ai][bj][m][1]);
          }
      } else if (c32 < 2400) {
        if (fq == 0) {
#pragma unroll
          for (int ai = 0; ai < 2; ++ai)
#pragma unroll
            for (int m = 0; m < 4; ++m) {
              const int row = u.pm * 256 + ai * 128 + wr * 64 + m * 16 + fr;
              float* dst = reinterpret_cast<float*>(big + BO_WI) + (size_t)row * 8;
              stg16f(dst, acc[ai][bj][m][0] * 0.04419417382415922f);
              stg16f(dst + 4, acc[ai][bj][m][1] * 0.04419417382415922f);
            }
        }
      }
    }
  }
};

struct EpiVt {
  static constexpr bool PERM = true;
  char* ws; int kind;
  DI void operator()(const f32x4 (&acc)[2][2][4][2], const pg8::Unit& u, int wr, int wc, int fr, int fq) const {
    char* big = ws + OFF_BIG;
#pragma unroll
    for (int ai = 0; ai < 2; ++ai)
#pragma unroll
      for (int m = 0; m < 4; ++m) {
        const int cv = u.pm * 256 + ai * 128 + wr * 64 + m * 16 + fr;
#pragma unroll
        for (int bj = 0; bj < 2; ++bj) {
          const int tok0 = u.pn * 256 + bj * 128 + wc * 32 + 8 * fq;
          const int bb = tok0 >> 12, s0 = tok0 & 4095;
          const f32x4 a = acc[ai][bj][m][0], b = acc[ai][bj][m][1];
          if (kind != 1) {
            const int h = cv >> 6, d = cv & 63;
            u16* vt = reinterpret_cast<u16*>(big + BO_V) + ((size_t)(bb * 12 + h) * 128 + (s0 >> 5)) * 2048 + d * 32 + (s0 & 31);
            stg16(vt, pack8(a, b));
          } else {
            const int hh = cv / 192, dv = cv % 192;
            u16* v0 = reinterpret_cast<u16*>(big + BO_V) + ((size_t)(bb * 4 + hh) * 128 + (s0 >> 5)) * 6144 + dv * 32 + (s0 & 31);
            stg16(v0, pack8(a, b));
            const int j4 = s0 >> 2, j16 = s0 >> 4, r0 = s0 & 15;
            u16* v1 = reinterpret_cast<u16*>(big + BO_V + SZ_QKV) + (((size_t)(bb * 4 + hh) * 4) * 32 + (j4 >> 5)) * 6144 + dv * 32 + (j4 & 31);
            u16* v2 = reinterpret_cast<u16*>(big + BO_V + 2 * SZ_QKV) + (((size_t)(bb * 4 + hh) * 16 + r0) * 8 + (j16 >> 5)) * 6144 + dv * 32 + (j16 & 31);
#pragma unroll
            for (int r = 0; r < 4; ++r) stg4(v1 + (size_t)r * 32 * 6144, pk2(a[r], b[r]));
#pragma unroll
            for (int i = 0; i < 4; ++i) { stg2(v2 + (size_t)i * 8 * 6144, f2bf(a[i])); stg2(v2 + (size_t)(i + 4) * 8 * 6144, f2bf(b[i])); }
          }
        }
      }
  }
};

struct EpiMemKV {
  static constexpr bool PERM = true;
  char* ws;
  DI void operator()(const f32x4 (&acc)[2][2][4][2], const pg8::Unit& u, int wr, int wc, int fr, int fq) const {
#pragma unroll
    for (int bj = 0; bj < 2; ++bj) {
      const int c32 = u.pn * 256 + bj * 128 + wc * 32;
      const int layer = c32 >> 9, c = c32 & 511;
      const int h = (c & 255) >> 6, dd = (c & 63) + 8 * fq;
      u16* mk = reinterpret_cast<u16*>(ws + OFF_MK + layer * SZ_MK);
      u16* mvt = reinterpret_cast<u16*>(ws + OFF_MVT + layer * SZ_MK);
#pragma unroll
      for (int ai = 0; ai < 2; ++ai)
#pragma unroll
        for (int m = 0; m < 4; ++m) {
          const int row = u.pm * 256 + ai * 128 + wr * 64 + m * 16 + fr;
          const int bb = row >> 8, n = row & 255;
          const f32x4 a = acc[ai][bj][m][0], b = acc[ai][bj][m][1];
          if (c < 256) {
            stg16(mk + ((size_t)(bb * 4 + h) * 256 + n) * 64 + dd, pack8(a, b));
          } else {
            u16* vt = mvt + ((size_t)(bb * 4 + h) * 8 + (n >> 5)) * 2048 + dd * 32 + (n & 31);
#pragma unroll
            for (int i = 0; i < 4; ++i) { stg2(vt + i * 32, f2bf(a[i])); stg2(vt + (i + 4) * 32, f2bf(b[i])); }
          }
        }
    }
  }
};

struct EpiResid {
  static constexpr bool PERM = false;
  const float* xsrc; float* out; const float2* stat; const float* g; const float* b;
  DI void operator()(const f32x4 (&acc)[2][2][4][2], const pg8::Unit& u, int wr, int wc, int fr, int fq) const {
    const int col0 = u.pn * 256 + wc * 32 + 4 * fq;
    f32x4 gg[2][2], bb[2][2];
    if (stat) {
#pragma unroll
      for (int bj = 0; bj < 2; ++bj)
#pragma unroll
        for (int n = 0; n < 2; ++n) { gg[bj][n] = ldg4(g + col0 + bj * 128 + n * 16); bb[bj][n] = ldg4(b + col0 + bj * 128 + n * 16); }
    }
#pragma unroll
    for (int h4 = 0; h4 < 4; ++h4) {
      const int ai = h4 >> 1, m0 = (h4 & 1) * 2;
      f32x4 xv[2][2][2]; float2 st[2];
#pragma unroll
      for (int mm = 0; mm < 2; ++mm) {
        const int row = u.pm * 256 + ai * 128 + wr * 64 + (m0 + mm) * 16 + fr;
        st[mm] = stat ? ldg2(stat + row) : make_float2(0.f, 1.f);
#pragma unroll
        for (int bj = 0; bj < 2; ++bj)
#pragma unroll
          for (int n = 0; n < 2; ++n) xv[mm][bj][n] = ldg4(xsrc + (size_t)row * 1024 + col0 + bj * 128 + n * 16);
      }
#pragma unroll
      for (int mm = 0; mm < 2; ++mm) {
        const int row = u.pm * 256 + ai * 128 + wr * 64 + (m0 + mm) * 16 + fr;
#pragma unroll
        for (int bj = 0; bj < 2; ++bj)
#pragma unroll
          for (int n = 0; n < 2; ++n) {
            f32x4 x = xv[mm][bj][n];
            if (stat) x = (x - st[mm].x) * st[mm].y * gg[bj][n] + bb[bj][n];
            stg16f(out + (size_t)row * 1024 + col0 + bj * 128 + n * 16, x * ALPHA + acc[ai][bj][m0 + mm][n]);
          }
      }
    }
  }
};

struct EpiSwiGLU {
  static constexpr bool PERM = true;
  u16* h;
  DI void operator()(const f32x4 (&acc)[2][2][4][2], const pg8::Unit& u, int wr, int wc, int fr, int fq) const {
    const int j0 = u.pn * 128 + wc * 32 + 8 * fq;
#pragma unroll
    for (int ai = 0; ai < 2; ++ai)
#pragma unroll
      for (int m = 0; m < 4; ++m) {
        const int row = u.pm * 256 + ai * 128 + wr * 64 + m * 16 + fr;
        f32x4 o[2];
#pragma unroll
        for (int n = 0; n < 2; ++n)
#pragma unroll
          for (int i = 0; i < 4; ++i) { const float g = acc[ai][0][m][n][i], uu = acc[ai][1][m][n][i]; o[n][i] = g * __builtin_amdgcn_rcpf(1.f + __expf(-g)) * uu; }
        stg16(h + (size_t)row * DFF + j0, pack8(o[0], o[1]));
      }
  }
};

DI void ln_phase(const Ctx& cx, float* xio, const float* __restrict__ g, const float* __restrict__ b, u16* xb, float2* stat, bool write_f32) {
  const int lane = cx.tid & 63, gw = cx.bid * WPB + __builtin_amdgcn_readfirstlane(cx.tid >> 6), nw = cx.nb * WPB;
  float4 gg[4], bb[4];
  for (int i = 0; i < 4; ++i) { gg[i] = *reinterpret_cast<const float4*>(g + (i * 64 + lane) * 4); bb[i] = *reinterpret_cast<const float4*>(b + (i * 64 + lane) * 4); }
  constexpr int RB = 4;
  for (int r0 = gw * RB; r0 < T; r0 += nw * RB) {
    float4 v[RB][4]; float s[RB], q[RB];
#pragma unroll
    for (int k = 0; k < RB; ++k) {
      const float4* row = reinterpret_cast<const float4*>(xio + (size_t)(r0 + k) * 1024);
      s[k] = 0.f;
#pragma unroll
      for (int i = 0; i < 4; ++i) { v[k][i] = row[i * 64 + lane]; s[k] += v[k][i].x + v[k][i].y + v[k][i].z + v[k][i].w; }
    }
#pragma unroll
    for (int k = 0; k < RB; ++k) s[k] = wave_sum(s[k]) * (1.f / 1024.f);
#pragma unroll
    for (int k = 0; k < RB; ++k) {
      q[k] = 0.f;
#pragma unroll
      for (int i = 0; i < 4; ++i) { float a = v[k][i].x - s[k], b2 = v[k][i].y - s[k], c = v[k][i].z - s[k], d = v[k][i].w - s[k]; q[k] += a * a + b2 * b2 + c * c + d * d; }
    }
#pragma unroll
    for (int k = 0; k < RB; ++k) q[k] = rsqrtf(wave_sum(q[k]) * (1.f / 1024.f) + LN_EPS);
    if (lane < RB) { float2 sv; sv.x = lane == 0 ? s[0] : lane == 1 ? s[1] : lane == 2 ? s[2] : s[3]; sv.y = lane == 0 ? q[0] : lane == 1 ? q[1] : lane == 2 ? q[2] : q[3]; stat[r0 + lane] = sv; }
#pragma unroll
    for (int k = 0; k < RB; ++k) {
      float4* row = reinterpret_cast<float4*>(xio + (size_t)(r0 + k) * 1024);
#pragma unroll
      for (int i = 0; i < 4; ++i) {
        float4 o;
        o.x = (v[k][i].x - s[k]) * q[k] * gg[i].x + bb[i].x; o.y = (v[k][i].y - s[k]) * q[k] * gg[i].y + bb[i].y;
        o.z = (v[k][i].z - s[k]) * q[k] * gg[i].z + bb[i].z; o.w = (v[k][i].w - s[k]) * q[k] * gg[i].w + bb[i].w;
        if (write_f32) row[i * 64 + lane] = o;
        *reinterpret_cast<uint2*>(xb + (size_t)(r0 + k) * 1024 + (i * 64 + lane) * 4) = make_uint2(pk2(o.x, o.y), pk2(o.z, o.w));
      }
    }
  }
}

template <int NDT> struct AttState { f32x16 o[NDT]; float m, l; };
template <int NDT> DI void att_init(AttState<NDT>& st) {
#pragma unroll
  for (int d = 0; d < NDT; ++d)
#pragma unroll
    for (int r = 0; r < 16; ++r) st.o[d][r] = 0.f;
  st.m = -1e30f; st.l = 0.f;
}
DI int pi_swap(int i) { return (i & 0x13) | ((i & 4) << 1) | ((i & 8) >> 1); }

template <int NDT> struct Frags { bf16x8 k[4]; bf16x8 v[NDT == 2 ? 4 : 1]; unsigned w; };
template <int NDT> DI void att_load(Frags<NDT>& f, const u16* krow, const u16* vt) {
#pragma unroll
  for (int c = 0; c < 4; ++c) f.k[c] = ld8(krow + c * 16);
  if (NDT == 2) {
#pragma unroll
    for (int d = 0; d < 2; ++d)
#pragma unroll
      for (int c = 0; c < 2; ++c) f.v[d * 2 + c] = ld8(vt + d * 1024 + c * 16);
  }
}
template <int NDT, class MaskP>
DI void att_compute(AttState<NDT>& st, const bf16x8 (&qf)[4], const Frags<NDT>& f, const u16* vt, const MaskP& maskp) {
  constexpr float CS = 0.18033688011112042f;
  f32x16 s;
#pragma unroll
  for (int r = 0; r < 16; ++r) s[r] = 0.f;
#pragma unroll
  for (int c = 0; c < 4; ++c) s = mfma32(f.k[c], qf[c], s);
  float mx = fmaxf(fmaxf(s[0], s[1]), s[2]);
#pragma unroll
  for (int r = 3; r < 15; r += 2) mx = fmaxf(fmaxf(mx, s[r]), s[r + 1]);
  mx = fmaxf(mx, s[15]);
  mx = red32_max(mx);
  constexpr float DEFER = 8.0f / CS;
  const bool upd = mx > st.m + DEFER;
  if (__any(upd)) {
    const float mnew = upd ? mx : st.m;
    const float alpha = __builtin_amdgcn_exp2f((st.m - mnew) * CS);
    st.l *= alpha; st.m = mnew;
#pragma unroll
    for (int d = 0; d < NDT; ++d)
#pragma unroll
      for (int r = 0; r < 16; ++r) st.o[d][r] *= alpha;
  }
  const float nb = -st.m * CS;
  float ps = 0.f;
#pragma unroll
  for (int r = 0; r < 16; ++r) { s[r] = maskp(r, __builtin_amdgcn_exp2f(fmaf(s[r], CS, nb))); ps += s[r]; }
  st.l += ps;
  bf16x8 pf[2];
#pragma unroll
  for (int c = 0; c < 2; ++c) {
    u32x4 t;
#pragma unroll
    for (int j = 0; j < 4; ++j) t[j] = pk2(s[8 * c + 2 * j], s[8 * c + 2 * j + 1]);
    pf[c] = __builtin_bit_cast(bf16x8, t);
  }
  if (NDT == 2) {
#pragma unroll
    for (int d = 0; d < 2; ++d)
#pragma unroll
      for (int c = 0; c < 2; ++c) st.o[d] = mfma32(f.v[d * 2 + c], pf[c], st.o[d]);
  } else {
#pragma unroll
    for (int hb = 0; hb < 2; ++hb) {
      bf16x8 va[6];
#pragma unroll
      for (int i = 0; i < 6; ++i) va[i] = ld8(vt + (hb * 3 + (i >> 1)) * 1024 + (i & 1) * 16);
      asm volatile("" : "+v"(va[0]), "+v"(va[1]), "+v"(va[2]), "+v"(va[3]), "+v"(va[4]), "+v"(va[5]));
#pragma unroll
      for (int i = 0; i < 6; ++i) st.o[hb * 3 + (i >> 1)] = mfma32(va[i], pf[i & 1], st.o[hb * 3 + (i >> 1)]);
    }
  }
}
DI float mask_bit(unsigned w, int bit, float p) { int m; asm("v_bfe_i32 %0, %1, %2, 1" : "=v"(m) : "v"(w), "n"(bit)); return __uint_as_float(__float_as_uint(p) & (unsigned)m); }
template <int NDT, class KP, class VP, class WP, class MK>
DI void att_range(AttState<NDT>& st, const bf16x8 (&qf)[4], int k0, int k1, const KP& kp, const VP& vp, const WP& wp, const MK& mk) {
  if (NDT == 2) {
    Frags<NDT> f0, f1, f2;
    att_load<NDT>(f0, kp(k0), vp(k0)); f0.w = wp(k0);
    f1 = f0; f2 = f0;
    if (k0 + 1 <= k1) { att_load<NDT>(f1, kp(k0 + 1), vp(k0 + 1)); f1.w = wp(k0 + 1); }
#pragma unroll 1
    for (int kt = k0; kt <= k1; kt += 3) {
      if (kt + 2 <= k1) { att_load<NDT>(f2, kp(kt + 2), vp(kt + 2)); f2.w = wp(kt + 2); }
      att_compute<NDT>(st, qf, f0, vp(kt), mk(kt, f0.w));
      if (kt + 1 > k1) break;
      if (kt + 3 <= k1) { att_load<NDT>(f0, kp(kt + 3), vp(kt + 3)); f0.w = wp(kt + 3); }
      att_compute<NDT>(st, qf, f1, vp(kt + 1), mk(kt + 1, f1.w));
      if (kt + 2 > k1) break;
      if (kt + 4 <= k1) { att_load<NDT>(f1, kp(kt + 4), vp(kt + 4)); f1.w = wp(kt + 4); }
      att_compute<NDT>(st, qf, f2, vp(kt + 2), mk(kt + 2, f2.w));
    }
  } else {
#pragma unroll 1
    for (int kt = k0; kt <= k1; ++kt) {
      Frags<NDT> cur;
      att_load<NDT>(cur, kp(kt), vp(kt)); cur.w = wp(kt);
      asm volatile("" : "+v"(cur.k[0]), "+v"(cur.k[1]), "+v"(cur.k[2]), "+v"(cur.k[3]));
      att_compute<NDT>(st, qf, cur, vp(kt), mk(kt, cur.w));
    }
  }
}

template <int NDT> DI void att_store(AttState<NDT>& st, u16* orow, int hf) {
  const float lt = red32_sum(st.l);
  const float inv = 1.f / lt;
#pragma unroll
  for (int d = 0; d < NDT; ++d)
#pragma unroll
    for (int g = 0; g < 4; ++g) {
      uint2 v = make_uint2(pk2(st.o[d][4 * g] * inv, st.o[d][4 * g + 1] * inv), pk2(st.o[d][4 * g + 2] * inv, st.o[d][4 * g + 3] * inv));
      *reinterpret_cast<uint2*>(orow + d * 32 + 8 * g + 4 * hf) = v;
    }
}

DI void load_q(bf16x8 (&qf)[4], const u16* qrow, int hf) {
#pragma unroll
  for (int c = 0; c < 4; ++c) qf[c] = ld8(qrow + c * 16 + 8 * hf);
}

DI void mem_att_unit(char* ws, int layer, int kind, int u, int lane) {
  const int qt = u & 127, bh = u >> 7, b = bh >> 2, hm = bh & 3;
  const int ql = lane & 31, hf = lane >> 5, tq = qt * 32 + ql;
  const u16* QM = reinterpret_cast<const u16*>(ws + OFF_BIG + (kind == 1 ? BO_QM_B : BO_QM_AC));
  const u16* MK = reinterpret_cast<const u16*>(ws + OFF_MK + layer * SZ_MK);
  const u16* MVT = reinterpret_cast<const u16*>(ws + OFF_MVT + layer * SZ_MK);
  bf16x8 qf[4]; load_q(qf, QM + ((size_t)bh * S + tq) * 64, hf);
  AttState<2> st; att_init(st);
  const int pk = pi_swap(ql);
  const u16* kb = MK + ((size_t)bh * 256 + pk) * 64 + 8 * hf;
  const u16* vb = MVT + ((size_t)bh * 8) * 2048 + ql * 32 + 8 * hf;
  int klast = 7; asm volatile("" : "+s"(klast));
  att_range<2>(st, qf, 0, klast,
               [kb](int kt) { return kb + kt * 2048; }, [vb](int kt) { return vb + kt * 2048; },
               [](int) { return 0u; }, [](int, unsigned) { return [](int, float p) { return p; }; });
  u16* mix = reinterpret_cast<u16*>(ws + OFF_MIX);
  att_store<2>(st, mix + (size_t)(b * S + tq) * 1024 + 768 + hm * 64, hf);
}

DI void dsa_att_unit(char* ws, int bh, int qt, int lane) {
  const int b = bh / 12, h = bh % 12;
  const int ql = lane & 31, hf = lane >> 5, tq = qt * 32 + ql;
  char* big = ws + OFF_BIG;
  const u16* Q = reinterpret_cast<const u16*>(big + BO_Q);
  const u16* K = reinterpret_cast<const u16*>(big + BO_K);
  const u16* VT = reinterpret_cast<const u16*>(big + BO_V);
  const unsigned* BM = reinterpret_cast<const unsigned*>(big + BO_BM) + (size_t)(b * S + tq) * 128;
  bf16x8 qf[4]; load_q(qf, Q + ((size_t)bh * S + tq) * 64, hf);
  AttState<2> st; att_init(st);
  const int pk = pi_swap(ql);
  const u16* kb = K + ((size_t)bh * S + pk) * 64 + 8 * hf;
  const u16* vb = VT + ((size_t)bh * 128) * 2048 + ql * 32 + 8 * hf;
  const int sh = 8 * hf;
  att_range<2>(st, qf, 0, qt,
               [kb](int kt) { return kb + kt * 2048; }, [vb](int kt) { return vb + kt * 2048; },
               [BM](int kt) { return ldg32(BM + kt); },
               [sh](int, unsigned w) { const unsigned ws_ = w >> sh; return [ws_](int r, float p) { return mask_bit(ws_, 16 * (r >> 3) + (r & 7), p); }; });
  u16* mix = reinterpret_cast<u16*>(ws + OFF_MIX);
  att_store<2>(st, mix + (size_t)(b * S + tq) * 1024 + h * 64, hf);
}

DI void moba_att_unit(char* ws, int bh, int qt, int lane) {
  const int b = bh / 12, h = bh % 12;
  const int ql = lane & 31, hf = lane >> 5, tq = qt * 32 + ql;
  char* big = ws + OFF_BIG;
  const u16* Q = reinterpret_cast<const u16*>(big + BO_Q);
  const u16* K = reinterpret_cast<const u16*>(big + BO_K);
  const u16* VT = reinterpret_cast<const u16*>(big + BO_V);
  const float* KM = reinterpret_cast<const float*>(ws + OFF_KMEAN) + (size_t)bh * 16 * 64;
  const u16* qrow = Q + ((size_t)bh * S + tq) * 64;
  bf16x8 qf[4]; load_q(qf, qrow, hf);
  const int own = qt >> 3;
  unsigned selmask = 0u;
  {
    float b0 = -3e38f, b1 = -3e38f, b2 = -3e38f; int i0 = -1, i1 = -1, i2 = -1;
    for (int n = 0; n < own; ++n) {
      float g = 0.f;
      for (int d8 = 0; d8 < 8; ++d8) {
        const u32x4 qq = *reinterpret_cast<const u32x4*>(qrow + d8 * 8);
        const float4 ka = *reinterpret_cast<const float4*>(KM + n * 64 + d8 * 8);
        const float4 kb = *reinterpret_cast<const float4*>(KM + n * 64 + d8 * 8 + 4);
        g += __uint_as_float(qq[0] << 16) * ka.x + __uint_as_float(qq[0] & 0xffff0000u) * ka.y
           + __uint_as_float(qq[1] << 16) * ka.z + __uint_as_float(qq[1] & 0xffff0000u) * ka.w
           + __uint_as_float(qq[2] << 16) * kb.x + __uint_as_float(qq[2] & 0xffff0000u) * kb.y
           + __uint_as_float(qq[3] << 16) * kb.z + __uint_as_float(qq[3] & 0xffff0000u) * kb.w;
      }
      if (g > b0) { b2 = b1; i2 = i1; b1 = b0; i1 = i0; b0 = g; i0 = n; }
      else if (g > b1) { b2 = b1; i2 = i1; b1 = g; i1 = n; }
      else if (g > b2) { b2 = g; i2 = n; }
    }
    if (i0 >= 0) selmask |= 1u << i0;
    if (i1 >= 0) selmask |= 1u << i1;
    if (i2 >= 0) selmask |= 1u << i2;
  }
  AttState<2> st; att_init(st);
  const int pk = pi_swap(ql);
  const u16* kb = K + ((size_t)bh * S + pk) * 64 + 8 * hf;
  const u16* vb = VT + ((size_t)bh * 128) * 2048 + ql * 32 + 8 * hf;
  for (int n = 0; n < own; ++n) {
    const unsigned minew = ((selmask >> n) & 1u) ? 0xffffffffu : 0u;
    if (!__any(minew != 0u)) continue;
    att_range<2>(st, qf, n * 8, n * 8 + 7,
                 [kb](int kt) { return kb + kt * 2048; }, [vb](int kt) { return vb + kt * 2048; },
                 [minew](int) { return minew; }, [](int, unsigned w) { return [w](int, float p) { return w != 0u ? p : 0.f; }; });
  }
  att_range<2>(st, qf, own * 8, qt,
               [kb](int kt) { return kb + kt * 2048; }, [vb](int kt) { return vb + kt * 2048; },
               [](int) { return 0u; },
               [hf, tq](int kt, unsigned) { const int dq = tq - (kt * 32 + 8 * hf); return [dq](int r, float p) { return 16 * (r >> 3) + (r & 7) <= dq ? p : 0.f; }; });
  u16* mix = reinterpret_cast<u16*>(ws + OFF_MIX);
  att_store<2>(st, mix + (size_t)(b * S + tq) * 1024 + h * 64, hf);
}

template <bool DSA>
DI void blk_att_unit(char* ws, char* smem, int wid, int lane, int bh, int Qb) {
  typedef __attribute__((address_space(3))) unsigned char* lds_p;
  typedef __attribute__((address_space(3))) unsigned* lds_u32p;
  constexpr int D = 6, R = 8, SLOT = 10240;
  lds_p lds = (lds_p)smem;
  const int b = bh / 12, h = bh % 12;
  const int ql = lane & 31, hf = lane >> 5, qt = Qb * 8 + wid, tq = qt * 32 + ql, nkt = Qb * 8 + 8;
  char* big = ws + OFF_BIG;
  const u16* Q = reinterpret_cast<const u16*>(big + BO_Q);
  const u16* K = reinterpret_cast<const u16*>(big + BO_K);
  const u16* VT = reinterpret_cast<const u16*>(big + BO_V);
  const u16* qrow = Q + ((size_t)bh * S + tq) * 64;
  bf16x8 qf[4]; load_q(qf, qrow, hf);
  unsigned selmask = 0u;
  if (!DSA) {
    const u16* KMB = reinterpret_cast<const u16*>(ws + OFF_KMEANB) + (size_t)bh * 16 * 64 + 8 * hf;
    f32x16 ga, gb;
#pragma unroll
    for (int r = 0; r < 16; ++r) { ga[r] = 0.f; gb[r] = 0.f; }
#pragma unroll
    for (int c = 0; c < 4; ++c) {
      ga = mfma32(ld8(KMB + (ql & 15) * 64 + c * 16), qf[c], ga);
      gb = mfma32(ld8(KMB + ((ql & 15) ^ 4) * 64 + c * 16), qf[c], gb);
    }
    float b0 = -3e38f, b1 = -3e38f, b2 = -3e38f; int i0 = -1, i1 = -1, i2 = -1;
#pragma unroll
    for (int r = 0; r < 8; ++r) {
#pragma unroll
      for (int t = 0; t < 2; ++t) {
        const int n = ((r & 3) + 8 * (r >> 2) + 4 * hf) ^ (4 * t);
        const float g = (n < Qb) ? (t == 0 ? ga[r] : gb[r]) : -3e38f;
        const bool c0 = g > b0, c1 = g > b1, c2 = g > b2;
        const float nb2 = c1 ? b1 : (c2 ? g : b2); const int ni2 = c1 ? i1 : (c2 ? n : i2);
        const float nb1 = c0 ? b0 : (c1 ? g : b1); const int ni1 = c0 ? i0 : (c1 ? n : i1);
        const float nb0 = c0 ? g : b0;             const int ni0 = c0 ? n : i0;
        b0 = nb0; b1 = nb1; b2 = nb2; i0 = ni0; i1 = ni1; i2 = ni2;
      }
    }
    if (b0 > -1e38f) selmask |= 1u << i0;
    if (b1 > -1e38f) selmask |= 1u << i1;
    if (b2 > -1e38f) selmask |= 1u << i2;
  }
  const char* src;
  {
    const int p = (wid & 3) * 64 + lane;
    if (wid < 4) { const int r = p >> 3, lc = (p & 7) ^ ((r >> 1) & 7); src = reinterpret_cast<const char*>(K + ((size_t)bh * S + r) * 64 + lc * 8); }
    else { const int d = p >> 2, lc = (p & 3) ^ ((d >> 2) & 3); src = reinterpret_cast<const char*>(VT + (size_t)bh * 128 * 2048 + d * 32 + lc * 8); }
  }
  const char* msrc = big + BO_BM + ((size_t)(b * S + Qb * 256 + ((wid & 3) * 64 + lane)) * 128) * 4;
  const unsigned ldsw = (unsigned)wid * 1024u, ldsm = 8192u + (unsigned)wid * 256u;
#define BA_ISSUE(kt_) do { const unsigned _sb = (unsigned)(((kt_) & (R - 1)) * SLOT); \
    __builtin_amdgcn_global_load_lds((const unsigned*)(src + (size_t)(kt_) * 4096), (lds_u32p)(lds + _sb + ldsw), 16, 0, 0); \
    if (DSA) __builtin_amdgcn_global_load_lds((const unsigned*)(msrc + (size_t)(kt_) * 4), (lds_u32p)(lds + _sb + ldsm), 4, 0, 0); } while (0)
#define BA_WAIT(n) asm volatile("s_waitcnt vmcnt(" #n ")" ::: "memory")
  int koff[4], voff[4];
  {
    const int kr = pi_swap(ql);
#pragma unroll
    for (int c = 0; c < 4; ++c) koff[c] = kr * 128 + (((2 * c + hf) ^ ((kr >> 1) & 7)) << 4);
#pragma unroll
    for (int dt = 0; dt < 2; ++dt)
#pragma unroll
      for (int c = 0; c < 2; ++c) { const int d = dt * 32 + ql; voff[dt * 2 + c] = 4096 + d * 64 + (((2 * c + hf) ^ ((d >> 2) & 3)) << 4); }
  }
  const int moff = 8192 + (wid * 32 + ql) * 4;
  AttState<2> st; att_init(st);
  asm volatile("" :: "v"(qf[0]), "v"(qf[1]), "v"(qf[2]), "v"(qf[3]));
  __builtin_amdgcn_s_barrier();
#pragma unroll
  for (int i = 0; i < D; ++i) BA_ISSUE(i);
  for (int kt = 0; kt < nkt; ++kt) {
    if (kt + D < nkt) BA_ISSUE(kt + D);
    int rem = nkt - 1 - kt; rem = rem > D ? D : rem;
    if (DSA) {
      switch (rem) { case 6: BA_WAIT(12); break; case 5: BA_WAIT(10); break; case 4: BA_WAIT(8); break; case 3: BA_WAIT(6); break;
                     case 2: BA_WAIT(4); break; case 1: BA_WAIT(2); break; default: BA_WAIT(0); break; }
    } else {
      switch (rem) { case 6: BA_WAIT(6); break; case 5: BA_WAIT(5); break; case 4: BA_WAIT(4); break; case 3: BA_WAIT(3); break;
                     case 2: BA_WAIT(2); break; case 1: BA_WAIT(1); break; default: BA_WAIT(0); break; }
    }
    __builtin_amdgcn_s_barrier();
    if (kt > qt) continue;
    unsigned wmask = 0xffffffffu;
    if (!DSA && kt < Qb * 8) {
      wmask = ((selmask >> (kt >> 3)) & 1u) ? 0xffffffffu : 0u;
      if (!__any(wmask != 0u)) continue;
    }
    lds_p img = lds + (kt & (R - 1)) * SLOT;
    Frags<2> f;
#pragma unroll
    for (int c = 0; c < 4; ++c) f.k[c] = *(const __attribute__((address_space(3))) bf16x8*)(img + koff[c]);
#pragma unroll
    for (int c = 0; c < 4; ++c) f.v[c] = *(const __attribute__((address_space(3))) bf16x8*)(img + voff[c]);
    if (DSA) {
      const unsigned w_ = (*(const __attribute__((address_space(3))) unsigned*)(img + moff)) >> (8 * hf);
      att_compute<2>(st, qf, f, nullptr, [w_](int r, float p) { return mask_bit(w_, 16 * (r >> 3) + (r & 7), p); });
    } else if (kt < Qb * 8) {
      att_compute<2>(st, qf, f, nullptr, [wmask](int, float p) { return wmask != 0u ? p : 0.f; });
    } else {
      const int dq = tq - (kt * 32 + 8 * hf);
      att_compute<2>(st, qf, f, nullptr, [dq](int r, float p) { return 16 * (r >> 3) + (r & 7) <= dq ? p : 0.f; });
    }
  }
#undef BA_ISSUE
#undef BA_WAIT
  u16* mix = reinterpret_cast<u16*>(ws + OFF_MIX);
  att_store<2>(st, mix + (size_t)(b * S + tq) * 1024 + h * 64, hf);
}

DI void dil_att_unit(char* ws, int u, int lane) {
  const int r16 = u & 15, T0 = (u >> 4) & 7, bhh = u >> 7, b = bhh >> 2, hh = bhh & 3;
  const int ql = lane & 31, hf = lane >> 5;
  const int tq = T0 * 512 + 16 * ql + r16;
  char* big = ws + OFF_BIG;
  const u16* Q = reinterpret_cast<const u16*>(big + BO_Q);
  const u16* K = reinterpret_cast<const u16*>(big + BO_K);
  AttState<6> st; att_init(st);
  const int pk = pi_swap(ql);
  for (int g = 0; g < 3; ++g) {
    const int sh = 2 * g, dil = 1 << sh, r = r16 & (dil - 1);
    const int bh = b * 12 + 4 * g + hh;
    bf16x8 qf[4];
    load_q(qf, Q + ((size_t)bh * S + tq) * 64, hf);
    const int jq = tq >> sh;
    const int jmin = (T0 * 512 + r16) >> sh, jmax = (T0 * 512 + 496 + r16) >> sh;
    int k0 = jmin - 128; k0 = k0 < 0 ? 0 : k0 >> 5;
    const u16* Vg = reinterpret_cast<const u16*>(big + BO_V + (size_t)g * SZ_QKV) + ((size_t)(bhh * dil + r) * (128 >> sh)) * 6144 + ql * 32 + 8 * hf;
    const u16* Kg = K + ((size_t)bh * S + r) * 64 + 8 * hf;
    att_range<6>(st, qf, k0, jmax >> 5,
                 [Kg, pk, sh](int jt) { return Kg + ((size_t)((jt * 32 + pk) << sh)) * 64; },
                 [Vg](int jt) { return Vg + (size_t)jt * 6144; },
                 [](int) { return 0u; },
                 [hf, jq](int jt, unsigned) { const int dq = jq - (jt * 32 + 8 * hf); return [dq](int rr, float p) { return (unsigned)(dq - (16 * (rr >> 3) + (rr & 7))) <= 128u ? p : 0.f; }; });
  }
  u16* mix = reinterpret_cast<u16*>(ws + OFF_MIX);
  att_store<6>(st, mix + (size_t)(b * S + tq) * 1024 + hh * 192, hf);
}

DI void ki_prep_phase(const Ctx& cx, char* ws, const float* g, const float* bta) {
  const int lane = cx.tid & 63, gw = cx.bid * WPB + __builtin_amdgcn_readfirstlane(cx.tid >> 6), nw = cx.nb * WPB;
  const float* raw = reinterpret_cast<const float*>(ws + OFF_BIG + BO_KIRAW);
  u16* kib = reinterpret_cast<u16*>(ws + OFF_BIG + BO_KIB);
  const float* cs = reinterpret_cast<const float*>(ws + OFF_COS);
  const float* sn = reinterpret_cast<const float*>(ws + OFF_SIN);
  const float gg = g[lane], bb = bta[lane];
  constexpr int RB = 4;
  for (int r0 = gw * RB; r0 < T; r0 += nw * RB) {
    float v[RB], c[RB], s[RB];
#pragma unroll
    for (int k = 0; k < RB; ++k) {
      v[k] = raw[(size_t)(r0 + k) * 64 + lane];
      c[k] = cs[(r0 + k) * 8 + (lane & 7)]; s[k] = sn[(r0 + k) * 8 + (lane & 7)];
    }
    float mu[RB], d[RB], rs[RB];
#pragma unroll
    for (int k = 0; k < RB; ++k) mu[k] = wave_sum(v[k]) * (1.f / 64.f);
#pragma unroll
    for (int k = 0; k < RB; ++k) { d[k] = v[k] - mu[k]; rs[k] = rsqrtf(wave_sum(d[k] * d[k]) * (1.f / 64.f) + LN_EPS); }
#pragma unroll
    for (int k = 0; k < RB; ++k) {
      float y = d[k] * rs[k] * gg + bb;
      const float py = sx<8>(y);
      if (lane < 16) y = lane < 8 ? y * c[k] - py * s[k] : y * c[k] + py * s[k];
      kib[(size_t)(r0 + k) * 64 + rope_pos(lane)] = f2bf(y);
    }
  }
}

DI float relu1(float x) { return __builtin_amdgcn_fmed3f(x, 0.f, 3.0e38f); }
DI unsigned sortable(float f) { unsigned u = __float_as_uint(f); u = (u & 0x80000000u) ? ~u : (u | 0x80000000u); return u & ~((1u << SEL_LOW_BIT) - 1u); }

DI int wave_total(int v) {
  v += __builtin_amdgcn_update_dpp(0, v, 0x111, 0xf, 0xf, true);
  v += __builtin_amdgcn_update_dpp(0, v, 0x112, 0xf, 0xf, true);
  v += __builtin_amdgcn_update_dpp(0, v, 0x114, 0xf, 0xf, true);
  v += __builtin_amdgcn_update_dpp(0, v, 0x118, 0xf, 0xf, true);
  v += __builtin_amdgcn_update_dpp(0, v, 0x142, 0xa, 0xf, true);
  v += __builtin_amdgcn_update_dpp(0, v, 0x143, 0xc, 0xf, true);
  return __builtin_amdgcn_readlane(v, 63);
}

DI unsigned long long select256(const unsigned (&u)[64], int lane) {
  unsigned th = 0u;
  int g = 0;
  for (int bit = 31; bit >= SEL_LOW_BIT; --bit) {
    const unsigned c = th | (1u << bit);
    int cnt = 0;
#pragma unroll
    for (int r = 0; r < 64; r += 8)
      asm("v_cmp_le_u32 vcc, %1, %2\n\tv_addc_co_u32 %0, vcc, 0, %0, vcc\n\t"
          "v_cmp_le_u32 vcc, %1, %3\n\tv_addc_co_u32 %0, vcc, 0, %0, vcc\n\t"
          "v_cmp_le_u32 vcc, %1, %4\n\tv_addc_co_u32 %0, vcc, 0, %0, vcc\n\t"
          "v_cmp_le_u32 vcc, %1, %5\n\tv_addc_co_u32 %0, vcc, 0, %0, vcc\n\t"
          "v_cmp_le_u32 vcc, %1, %6\n\tv_addc_co_u32 %0, vcc, 0, %0, vcc\n\t"
          "v_cmp_le_u32 vcc, %1, %7\n\tv_addc_co_u32 %0, vcc, 0, %0, vcc\n\t"
          "v_cmp_le_u32 vcc, %1, %8\n\tv_addc_co_u32 %0, vcc, 0, %0, vcc\n\t"
          "v_cmp_le_u32 vcc, %1, %9\n\tv_addc_co_u32 %0, vcc, 0, %0, vcc"
          : "+v"(cnt) : "s"(c), "v"(u[r]), "v"(u[r + 1]), "v"(u[r + 2]), "v"(u[r + 3]), "v"(u[r + 4]), "v"(u[r + 5]), "v"(u[r + 6]), "v"(u[r + 7]) : "vcc");
    const int n = wave_total(cnt);
    if (n == 256) { th = c - 1u; g = 256; break; }
    if (n > 256) th = c; else g = n;
  }
  int need = th == 0u ? 0 : 256 - g;
  int mlo = 0, mhi = 0;
#pragma unroll
  for (int r = 0; r < 64; ++r) {
    const unsigned long long gt = __ballot(u[r] > th), eq = __ballot(u[r] == th);
    unsigned long long tk = 0ull;
    if (need > 0 && eq != 0ull) {
      const int pre = __builtin_amdgcn_mbcnt_hi((unsigned)(eq >> 32), __builtin_amdgcn_mbcnt_lo((unsigned)eq, 0u));
      tk = __ballot(u[r] == th && pre < need);
      need -= __popcll(tk);
    }
    const unsigned long long mv = gt | tk;
    asm volatile("s_nop 3\n\tv_writelane_b32 %0, %2, %4\n\tv_writelane_b32 %1, %3, %4" : "+v"(mlo), "+v"(mhi) : "s"((unsigned)mv), "s"((unsigned)(mv >> 32)), "n"(r));
  }
  return ((unsigned long long)(unsigned)mhi << 32) | (unsigned)mlo;
}

DI void dsa_select_block(char* ws, char* smem, int wid, int lane, int b, int t0, int gwave) {
  typedef __attribute__((address_space(3))) unsigned char* lds_p;
  lds_p lds = (lds_p)smem;
  char* big = ws + OFF_BIG;
  const u16* QI = reinterpret_cast<const u16*>(big + BO_QI);
  const char* kbase = big + BO_KIB + (size_t)b * S * 128;
  const float* WI = reinterpret_cast<const float*>(big + BO_WI);
  unsigned long long* BM = reinterpret_cast<unsigned long long*>(big + BO_BM);
  unsigned* scr = reinterpret_cast<unsigned*>(big + BO_SCR) + (size_t)gwave * 4096 + lane;
  const int tA = t0 + 2 * wid, nch = ((t0 + 15) >> 8) + 1;
  const int row = lane & 15, kq = lane >> 4, tid = wid * 64 + lane;
  const u16* qip = QI + ((size_t)(b * S + tA + (row >> 3)) * 8 + (row & 7)) * 64 + kq * 8;
  const bf16x8 qa0 = ld8(qip), qa1 = ld8(qip + 32);
  const float4 w = *reinterpret_cast<const float4*>(WI + (size_t)(b * S + tA + (kq >> 1)) * 8 + (kq & 1) * 4);
  unsigned soff[4];
#pragma unroll
  for (int i = 0; i < 4; ++i) { const int p = i * 512 + tid, r = p >> 3, lc = (p & 7) ^ ((r >> 1) & 7); soff[i] = (unsigned)(r * 128 + lc * 16); }
  const unsigned ldsw = (unsigned)wid * 1024u;
#define SEL_ISSUE(c, slot) do { _Pragma("unroll") for (int _i = 0; _i < 4; ++_i) \
    __builtin_amdgcn_global_load_lds((const unsigned*)(kbase + (size_t)(c) * 32768 + soff[_i]), (__attribute__((address_space(3))) unsigned*)(lds + (slot) * 32768 + _i * 8192 + ldsw), 16, 0, 0); } while (0)
#define SEL_WAIT(n) asm volatile("s_waitcnt vmcnt(" #n ")" ::: "memory")
  int boff[2];
#pragma unroll
  for (int kk = 0; kk < 2; ++kk) boff[kk] = row * 128 + (((kk * 4 + kq) ^ ((row >> 1) & 7)) << 4);
  asm volatile("" :: "v"(qa0), "v"(qa1), "v"(w.x), "v"(w.y), "v"(w.z), "v"(w.w));
  __builtin_amdgcn_s_barrier();
  SEL_ISSUE(0, 0);
  if (nch > 1) SEL_ISSUE(1, 1);
  unsigned u[64];
#pragma unroll
  for (int c = 0; c < 16; ++c) {
    if (c < nch) {
      if (c + 2 < nch) { SEL_ISSUE(c + 2, (c + 2) & 3); SEL_WAIT(8); }
      else if (c + 1 < nch) SEL_WAIT(4);
      else SEL_WAIT(0);
      __builtin_amdgcn_s_barrier();
      lds_p img = lds + (c & 3) * 32768;
#pragma unroll
      for (int rr = 0; rr < 4; ++rr) {
        const int r = c * 4 + rr;
        float sa[4], sb[4];
        bf16x8 kb0[4], kb1[4];
#pragma unroll
        for (int tt = 0; tt < 4; ++tt) {
          const int tile = rr * 4 + tt;
          kb0[tt] = *(const __attribute__((address_space(3))) bf16x8*)(img + tile * 2048 + boff[0]);
          kb1[tt] = *(const __attribute__((address_space(3))) bf16x8*)(img + tile * 2048 + boff[1]);
        }
        f32x4 cc[4];
#pragma unroll
        for (int tt = 0; tt < 4; ++tt) cc[tt] = mfma16(qa0, kb0[tt], f32x4{0.f, 0.f, 0.f, 0.f});
#pragma unroll
        for (int tt = 0; tt < 4; ++tt) cc[tt] = mfma16(qa1, kb1[tt], cc[tt]);
        float pp[4], ps[4];
#pragma unroll
        for (int tt = 0; tt < 4; ++tt) pp[tt] = w.x * relu1(cc[tt][0]) + w.y * relu1(cc[tt][1]) + w.z * relu1(cc[tt][2]) + w.w * relu1(cc[tt][3]);
#pragma unroll
        for (int tt = 0; tt < 4; ++tt) ps[tt] = sx<16>(pp[tt]);
#pragma unroll
        for (int tt = 0; tt < 4; ++tt) {
          const float pt = pp[tt] + ps[tt];
          const int iv = __builtin_bit_cast(int, pt); int iw = iv; asm volatile("" : "+v"(iw));
          auto sw = __builtin_amdgcn_permlane32_swap(iv, iw, false, false);
          sa[tt] = __builtin_bit_cast(float, (int)sw[0]); sb[tt] = __builtin_bit_cast(float, (int)sw[1]);
        }
        const float scA = kq == 0 ? sa[0] : kq == 1 ? sa[1] : kq == 2 ? sa[2] : sa[3];
        const float scB = kq == 0 ? sb[0] : kq == 1 ? sb[1] : kq == 2 ? sb[2] : sb[3];
        const int key = r * 64 + lane;
        u[r] = key <= tA ? sortable(scA) : 0u;
        stg4(scr + r * 64, key <= tA + 1 ? sortable(scB) : 0u);
      }
    } else {
#pragma unroll
      for (int rr = 0; rr < 4; ++rr) { u[c * 4 + rr] = 0u; stg4(scr + (c * 4 + rr) * 64, 0u); }
    }
  }
#undef SEL_ISSUE
#undef SEL_WAIT
  const unsigned long long mA = select256(u, lane);
  stg8(BM + (size_t)(b * S + tA) * 64 + lane, make_uint2((unsigned)mA, (unsigned)(mA >> 32)));
#pragma unroll
  for (int r = 0; r < 64; ++r) u[r] = ldg32(scr + r * 64);
  const unsigned long long mB = select256(u, lane);
  stg8(BM + (size_t)(b * S + tA + 1) * 64 + lane, make_uint2((unsigned)mB, (unsigned)(mB >> 32)));
}

DI void kmean_phase(const Ctx& cx, char* ws) {
  const int lane = cx.tid & 63, gw = cx.bid * WPB + __builtin_amdgcn_readfirstlane(cx.tid >> 6), nw = cx.nb * WPB;
  const u16* K = reinterpret_cast<const u16*>(ws + OFF_BIG + BO_K);
  float* KM = reinterpret_cast<float*>(ws + OFF_KMEAN);
  for (int u = gw; u < NB * 12 * 16; u += nw) {
    const int bh = u >> 4, blk = u & 15;
    const u16* kp = K + ((size_t)bh * S + blk * 256) * 64 + lane * 8;
    float acc[8];
#pragma unroll
    for (int j = 0; j < 8; ++j) acc[j] = 0.f;
#pragma unroll 8
    for (int i = 0; i < 32; ++i) {
      const u32x4 v = __builtin_bit_cast(u32x4, ld8(kp + i * 512));
#pragma unroll
      for (int j = 0; j < 4; ++j) { acc[2 * j] += __uint_as_float(v[j] << 16); acc[2 * j + 1] += __uint_as_float(v[j] & 0xffff0000u); }
    }
#pragma unroll
    for (int j = 0; j < 8; ++j) { float a = acc[j]; a += sx<8>(a); a += sx<16>(a); a = red32_sum(a); acc[j] = a * (1.f / 256.f); }
    if (lane < 8) {
      float* dst = KM + (size_t)u * 64 + lane * 8;
      *reinterpret_cast<float4*>(dst) = make_float4(acc[0], acc[1], acc[2], acc[3]);
      *reinterpret_cast<float4*>(dst + 4) = make_float4(acc[4], acc[5], acc[6], acc[7]);
      *reinterpret_cast<uint4*>(reinterpret_cast<u16*>(ws + OFF_KMEANB) + (size_t)u * 64 + lane * 8) =
          make_uint4(pk2(acc[0], acc[1]), pk2(acc[2], acc[3]), pk2(acc[4], acc[5]), pk2(acc[6], acc[7]));
    }
  }
}

DI void grid_barrier(unsigned* cnt, unsigned target, int tid) {
  asm volatile("s_waitcnt vmcnt(0)" ::: "memory");
  __syncthreads();
  if (tid == 0) {
    __builtin_amdgcn_fence(__ATOMIC_RELEASE, "agent");
    asm volatile("s_waitcnt vmcnt(0)" ::: "memory");
    __hip_atomic_fetch_add(cnt, 1u, __ATOMIC_RELAXED, __HIP_MEMORY_SCOPE_AGENT);
    while (__hip_atomic_load(cnt, __ATOMIC_RELAXED, __HIP_MEMORY_SCOPE_AGENT) < target) __builtin_amdgcn_s_sleep(1);
    __builtin_amdgcn_fence(__ATOMIC_ACQUIRE, "agent");
    asm volatile("s_waitcnt vmcnt(0)" ::: "memory");
  }
  __syncthreads();
}

#define XB_TMO      128
#define XB_XCNT(j)  (256  + 64 * (j))
#define XB_XSUB(j)  (1280 + 64 * (j))
#define XB_XGEN(j)  (2304 + 64 * (j))
#define XB_TOP      3328
#define XB_TOPGEN   3392
#define XB_SPIN_CAP (1u << 20)
DI unsigned xb_ld(unsigned* p) { return __hip_atomic_load(p, __ATOMIC_RELAXED, __HIP_MEMORY_SCOPE_AGENT); }
DI unsigned xb_add(unsigned* p, unsigned v) { return __hip_atomic_fetch_add(p, v, __ATOMIC_RELAXED, __HIP_MEMORY_SCOPE_AGENT); }
DI unsigned xb_xcc_id() { return (unsigned)__builtin_amdgcn_s_getreg((3 << 11) | 20) & 0xFu; }
#define XB_SPIN(cond, bar) do { unsigned _sp = 0; while (cond) { __builtin_amdgcn_s_sleep(1); \
    if ((++_sp & 255u) == 0u) { if (xb_ld(&(bar)[XB_TMO])) break; if (_sp > XB_SPIN_CAP) { atomicAdd(&(bar)[XB_TMO], 1u); break; } } } } while (0)
typedef volatile __attribute__((address_space(3))) unsigned* xb_lds_p;
DI void xcd_barrier_complete(unsigned* bar, unsigned x, unsigned G, unsigned& nloc, unsigned& nx) {
  unsigned sum, cnt, mine, sp = 0u;
  for (;;) {
    sum = 0u; cnt = 0u; mine = 0u;
#pragma unroll
    for (unsigned j = 0; j < 16; ++j) { const unsigned c = xb_ld(&bar[XB_XCNT(j)]); sum += c; cnt += (c > 0u) ? 1u : 0u; mine = (j == x) ? c : mine; }
    if (sum == G) break;
    __builtin_amdgcn_s_sleep(1);
    if ((++sp & 255u) == 0u) { if (xb_ld(&bar[XB_TMO])) break; if (sp > XB_SPIN_CAP) { atomicAdd(&bar[XB_TMO], 1u); break; } }
  }
  nloc = mine > 0u ? mine : 1u; nx = cnt > 0u ? cnt : 1u;
}
DI void xcd_barrier(unsigned* bar, unsigned x, xb_lds_p st, unsigned G, int tid) {
  asm volatile("s_waitcnt vmcnt(0)" ::: "memory");
  __syncthreads();
  if (tid == 0) {
    __builtin_amdgcn_s_waitcnt(0);
    unsigned nloc = st[0], nx = st[1];
    if (nloc == 0u) { xcd_barrier_complete(bar, x, G, nloc, nx); st[0] = nloc; st[1] = nx; }
    const unsigned old = xb_add(&bar[XB_XSUB(x)], 1u);
    const unsigned gen = old / nloc;
    if (old + 1u == (gen + 1u) * nloc) {
      __builtin_amdgcn_fence(__ATOMIC_RELEASE, "agent");
      asm volatile("s_waitcnt vmcnt(0)" ::: "memory");
      const unsigned og = xb_add(&bar[XB_TOP], 1u);
      const unsigned tg = og / nx;
      if (og + 1u == (tg + 1u) * nx) xb_add(&bar[XB_TOPGEN], 1u);
      else XB_SPIN(xb_ld(&bar[XB_TOPGEN]) == tg, bar);
      __builtin_amdgcn_fence(__ATOMIC_ACQUIRE, "agent");
      xb_add(&bar[XB_XGEN(x)], 1u);
      asm volatile("s_waitcnt vmcnt(0)" ::: "memory");
    } else {
      XB_SPIN(xb_ld(&bar[XB_XGEN(x)]) == gen, bar);
      __builtin_amdgcn_fence(__ATOMIC_ACQUIRE, "agent");
      asm volatile("s_waitcnt vmcnt(0)" ::: "memory");
    }
  }
  __syncthreads();
}

template <class Epi>
DI void run_gemm(const Ctx& cx, char* smem, const u16* A, const u16* Bt, int M, int N, int K, int crot, const Epi& epi) {
  pg8::StaticOrder so; so.init(M, N, cx.nb, (cx.bid + crot) % cx.nb);
  pg8::gemm_phase(cx.tid, (PG8_LAS unsigned char*)smem, pg8::Gemm{A, Bt, M, N, K}, so, epi);
}

__global__ void __launch_bounds__(NTHR, 2) fwd_kernel(Params p) {
  extern __shared__ __attribute__((aligned(16))) char smem[];
  cg::grid_group grid = cg::this_grid();
  bool first = true;
  const int wave_id = __builtin_amdgcn_readfirstlane(threadIdx.x >> 6);
  xb_lds_p xb_st = (xb_lds_p)(smem + LDS_BYTES);
  unsigned* xb_bar = reinterpret_cast<unsigned*>(p.ws + OFF_BAR);
  const unsigned xb_x = xb_xcc_id();
  if (threadIdx.x == 0) { xb_st[0] = 0u; xb_st[1] = 0u; (void)xb_add(&xb_bar[XB_XCNT(xb_x)], 1u); }
  __syncthreads();
  if (p.ph_lo == 0) {
    Ctx cx; cx.tid = threadIdx.x; cx.bid = blockIdx.x; cx.nb = gridDim.x;
    if (EN & 1) phase0(cx, p, p.ws, smem);
    if (XP0) phase0(cx, p, p.ws, smem);
    for (int i = 0; i < XSYNC; ++i) grid.sync();
    first = false;
  }
  bool rep_done = false;
  int nbar = 0;
  for (int ph = p.ph_lo < 1 ? 1 : p.ph_lo; ph < p.ph_hi; ++ph) {
    const int layer = (ph - 1) / 9, slot = (ph - 1) % 9;
    if (REP) { if (((REP >> slot) & 1) && ((REPL >> layer) & 1) && !rep_done) { rep_done = true; --ph; } else rep_done = false; }
    const int kind = layer % 3, jl = layer / 3;
    if ((slot == 1 && kind == 1) || (slot == 2 && kind != 0)) continue;
    if (!first) {
      if (nbar == 0) grid.sync();
      else xcd_barrier(reinterpret_cast<unsigned*>(p.ws + OFF_BAR), xb_x, xb_st, gridDim.x, (int)threadIdx.x);
      ++nbar;
    }
    first = false;
    typedef const Params __attribute__((address_space(4)))* KArgs;
    KArgs pp = (KArgs)__builtin_amdgcn_kernarg_segment_ptr();
    asm volatile("" : "+s"(pp));
    char* ws = pp->ws; float* outp = pp->out;
    Ctx cx; cx.bid = blockIdx.x; cx.nb = gridDim.x;
    int wid = wave_id;
    asm volatile("" : "+s"(ws), "+s"(outp), "+s"(wid), "+s"(cx.bid), "+s"(cx.nb));
    unsigned ones = ~0u; asm volatile("" : "+s"(ones));
    const int lane = __builtin_amdgcn_mbcnt_hi(ones, __builtin_amdgcn_mbcnt_lo(ones, 0u));
    cx.tid = wid * 64 + lane;
    const int gw = cx.bid * WPB + wid, nw = cx.nb * WPB;
    if (slot == 0 && (EN & 2)) {
      const int nmain = kind == 0 ? NMAIN_A : NMAIN_BC;
      run_gemm(cx, smem, reinterpret_cast<const u16*>(ws + OFF_XB), reinterpret_cast<const u16*>(ws + win_off(layer)), T, nmain, 1024, 0, EpiInProj{ws, kind});
      run_gemm(cx, smem, reinterpret_cast<const u16*>(ws + win_off(layer)) + (size_t)nmain * 1024, reinterpret_cast<const u16*>(ws + OFF_XB), 768, T, 1024, kind == 0 ? 0 : cx.nb / 2, EpiVt{ws, kind});
      if (layer == 0 && (EN & 2048))
        run_gemm(cx, smem, reinterpret_cast<const u16*>(ws + OFF_MEMN), reinterpret_cast<const u16*>(ws + OFF_WMKV), NB * NMEM, 4 * 512, 1024, cx.nb / 2, EpiMemKV{ws});
    } else if (slot == 1 && (EN & 4)) {
      if (kind == 0) ki_prep_phase(cx, ws, pp->idx_g + jl * 64, pp->idx_b + jl * 64);
      else kmean_phase(cx, ws);
    } else if (slot == 2 && (EN & 8)) {
      for (int v = cx.bid; v < NB * (S / 16); v += cx.nb) {
        const int b = v >> 8, idx = v & 255, j = (b & 1) ? 255 - idx : idx;
        dsa_select_block(ws, smem, wid, lane, b, j * 16, gw);
      }
    } else if (slot == 3) {
      if (EN & 128) for (int u = gw; u < NB * 4 * 128; u += nw) mem_att_unit(ws, layer, kind, u, lane);
      if (kind == 1 && (EN & 16)) {
        for (int u = gw; u < NB * 4 * 8 * 16; u += nw) dil_att_unit(ws, u, lane);
      } else {
        for (int k = 0; k * cx.nb < NB * 12 * 16; ++k) {
          const int v = k * cx.nb + ((k & 1) ? cx.nb - 1 - cx.bid : cx.bid);
          if (v >= NB * 12 * 16) continue;
          const int Qb = 15 - v / 96, bh = v % 96;
          if (kind == 0) { if (EN & 32) blk_att_unit<true>(ws, smem, wid, lane, bh, Qb); }
          else { if (EN & 64) blk_att_unit<false>(ws, smem, wid, lane, bh, Qb); }
        }
      }
    } else if (slot == 4 && (EN & 256)) {
      run_gemm(cx, smem, reinterpret_cast<const u16*>(ws + OFF_MIX), reinterpret_cast<const u16*>(ws + OFF_WOUT + layer * SZ_WOUT), T, 1024, 1024, 0, EpiResid{layer == 0 ? pp->x : outp, outp, layer == 0 ? nullptr : reinterpret_cast<const float2*>(ws + OFF_STAT), pp->ln2g + (layer - 1) * 1024, pp->ln2b + (layer - 1) * 1024});
    } else if (slot == 5) {
      ln_phase(cx, outp, pp->ln1g + layer * 1024, pp->ln1b + layer * 1024, reinterpret_cast<u16*>(ws + OFF_XB), reinterpret_cast<float2*>(ws + OFF_STAT), false);
    } else if (slot == 6 && (EN & 512)) {
      run_gemm(cx, smem, reinterpret_cast<const u16*>(ws + OFF_XB), reinterpret_cast<const u16*>(ws + OFF_WGU + layer * SZ_WGU), T, 2 * DFF, 1024, 0, EpiSwiGLU{reinterpret_cast<u16*>(ws + OFF_BIG + BO_H)});
    } else if (slot == 7 && (EN & 1024)) {
      run_gemm(cx, smem, reinterpret_cast<const u16*>(ws + OFF_BIG + BO_H), reinterpret_cast<const u16*>(ws + OFF_WDN + layer * SZ_WDN), T, 1024, DFF, 0, EpiResid{outp, outp, reinterpret_cast<const float2*>(ws + OFF_STAT), pp->ln1g + layer * 1024, pp->ln1b + layer * 1024});
    } else {
      ln_phase(cx, outp, pp->ln2g + layer * 1024, pp->ln2b + layer * 1024, reinterpret_cast<u16*>(ws + OFF_XB), reinterpret_cast<float2*>(ws + OFF_STAT), layer == DEPTH - 1);
    }
  }
}

extern "C" void kernel_launch(void* const* d_in, const int* in_sizes, int n_in, void* d_out, int out_size,
                              void* d_ws, size_t ws_size, hipStream_t stream) {
  static int grid_blocks = 0;
  if (!grid_blocks) {
    int dev = 0, cus = 0, per_cu = 0;
    (void)hipGetDevice(&dev);
    (void)hipDeviceGetAttribute(&cus, hipDeviceAttributeMultiprocessorCount, dev);
    if (hipFuncSetAttribute((const void*)fwd_kernel, hipFuncAttributeMaxDynamicSharedMemorySize, LDS_TOTAL) != hipSuccess)
      fprintf(stderr, "hipFuncSetAttribute(max dynamic LDS) failed\n");
    (void)hipOccupancyMaxActiveBlocksPerMultiprocessor(&per_cu, fwd_kernel, NTHR, LDS_TOTAL);
    if (per_cu < 1) fprintf(stderr, "occupancy query reports %d blocks per CU\n", per_cu);
    grid_blocks = cus;
  }
  if (ws_size < WS_NEED) fprintf(stderr, "workspace too small: %zu < %zu\n", ws_size, (size_t)WS_NEED);
  Params p{};
  p.x = (const float*)d_in[0]; p.mem = (const float*)d_in[1]; p.pos = (const int*)d_in[2];
  p.mem_g = (const float*)d_in[3]; p.mem_b = (const float*)d_in[4];
  p.w_in_a = (const float*)d_in[5]; p.idx_g = (const float*)d_in[6]; p.idx_b = (const float*)d_in[7];
  p.w_in_b = (const float*)d_in[8]; p.w_in_c = (const float*)d_in[9];
  p.w_mkv = (const float*)d_in[10]; p.w_out = (const float*)d_in[11];
  p.ln1g = (const float*)d_in[12]; p.ln1b = (const float*)d_in[13];
  p.w_gu = (const float*)d_in[14]; p.w_dn = (const float*)d_in[15];
  p.ln2g = (const float*)d_in[16]; p.ln2b = (const float*)d_in[17];
  p.out = (float*)d_out; p.ws = (char*)d_ws;
  for (int i = 0; i < 8; ++i) p.inv_freq[i] = (float)pow(500000.0, -(double)i / 8.0);
  const int NPH = 1 + DEPTH * 9;
#if SINGLE_LAUNCH
  (void)hipMemsetAsync((char*)d_ws + OFF_BAR, 0, (size_t)XCD_BAR_WORDS * 4, stream);
  p.ph_lo = 0; p.ph_hi = NPH;
  void* args[] = {&p};
  hipError_t e = hipLaunchCooperativeKernel((void*)fwd_kernel, dim3(grid_blocks), dim3(NTHR), args, LDS_TOTAL, stream);
  if (e != hipSuccess) fprintf(stderr, "cooperative launch failed: %s (grid %d)\n", hipGetErrorString(e), grid_blocks);
#else
  for (int ph = 0; ph < NPH; ++ph) {
    if (ph > 0) {
      const int layer = (ph - 1) / 9, slot = (ph - 1) % 9, kind = layer % 3;
      if ((slot == 1 && kind == 1) || (slot == 2 && kind != 0)) continue;
    }
    p.ph_lo = ph; p.ph_hi = ph + 1;
    hipLaunchKernelGGL(fwd_kernel, dim3(grid_blocks), dim3(NTHR), LDS_TOTAL, stream, p);
  }
#endif
}
```

```cpp
#include <hip/hip_runtime.h>
#include <hip/hip_cooperative_groups.h>
#include <cstdio>
#include <cmath>
namespace cg = cooperative_groups;

#ifndef EN
#define EN 0xFFFF
#endif
#ifndef SEL_LOW_BIT
#define SEL_LOW_BIT 8
#endif
#ifndef XSYNC
#define XSYNC 0
#endif
#ifndef XP0
#define XP0 0
#endif
#ifndef REP
#define REP 0
#endif
#ifndef REPL
#define REPL 15
#endif
#ifndef SINGLE_LAUNCH
#define SINGLE_LAUNCH 1
#endif

#define DI __device__ __forceinline__
typedef unsigned short u16;
using bf16x8 = __attribute__((ext_vector_type(8))) __bf16;
using bf2 = __attribute__((ext_vector_type(2))) __bf16;
using f32x4 = __attribute__((ext_vector_type(4))) float;
using f32x16 = __attribute__((ext_vector_type(16))) float;
using u32x4 = __attribute__((ext_vector_type(4))) unsigned;

constexpr int NB = 8, S = 4096, DM = 1024, T = NB * S, DEPTH = 4;
constexpr int NMEM = 256, DFF = 2816;
constexpr int NPAD_A = 3328, NPAD_BC = 2560;
constexpr int NMAIN_A = 2560, NMAIN_BC = 1792;
constexpr int NTHR = 512, WPB = 8;
constexpr int LDS_BYTES = 131072;
constexpr int LDS_TOTAL = LDS_BYTES + 16;
constexpr float ALPHA = 1.681792830507429f;
constexpr float LN_EPS = 1e-5f;

constexpr size_t SZ_WIN_A = (size_t)NPAD_A * 1024 * 2, SZ_WIN_BC = (size_t)NPAD_BC * 1024 * 2;
constexpr size_t OFF_WIN0 = 0;
constexpr size_t OFF_WIN1 = OFF_WIN0 + SZ_WIN_A;
constexpr size_t OFF_WIN2 = OFF_WIN1 + SZ_WIN_BC;
constexpr size_t OFF_WIN3 = OFF_WIN2 + SZ_WIN_BC;
constexpr size_t OFF_WMKV = OFF_WIN3 + SZ_WIN_A;
constexpr size_t SZ_WMKV = (size_t)512 * 1024 * 2;
constexpr size_t OFF_WOUT = OFF_WMKV + 4 * SZ_WMKV;
constexpr size_t SZ_WOUT = (size_t)1024 * 1024 * 2;
constexpr size_t OFF_WGU = OFF_WOUT + 4 * SZ_WOUT;
constexpr size_t SZ_WGU = (size_t)5632 * 1024 * 2;
constexpr size_t OFF_WDN = OFF_WGU + 4 * SZ_WGU;
constexpr size_t SZ_WDN = (size_t)1024 * 2816 * 2;
constexpr size_t OFF_XB = OFF_WDN + 4 * SZ_WDN;
constexpr size_t SZ_XB = (size_t)T * 1024 * 2;
constexpr size_t OFF_MIX = OFF_XB + SZ_XB;
constexpr size_t OFF_MEMN = OFF_MIX + SZ_XB;
constexpr size_t OFF_MK = OFF_MEMN + (size_t)2048 * 1024 * 2;
constexpr size_t SZ_MK = (size_t)8 * 4 * 256 * 64 * 2;
constexpr size_t OFF_MVT = OFF_MK + 4 * SZ_MK;
constexpr size_t OFF_COS = OFF_MVT + 4 * SZ_MK;
constexpr size_t OFF_SIN = OFF_COS + (size_t)T * 8 * 4;
constexpr size_t OFF_KMEAN = OFF_SIN + (size_t)T * 8 * 4;
constexpr size_t OFF_KMEANB = OFF_KMEAN + (size_t)8 * 12 * 16 * 64 * 4;
constexpr size_t OFF_BIG = OFF_KMEANB + (size_t)8 * 12 * 16 * 64 * 2;
constexpr size_t SZ_QKV = (size_t)T * 768 * 2;
constexpr size_t BO_Q = 0, BO_K = SZ_QKV, BO_V = 2 * SZ_QKV;
constexpr size_t BO_QM_AC = 3 * SZ_QKV, BO_QM_B = 5 * SZ_QKV;
constexpr size_t SZ_QM = (size_t)T * 256 * 2;
constexpr size_t BO_QI = BO_QM_AC + SZ_QM;
constexpr size_t BO_KIRAW = BO_QI + (size_t)T * 512 * 2;
constexpr size_t BO_KIB = BO_KIRAW + (size_t)T * 64 * 4;
constexpr size_t BO_WI = BO_KIB + (size_t)T * 64 * 2;
constexpr size_t BO_BM = BO_WI + (size_t)T * 8 * 4;
constexpr size_t BO_SCR = BO_BM + (size_t)T * 128 * 4;
constexpr size_t BO_H = 0;
constexpr size_t OFF_STAT = OFF_BIG + 5 * SZ_QKV + SZ_QM;
constexpr size_t OFF_BAR = OFF_STAT + (size_t)T * 8;
constexpr int XCD_BAR_WORDS = 3456;
constexpr size_t WS_NEED = OFF_BAR + (size_t)XCD_BAR_WORDS * 4;

struct Ctx { int tid, bid, nb; };

struct Params {
  const float* x; const float* mem; const int* pos; const float* mem_g; const float* mem_b;
  const float* w_in_a; const float* idx_g; const float* idx_b; const float* w_in_b; const float* w_in_c;
  const float* w_mkv; const float* w_out; const float* ln1g; const float* ln1b;
  const float* w_gu; const float* w_dn; const float* ln2g; const float* ln2b;
  float* out; char* ws;
  float inv_freq[8];
  int ph_lo, ph_hi;
};

DI unsigned pk2(float a, float b) { bf2 v; v[0] = (__bf16)a; v[1] = (__bf16)b; return __builtin_bit_cast(unsigned, v); }
DI u16 f2bf(float a) { return __builtin_bit_cast(u16, (__bf16)a); }
DI float bf2f(u16 b) { return __uint_as_float(((unsigned)b) << 16); }
typedef const bf16x8 __attribute__((address_space(1)))* gp_bf16x8;
typedef const unsigned __attribute__((address_space(1)))* gp_u32;
DI bf16x8 ld8(const u16* p) { return *((gp_bf16x8)(const void*)p); }
DI unsigned ldg32(const unsigned* p) { return *((gp_u32)(const void*)p); }
typedef unsigned u32x2v __attribute__((ext_vector_type(2)));
DI void stg16(void* p, uint4 v) { *((__attribute__((address_space(1))) u32x4*)p) = u32x4{v.x, v.y, v.z, v.w}; }
DI void stg16f(void* p, f32x4 v) { *((__attribute__((address_space(1))) f32x4*)p) = v; }
DI void stg8(void* p, uint2 v) { *((__attribute__((address_space(1))) u32x2v*)p) = u32x2v{v.x, v.y}; }
DI void stg4(void* p, unsigned v) { *((__attribute__((address_space(1))) unsigned*)p) = v; }
DI void stg2(void* p, u16 v) { *((__attribute__((address_space(1))) u16*)p) = v; }
DI f32x4 ldg4(const float* p) { return *((const __attribute__((address_space(1))) f32x4*)(const void*)p); }
typedef float f32x2v __attribute__((ext_vector_type(2)));
DI float2 ldg2(const float2* p) { const f32x2v v = *((const __attribute__((address_space(1))) f32x2v*)(const void*)p); return make_float2(v[0], v[1]); }
DI f32x4 mfma16(bf16x8 a, bf16x8 b, f32x4 c) { return __builtin_amdgcn_mfma_f32_16x16x32_bf16(a, b, c, 0, 0, 0); }
DI f32x16 mfma32(bf16x8 a, bf16x8 b, f32x16 c) { return __builtin_amdgcn_mfma_f32_32x32x16_bf16(a, b, c, 0, 0, 0); }
template <int M> DI float sx(float v) { return __builtin_bit_cast(float, __builtin_amdgcn_ds_swizzle(__builtin_bit_cast(int, v), (M << 10) | 0x1F)); }
DI float red32_sum(float v) { const int iv = __builtin_bit_cast(int, v); int iw = iv; asm volatile("" : "+v"(iw));
  auto r = __builtin_amdgcn_permlane32_swap(iv, iw, false, false); return __builtin_bit_cast(float, (int)r[0]) + __builtin_bit_cast(float, (int)r[1]); }
DI float red32_max(float v) { const int iv = __builtin_bit_cast(int, v); int iw = iv; asm volatile("" : "+v"(iw));
  auto r = __builtin_amdgcn_permlane32_swap(iv, iw, false, false); return fmaxf(__builtin_bit_cast(float, (int)r[0]), __builtin_bit_cast(float, (int)r[1])); }
DI float wave_sum(float v) { v += sx<1>(v); v += sx<2>(v); v += sx<4>(v); v += sx<8>(v); v += sx<16>(v); return red32_sum(v); }
DI size_t win_off(int layer) { return layer == 0 ? OFF_WIN0 : layer == 1 ? OFF_WIN1 : layer == 2 ? OFF_WIN2 : OFF_WIN3; }

DI int rope_pos(int c) { const int d = c & 63; return d < 16 ? (c & ~15) | (d & 3) | ((d & 4) << 1) | ((d & 8) >> 1) : c; }
DI int map_row(int kind, int c) {
  if (kind == 1) {
    if (c < 1536) return rope_pos(c);
    if (c < 2304) return NMAIN_A + (c - 1536);
    if (c < 2816) return 1792 + rope_pos(c - 2304);
    if (c < 2824) return 2368 + (c - 2816);
    if (c < 2888) return 2304 + (c - 2824);
    return 1536 + (c - 2888);
  }
  if (kind == 3) {
    if (c < 1536) return rope_pos(c);
    if (c < 2304) return NMAIN_BC + (c - 1536);
    return 1536 + (c - 2304);
  }
  if (kind == 2) {
    int isu = c >= DFF; int j = c - isu * DFF;
    return (j >> 7) * 256 + isu * 128 + (j & 127);
  }
  return c;
}

DI void conv_job(const Ctx& cx, const float* __restrict__ src, int Ks, int Ns, u16* __restrict__ dst, int kind, float* tile) {
  const int nnt = (Ns + 63) >> 6, nkt = Ks >> 8, tid = cx.tid;
  for (int t = cx.bid; t < nnt * nkt; t += cx.nb) {
    const int kt = t / nnt, nt = t % nnt;
    const int nn = tid & 63, n = nt * 64 + nn;
    float v[32];
#pragma unroll
    for (int i = 0; i < 32; ++i) { const int kk = i * 8 + (tid >> 6); v[i] = n < Ns ? src[(size_t)(kt * 256 + kk) * Ns + n] : 0.f; }
    __syncthreads();
#pragma unroll
    for (int i = 0; i < 32; ++i) tile[(i * 8 + (tid >> 6)) * 65 + nn] = v[i];
    __syncthreads();
#pragma unroll 4
    for (int i = 0; i < 16; ++i) {
      const int n2 = (tid >> 7) + 4 * i, k2 = tid & 127, nr = nt * 64 + n2;
      if (nr < Ns) {
        const int dr = map_row(kind, nr);
        *reinterpret_cast<unsigned*>(dst + (size_t)dr * Ks + kt * 256 + 2 * k2) = pk2(tile[(2 * k2) * 65 + n2], tile[(2 * k2 + 1) * 65 + n2]);
      }
    }
  }
}

DI void phase0(const Ctx& cx, const Params& p, char* ws, char* smem) {
  float* tile = reinterpret_cast<float*>(smem);
  for (int l = 0; l < DEPTH; ++l) {
    const int kind = l % 3, j = l / 3;
    const float* win = kind == 0 ? p.w_in_a + (size_t)j * 1024 * 3144 : kind == 1 ? p.w_in_b : p.w_in_c;
    conv_job(cx, win, 1024, kind == 0 ? 3144 : 2560, (u16*)(ws + win_off(l)), kind == 0 ? 1 : 3, tile);
    conv_job(cx, p.w_mkv + (size_t)l * 1024 * 512, 1024, 512, (u16*)(ws + OFF_WMKV + l * SZ_WMKV), 0, tile);
    conv_job(cx, p.w_out + (size_t)l * 1024 * 1024, 1024, 1024, (u16*)(ws + OFF_WOUT + l * SZ_WOUT), 0, tile);
    conv_job(cx, p.w_gu + (size_t)l * 1024 * 5632, 1024, 5632, (u16*)(ws + OFF_WGU + l * SZ_WGU), 2, tile);
    conv_job(cx, p.w_dn + (size_t)l * 2816 * 1024, 2816, 1024, (u16*)(ws + OFF_WDN + l * SZ_WDN), 0, tile);
  }
  const int gtid = cx.bid * NTHR + cx.tid, gn = cx.nb * NTHR;
  for (int l = 0; l < DEPTH; l += 3) {
    unsigned* d = reinterpret_cast<unsigned*>(ws + win_off(l) + (size_t)2376 * 1024 * 2);
    for (int i = gtid; i < (NMAIN_A - 2376) * 512; i += gn) d[i] = 0u;
  }
  {
    const float4* xs = reinterpret_cast<const float4*>(p.x);
    uint2* xd = reinterpret_cast<uint2*>(ws + OFF_XB);
    for (int i = gtid; i < T * 256; i += 4 * gn) {
      float4 v[4];
#pragma unroll
      for (int j = 0; j < 4; ++j) v[j] = xs[i + j * gn];
#pragma unroll
      for (int j = 0; j < 4; ++j) xd[i + j * gn] = make_uint2(pk2(v[j].x, v[j].y), pk2(v[j].z, v[j].w));
    }
  }
  {
    float* cs = reinterpret_cast<float*>(ws + OFF_COS); float* sn = reinterpret_cast<float*>(ws + OFF_SIN);
    for (int i = gtid; i < T * 8; i += gn) {
      int t = i >> 3, f = i & 7;
      float ang = (float)p.pos[t] * p.inv_freq[f];
      cs[i] = cosf(ang); sn[i] = sinf(ang);
    }
  }
  {
    const int lane = cx.tid & 63, gw = cx.bid * WPB + __builtin_amdgcn_readfirstlane(cx.tid >> 6), nw = cx.nb * WPB;
    u16* mn = reinterpret_cast<u16*>(ws + OFF_MEMN);
    for (int r = gw; r < NB * NMEM; r += nw) {
      const float4* src = reinterpret_cast<const float4*>(p.mem + (size_t)r * 1024);
      float4 v[4]; float s = 0.f;
      for (int i = 0; i < 4; ++i) { v[i] = src[i * 64 + lane]; s += v[i].x + v[i].y + v[i].z + v[i].w; }
      float mu = wave_sum(s) * (1.f / 1024.f);
      float q = 0.f;
      for (int i = 0; i < 4; ++i) { float a = v[i].x - mu, b = v[i].y - mu, c = v[i].z - mu, d = v[i].w - mu; q += a * a + b * b + c * c + d * d; }
      float rs = rsqrtf(wave_sum(q) * (1.f / 1024.f) + LN_EPS);
      for (int i = 0; i < 4; ++i) {
        int c = (i * 64 + lane) * 4;
        float4 g = *reinterpret_cast<const float4*>(p.mem_g + c), bb = *reinterpret_cast<const float4*>(p.mem_b + c);
        uint2 o = make_uint2(pk2((v[i].x - mu) * rs * g.x + bb.x, (v[i].y - mu) * rs * g.y + bb.y),
                             pk2((v[i].z - mu) * rs * g.z + bb.z, (v[i].w - mu) * rs * g.w + bb.w));
        *reinterpret_cast<uint2*>(mn + (size_t)r * 1024 + c) = o;
      }
    }
  }
}

namespace pg8 {
#define PG8_LAS __attribute__((address_space(3)))
typedef short s16x8 __attribute__((ext_vector_type(8)));
constexpr int BM = 256, BK = 64, HALF = 128, HTB = HALF * BK * 2, STAGE_BYTES = 8 * HTB, NXCD = 8, WGM = 8;
DI int lds_byte(int r, int c) { const int st = (r >> 4) * 2 + (c >> 5), rr = r & 15, cc = c & 31, ob = rr * 64 + cc * 2; return st * 1024 + (ob ^ (((ob >> 9) & 1) << 5)); }
DI void stage_rc(int b, int& R, int& C) { const int st = b / 1024, sb = b % 1024, swz = sb ^ (((sb >> 9) & 1) << 5); R = (st >> 1) * 16 + swz / 64; C = (st & 1) * 32 + (swz % 64) / 2; }
DI int perm32(int rho) { const int n = rho >> 4, i = rho & 15; return 8 * (i >> 2) + 4 * n + (i & 3); }
struct Unit { int pm, pn; };
struct Gemm { const u16* A; const u16* Bt; int M, N, K; };
struct StaticOrder {
  int nM, nN, nwg, G, c;
  DI void init(int M, int N, int G_, int c_) { nM = M / BM; nN = N / BM; nwg = nM * nN; G = G_; c = c_; }
  DI bool next(int i, Unit& u) const {
    const long L = (long)i * G + c; if (L >= nwg) return false;
    int wgid = (int)L; { const int q = nwg / NXCD, r = nwg % NXCD, xcd = wgid % NXCD, off = wgid / NXCD; wgid = (xcd < r ? xcd * (q + 1) : r * (q + 1) + (xcd - r) * q) + off; }
    const int nig = WGM * nN, gid = wgid / nig, fm = gid * WGM, gsz = (nM - fm) < WGM ? (nM - fm) : WGM;
    u.pm = fm + ((wgid % nig) % gsz); u.pn = (wgid % nig) / gsz; return true;
  }
};

template <class Epi>
DI void gemm_phase(int tid, PG8_LAS unsigned char* lds, const Gemm g, const StaticOrder& S, const Epi& E) {
  const int wid = __builtin_amdgcn_readfirstlane(tid >> 6), lane = tid & 63, wr = wid >> 2, wc = wid & 3, fr = lane & 15, fq = lane >> 4;
  const int K = g.K, nt = K / BK;
  unsigned voffA[2], voffB[2];
#pragma unroll
  for (int i = 0; i < 2; ++i) { int R, C; stage_rc(tid * 16 + i * 8192, R, C); const int Rb = Epi::PERM ? ((R & ~31) + perm32(R & 31)) : R;
    voffA[i] = (unsigned)(R * K + C) * 2u; voffB[i] = (unsigned)(Rb * K + C) * 2u; }
  const size_t kstep = (size_t)(BK * 2);
  const size_t hstep = (size_t)HALF * K * 2;
  const size_t tstep = 2 * hstep;
  const unsigned ldsw = (unsigned)wid * 1024u;
  const int aoff = lds_byte(wr * 64 + fr, fq * 8), boff = lds_byte(wc * 32 + fr, fq * 8);
#define PG8_SA(b, h) (((b) * 2 + (h)) * HTB)
#define PG8_SB(b, h) ((4 + (b) * 2 + (h)) * HTB)
#define PG8_STAGE(bufoff, gbase, voff) do { _Pragma("unroll") for (int _i = 0; _i < 2; ++_i) \
    __builtin_amdgcn_global_load_lds((const unsigned*)((const char*)(gbase) + (voff)[_i]), (PG8_LAS unsigned*)(lds + (bufoff) + ldsw + _i * 8192), 16, 0, 0); } while (0)
#define PG8_LDA(dst, b, h) do { _Pragma("unroll") for (int m = 0; m < 4; ++m) _Pragma("unroll") for (int k = 0; k < 2; ++k) dst[m][k] = *(const PG8_LAS s16x8*)(lds + PG8_SA(b, h) + aoff + m * 2048 + k * 1024); } while (0)
#define PG8_LDB(dst, b, h) do { _Pragma("unroll") for (int n = 0; n < 2; ++n) _Pragma("unroll") for (int k = 0; k < 2; ++k) dst[n][k] = *(const PG8_LAS s16x8*)(lds + PG8_SB(b, h) + boff + n * 2048 + k * 1024); } while (0)
#define PG8_MMA(ai, bj, At, Bt) do { __builtin_amdgcn_s_setprio(1); _Pragma("unroll") for (int m = 0; m < 4; ++m) _Pragma("unroll") for (int n = 0; n < 2; ++n) _Pragma("unroll") for (int k = 0; k < 2; ++k) \
    acc[ai][bj][m][n] = __builtin_amdgcn_mfma_f32_16x16x32_bf16(__builtin_bit_cast(bf16x8, Bt[n][k]), __builtin_bit_cast(bf16x8, At[m][k]), acc[ai][bj][m][n], 0, 0, 0); __builtin_amdgcn_s_setprio(0); } while (0)
#define PG8_WAIT_V(n) asm volatile("s_waitcnt vmcnt(" #n ")" ::: "memory")
#define PG8_WAIT_L(n) asm volatile("s_waitcnt lgkmcnt(" #n ")" ::: "memory")
#define PG8_BAR __builtin_amdgcn_s_barrier()
#define PG8_SCHED __builtin_amdgcn_sched_barrier(0)
  Unit cur, nxt; int ui = 0;
  if (!S.next(0, cur)) return;
  f32x4 acc[2][2][4][2];
#pragma unroll
  for (int a = 0; a < 2; ++a)
#pragma unroll
    for (int b = 0; b < 2; ++b)
#pragma unroll
      for (int m = 0; m < 4; ++m)
#pragma unroll
        for (int n = 0; n < 2; ++n) acc[a][b][m][n] = (f32x4){0.f, 0.f, 0.f, 0.f};
  s16x8 At[4][2], B0[2][2], B1[2][2];
  const char* cA = (const char*)g.A + (size_t)cur.pm * tstep; const char* cB = (const char*)g.Bt + (size_t)cur.pn * tstep;
  PG8_STAGE(PG8_SB(0, 0), cB, voffB); PG8_STAGE(PG8_SA(0, 0), cA, voffA); PG8_STAGE(PG8_SB(0, 1), cB + hstep, voffB); PG8_STAGE(PG8_SA(0, 1), cA + hstep, voffA);
  if (wr == 1) PG8_BAR;
  PG8_WAIT_V(4); PG8_BAR;
  PG8_STAGE(PG8_SB(1, 0), cB + kstep, voffB); PG8_STAGE(PG8_SA(1, 0), cA + kstep, voffA); PG8_STAGE(PG8_SB(1, 1), cB + hstep + kstep, voffB);
  PG8_WAIT_V(6); PG8_BAR;
  for (;;) {
    const bool has_next = S.next(ui + 1, nxt);
    const char* nA = has_next ? (const char*)g.A + (size_t)nxt.pm * tstep : cA; const char* nB = has_next ? (const char*)g.Bt + (size_t)nxt.pn * tstep : cB;
    for (int t = 0; t < nt; t += 2) {
      const bool last = (t == nt - 2);
      const char* a1 = cA + (size_t)(t + 1) * kstep;
      const char* a2 = last ? nA : cA + (size_t)(t + 2) * kstep; const char* b2 = last ? nB : cB + (size_t)(t + 2) * kstep;
      const char* a3 = a2 + kstep; const char* b3 = b2 + kstep;
      PG8_LDB(B0, 0, 0); PG8_SCHED; PG8_LDA(At, 0, 0); PG8_STAGE(PG8_SA(1, 1), a1 + hstep, voffA);
      PG8_WAIT_L(8); PG8_BAR; PG8_WAIT_L(0); PG8_MMA(0, 0, At, B0); PG8_BAR; PG8_SCHED;
      PG8_LDB(B1, 0, 1); PG8_STAGE(PG8_SB(0, 0), b2, voffB);
      PG8_BAR; PG8_WAIT_L(0); PG8_MMA(0, 1, At, B1); PG8_BAR;
      PG8_LDA(At, 0, 1); PG8_STAGE(PG8_SA(0, 0), a2, voffA);
      PG8_BAR; PG8_WAIT_L(0); PG8_MMA(1, 0, At, B0); PG8_BAR; PG8_SCHED;
      PG8_STAGE(PG8_SB(0, 1), b2 + hstep, voffB);
      PG8_WAIT_V(6); PG8_BAR; PG8_MMA(1, 1, At, B1); PG8_BAR;
      PG8_LDB(B0, 1, 0); PG8_SCHED; PG8_LDA(At, 1, 0); PG8_STAGE(PG8_SA(0, 1), a2 + hstep, voffA);
      PG8_WAIT_L(8); PG8_BAR; PG8_WAIT_L(0); PG8_MMA(0, 0, At, B0); PG8_BAR; PG8_SCHED;
      PG8_LDB(B1, 1, 1); PG8_STAGE(PG8_SB(1, 0), b3, voffB);
      PG8_BAR; PG8_WAIT_L(0); PG8_MMA(0, 1, At, B1); PG8_BAR;
      PG8_LDA(At, 1, 1); PG8_STAGE(PG8_SA(1, 0), a3, voffA);
      PG8_BAR; PG8_WAIT_L(0); PG8_MMA(1, 0, At, B0); PG8_BAR; PG8_SCHED;
      PG8_STAGE(PG8_SB(1, 1), b3 + hstep, voffB);
      PG8_WAIT_V(6); PG8_BAR; PG8_MMA(1, 1, At, B1); PG8_BAR;
    }
    E(acc, cur, wr, wc, fr, fq);
    if (!has_next) break;
#pragma unroll
    for (int a = 0; a < 2; ++a)
#pragma unroll
      for (int b = 0; b < 2; ++b)
#pragma unroll
        for (int m = 0; m < 4; ++m)
#pragma unroll
          for (int n = 0; n < 2; ++n) acc[a][b][m][n] = (f32x4){0.f, 0.f, 0.f, 0.f};
    cur = nxt; cA = nA; cB = nB; ++ui;
  }
  PG8_WAIT_V(0);
  if (wr == 0) PG8_BAR;
  PG8_BAR;
#undef PG8_SA
#undef PG8_SB
#undef PG8_STAGE
#undef PG8_LDA
#undef PG8_LDB
#undef PG8_MMA
#undef PG8_WAIT_V
#undef PG8_WAIT_L
#undef PG8_BAR
#undef PG8_SCHED
}
}

DI uint4 pack8(const f32x4& a, const f32x4& b) { return make_uint4(pk2(a[0], a[1]), pk2(a[2], a[3]), pk2(b[0], b[1]), pk2(b[2], b[3])); }

struct EpiInProj {
  static constexpr bool PERM = true;
  char* ws; int kind;
  DI void operator()(const f32x4 (&acc)[2][2][4][2], const pg8::Unit& u, int wr, int wc, int fr, int fq) const {
    char* big = ws + OFF_BIG;
    const float* cs = reinterpret_cast<const float*>(ws + OFF_COS);
    const float* sn = reinterpret_cast<const float*>(ws + OFF_SIN);
#pragma unroll
    for (int bj = 0; bj < 2; ++bj) {
      const int c32 = u.pn * 256 + bj * 128 + wc * 32;
      const int dd = (c32 & 63) + 8 * fq;
      if (c32 < 2304) {
        int sel, h;
        if (c32 < 768) { sel = 0; h = c32 >> 6; }
        else if (c32 < 1536) { sel = 1; h = (c32 - 768) >> 6; }
        else if (c32 < 1792) { sel = 2; h = (c32 - 1536) >> 6; }
        else { sel = 3; h = (c32 - 1792) >> 6; }
        const bool rope = sel != 2 && (c32 & 63) == 0 && fq < 2;
        f32x4 rc[2][4], rsn[2][4];
        if (rope) {
#pragma unroll
          for (int ai = 0; ai < 2; ++ai)
#pragma unroll
            for (int m = 0; m < 4; ++m) {
              const int row = u.pm * 256 + ai * 128 + wr * 64 + m * 16 + fr;
              rc[ai][m] = ldg4(cs + row * 8 + 4 * fq); rsn[ai][m] = ldg4(sn + row * 8 + 4 * fq);
            }
        }
#pragma unroll
        for (int ai = 0; ai < 2; ++ai)
#pragma unroll
          for (int m = 0; m < 4; ++m) {
            const int row = u.pm * 256 + ai * 128 + wr * 64 + m * 16 + fr;
            f32x4 a = acc[ai][bj][m][0], b = acc[ai][bj][m][1];
            if (rope) {
              const f32x4 na = a * rc[ai][m] - b * rsn[ai][m], nb = b * rc[ai][m] + a * rsn[ai][m];
              a = na; b = nb;
            }
            const int bb = row >> 12, s_ = row & 4095;
            size_t off;
            if (sel == 0) off = BO_Q + (((size_t)(bb * 12 + h) * S + s_) * 64 + dd) * 2;
            else if (sel == 1) off = BO_K + (((size_t)(bb * 12 + h) * S + s_) * 64 + dd) * 2;
            else if (sel == 2) off = (kind == 1 ? BO_QM_B : BO_QM_AC) + (((size_t)(bb * 4 + h) * S + s_) * 64 + dd) * 2;
            else off = BO_QI + (((size_t)row * 8 + h) * 64 + dd) * 2;
            stg16(big + off, pack8(a, b));
          }
      } else if (c32 < 2368) {
#pragma unroll
        for (int ai = 0; ai < 2; ++ai)
#pragma unroll
          for (int m = 0; m < 4; ++m) {
            const int row = u.pm * 256 + ai * 128 + wr * 64 + m * 16 + fr;
            float* dst = reinterpret_cast<float*>(big + BO_KIRAW) + (size_t)row * 64 + (c32 - 2304) + 8 * fq;
            stg16f(dst, acc[ai][bj][m][0]);
            stg16f(dst + 4, acc[ai][bj][m][1]);
          }
      } else if (c32 < 2400) {
        if (fq == 0) {
#pragma unroll
          for (int ai = 0; ai < 2; ++ai)
#pragma unroll
            for (int m = 0; m < 4; ++m) {
              const int row = u.pm * 256 + ai * 128 + wr * 64 + m * 16 + fr;
              float* dst = reinterpret_cast<float*>(big + BO_WI) + (size_t)row * 8;
              stg16f(dst, acc[ai][bj][m][0] * 0.04419417382415922f);
              stg16f(dst + 4, acc[ai][bj][m][1] * 0.04419417382415922f);
            }
        }
      }
    }
  }
};

struct EpiVt {
  static constexpr bool PERM = true;
  char* ws; int kind;
  DI void operator()(const f32x4 (&acc)[2][2][4][2], const pg8::Unit& u, int wr, int wc, int fr, int fq) const {
    char* big = ws + OFF_BIG;
#pragma unroll
    for (int ai = 0; ai < 2; ++ai)
#pragma unroll
      for (int m = 0; m < 4; ++m) {
        const int cv = u.pm * 256 + ai * 128 + wr * 64 + m * 16 + fr;
#pragma unroll
        for (int bj = 0; bj < 2; ++bj) {
          const int tok0 = u.pn * 256 + bj * 128 + wc * 32 + 8 * fq;
          const int bb = tok0 >> 12, s0 = tok0 & 4095;
          const f32x4 a = acc[ai][bj][m][0], b = acc[ai][bj][m][1];
          if (kind != 1) {
            const int h = cv >> 6, d = cv & 63;
            u16* vt = reinterpret_cast<u16*>(big + BO_V) + ((size_t)(bb * 12 + h) * 128 + (s0 >> 5)) * 2048 + d * 32 + (s0 & 31);
            stg16(vt, pack8(a, b));
          } else {
            const int hh = cv / 192, dv = cv % 192;
            u16* v0 = reinterpret_cast<u16*>(big + BO_V) + ((size_t)(bb * 4 + hh) * 128 + (s0 >> 5)) * 6144 + dv * 32 + (s0 & 31);
            stg16(v0, pack8(a, b));
            const int j4 = s0 >> 2, j16 = s0 >> 4, r0 = s0 & 15;
            u16* v1 = reinterpret_cast<u16*>(big + BO_V + SZ_QKV) + (((size_t)(bb * 4 + hh) * 4) * 32 + (j4 >> 5)) * 6144 + dv * 32 + (j4 & 31);
            u16* v2 = reinterpret_cast<u16*>(big + BO_V + 2 * SZ_QKV) + (((size_t)(bb * 4 + hh) * 16 + r0) * 8 + (j16 >> 5)) * 6144 + dv * 32 + (j16 & 31);
#pragma unroll
            for (int r = 0; r < 4; ++r) stg4(v1 + (size_t)r * 32 * 6144, pk2(a[r], b[r]));
#pragma unroll
            for (int i = 0; i < 4; ++i) { stg2(v2 + (size_t)i * 8 * 6144, f2bf(a[i])); stg2(v2 + (size_t)(i + 4) * 8 * 6144, f2bf(b[i])); }
          }
        }
      }
  }
};

struct EpiMemKV {
  static constexpr bool PERM = true;
  char* ws;
  DI void operator()(const f32x4 (&acc)[2][2][4][2], const pg8::Unit& u, int wr, int wc, int fr, int fq) const {
#pragma unroll
    for (int bj = 0; bj < 2; ++bj) {
      const int c32 = u.pn * 256 + bj * 128 + wc * 32;
      const int layer = c32 >> 9, c = c32 & 511;
      const int h = (c & 255) >> 6, dd = (c & 63) + 8 * fq;
      u16* mk = reinterpret_cast<u16*>(ws + OFF_MK + layer * SZ_MK);
      u16* mvt = reinterpret_cast<u16*>(ws + OFF_MVT + layer * SZ_MK);
#pragma unroll
      for (int ai = 0; ai < 2; ++ai)
#pragma unroll
        for (int m = 0; m < 4; ++m) {
          const int row = u.pm * 256 + ai * 128 + wr * 64 + m * 16 + fr;
          const int bb = row >> 8, n = row & 255;
          const f32x4 a = acc[ai][bj][m][0], b = acc[ai][bj][m][1];
          if (c < 256) {
            stg16(mk + ((size_t)(bb * 4 + h) * 256 + n) * 64 + dd, pack8(a, b));
          } else {
            u16* vt = mvt + ((size_t)(bb * 4 + h) * 8 + (n >> 5)) * 2048 + dd * 32 + (n & 31);
#pragma unroll
            for (int i = 0; i < 4; ++i) { stg2(vt + i * 32, f2bf(a[i])); stg2(vt + (i + 4) * 32, f2bf(b[i])); }
          }
        }
    }
  }
};

struct EpiResid {
  static constexpr bool PERM = false;
  const float* xsrc; float* out; const float2* stat; const float* g; const float* b;
  DI void operator()(const f32x4 (&acc)[2][2][4][2], const pg8::Unit& u, int wr, int wc, int fr, int fq) const {
    const int col0 = u.pn * 256 + wc * 32 + 4 * fq;
    f32x4 gg[2][2], bb[2][2];
    if (stat) {
#pragma unroll
      for (int bj = 0; bj < 2; ++bj)
#pragma unroll
        for (int n = 0; n < 2; ++n) { gg[bj][n] = ldg4(g + col0 + bj * 128 + n * 16); bb[bj][n] = ldg4(b + col0 + bj * 128 + n * 16); }
    }
#pragma unroll
    for (int h4 = 0; h4 < 4; ++h4) {
      const int ai = h4 >> 1, m0 = (h4 & 1) * 2;
      f32x4 xv[2][2][2]; float2 st[2];
#pragma unroll
      for (int mm = 0; mm < 2; ++mm) {
        const int row = u.pm * 256 + ai * 128 + wr * 64 + (m0 + mm) * 16 + fr;
        st[mm] = stat ? ldg2(stat + row) : make_float2(0.f, 1.f);
#pragma unroll
        for (int bj = 0; bj < 2; ++bj)
#pragma unroll
          for (int n = 0; n < 2; ++n) xv[mm][bj][n] = ldg4(xsrc + (size_t)row * 1024 + col0 + bj * 128 + n * 16);
      }
#pragma unroll
      for (int mm = 0; mm < 2; ++mm) {
        const int row = u.pm * 256 + ai * 128 + wr * 64 + (m0 + mm) * 16 + fr;
#pragma unroll
        for (int bj = 0; bj < 2; ++bj)
#pragma unroll
          for (int n = 0; n < 2; ++n) {
            f32x4 x = xv[mm][bj][n];
            if (stat) x = (x - st[mm].x) * st[mm].y * gg[bj][n] + bb[bj][n];
            stg16f(out + (size_t)row * 1024 + col0 + bj * 128 + n * 16, x * ALPHA + acc[ai][bj][m0 + mm][n]);
          }
      }
    }
  }
};

struct EpiSwiGLU {
  static constexpr bool PERM = true;
  u16* h;
  DI void operator()(const f32x4 (&acc)[2][2][4][2], const pg8::Unit& u, int wr, int wc, int fr, int fq) const {
    const int j0 = u.pn * 128 + wc * 32 + 8 * fq;
#pragma unroll
    for (int ai = 0; ai < 2; ++ai)
#pragma unroll
      for (int m = 0; m < 4; ++m) {
        const int row = u.pm * 256 + ai * 128 + wr * 64 + m * 16 + fr;
        f32x4 o[2];
#pragma unroll
        for (int n = 0; n < 2; ++n)
#pragma unroll
          for (int i = 0; i < 4; ++i) { const float g = acc[ai][0][m][n][i], uu = acc[ai][1][m][n][i]; o[n][i] = g * __builtin_amdgcn_rcpf(1.f + __expf(-g)) * uu; }
        stg16(h + (size_t)row * DFF + j0, pack8(o[0], o[1]));
      }
  }
};

DI void ln_phase(const Ctx& cx, float* xio, const float* __restrict__ g, const float* __restrict__ b, u16* xb, float2* stat, bool write_f32) {
  const int lane = cx.tid & 63, gw = cx.bid * WPB + __builtin_amdgcn_readfirstlane(cx.tid >> 6), nw = cx.nb * WPB;
  float4 gg[4], bb[4];
  for (int i = 0; i < 4; ++i) { gg[i] = *reinterpret_cast<const float4*>(g + (i * 64 + lane) * 4); bb[i] = *reinterpret_cast<const float4*>(b + (i * 64 + lane) * 4); }
  constexpr int RB = 4;
  for (int r0 = gw * RB; r0 < T; r0 += nw * RB) {
    float4 v[RB][4]; float s[RB], q[RB];
#pragma unroll
    for (int k = 0; k < RB; ++k) {
      const float4* row = reinterpret_cast<const float4*>(xio + (size_t)(r0 + k) * 1024);
      s[k] = 0.f;
#pragma unroll
      for (int i = 0; i < 4; ++i) { v[k][i] = row[i * 64 + lane]; s[k] += v[k][i].x + v[k][i].y + v[k][i].z + v[k][i].w; }
    }
#pragma unroll
    for (int k = 0; k < RB; ++k) s[k] = wave_sum(s[k]) * (1.f / 1024.f);
#pragma unroll
    for (int k = 0; k < RB; ++k) {
      q[k] = 0.f;
#pragma unroll
      for (int i = 0; i < 4; ++i) { float a = v[k][i].x - s[k], b2 = v[k][i].y - s[k], c = v[k][i].z - s[k], d = v[k][i].w - s[k]; q[k] += a * a + b2 * b2 + c * c + d * d; }
    }
#pragma unroll
    for (int k = 0; k < RB; ++k) q[k] = rsqrtf(wave_sum(q[k]) * (1.f / 1024.f) + LN_EPS);
    if (lane < RB) { float2 sv; sv.x = lane == 0 ? s[0] : lane == 1 ? s[1] : lane == 2 ? s[2] : s[3]; sv.y = lane == 0 ? q[0] : lane == 1 ? q[1] : lane == 2 ? q[2] : q[3]; stat[r0 + lane] = sv; }
#pragma unroll
    for (int k = 0; k < RB; ++k) {
      float4* row = reinterpret_cast<float4*>(xio + (size_t)(r0 + k) * 1024);
#pragma unroll
      for (int i = 0; i < 4; ++i) {
        float4 o;
        o.x = (v[k][i].x - s[k]) * q[k] * gg[i].x + bb[i].x; o.y = (v[k][i].y - s[k]) * q[k] * gg[i].y + bb[i].y;
        o.z = (v[k][i].z - s[k]) * q[k] * gg[i].z + bb[i].z; o.w = (v[k][i].w - s[k]) * q[k] * gg[i].w + bb[i].w;
        if (write_f32) row[i * 64 + lane] = o;
        *reinterpret_cast<uint2*>(xb + (size_t)(r0 + k) * 1024 + (i * 64 + lane) * 4) = make_uint2(pk2(o.x, o.y), pk2(o.z, o.w));
      }
    }
  }
}

template <int NDT> struct AttState { f32x16 o[NDT]; float m, l; };
template <int NDT> DI void att_init(AttState<NDT>& st) {
#pragma unroll
  for (int d = 0; d < NDT; ++d)
#pragma unroll
    for (int r = 0; r < 16; ++r) st.o[d][r] = 0.f;
  st.m = -1e30f; st.l = 0.f;
}
DI int pi_swap(int i) { return (i & 0x13) | ((i & 4) << 1) | ((i & 8) >> 1); }

template <int NDT> struct Frags { bf16x8 k[4]; bf16x8 v[NDT == 2 ? 4 : 1]; unsigned w; };
template <int NDT> DI void att_load(Frags<NDT>& f, const u16* krow, const u16* vt) {
#pragma unroll
  for (int c = 0; c < 4; ++c) f.k[c] = ld8(krow + c * 16);
  if (NDT == 2) {
#pragma unroll
    for (int d = 0; d < 2; ++d)
#pragma unroll
      for (int c = 0; c < 2; ++c) f.v[d * 2 + c] = ld8(vt + d * 1024 + c * 16);
  }
}
template <int NDT, class MaskP>
DI void att_compute(AttState<NDT>& st, const bf16x8 (&qf)[4], const Frags<NDT>& f, const u16* vt, const MaskP& maskp) {
  constexpr float CS = 0.18033688011112042f;
  f32x16 s;
#pragma unroll
  for (int r = 0; r < 16; ++r) s[r] = 0.f;
#pragma unroll
  for (int c = 0; c < 4; ++c) s = mfma32(f.k[c], qf[c], s);
  float mx = fmaxf(fmaxf(s[0], s[1]), s[2]);
#pragma unroll
  for (int r = 3; r < 15; r += 2) mx = fmaxf(fmaxf(mx, s[r]), s[r + 1]);
  mx = fmaxf(mx, s[15]);
  mx = red32_max(mx);
  constexpr float DEFER = 8.0f / CS;
  const bool upd = mx > st.m + DEFER;
  if (__any(upd)) {
    const float mnew = upd ? mx : st.m;
    const float alpha = __builtin_amdgcn_exp2f((st.m - mnew) * CS);
    st.l *= alpha; st.m = mnew;
#pragma unroll
    for (int d = 0; d < NDT; ++d)
#pragma unroll
      for (int r = 0; r < 16; ++r) st.o[d][r] *= alpha;
  }
  const float nb = -st.m * CS;
  float ps = 0.f;
#pragma unroll
  for (int r = 0; r < 16; ++r) { s[r] = maskp(r, __builtin_amdgcn_exp2f(fmaf(s[r], CS, nb))); ps += s[r]; }
  st.l += ps;
  bf16x8 pf[2];
#pragma unroll
  for (int c = 0; c < 2; ++c) {
    u32x4 t;
#pragma unroll
    for (int j = 0; j < 4; ++j) t[j] = pk2(s[8 * c + 2 * j], s[8 * c + 2 * j + 1]);
    pf[c] = __builtin_bit_cast(bf16x8, t);
  }
  if (NDT == 2) {
#pragma unroll
    for (int d = 0; d < 2; ++d)
#pragma unroll
      for (int c = 0; c < 2; ++c) st.o[d] = mfma32(f.v[d * 2 + c], pf[c], st.o[d]);
  } else {
#pragma unroll
    for (int hb = 0; hb < 2; ++hb) {
      bf16x8 va[6];
#pragma unroll
      for (int i = 0; i < 6; ++i) va[i] = ld8(vt + (hb * 3 + (i >> 1)) * 1024 + (i & 1) * 16);
      asm volatile("" : "+v"(va[0]), "+v"(va[1]), "+v"(va[2]), "+v"(va[3]), "+v"(va[4]), "+v"(va[5]));
#pragma unroll
      for (int i = 0; i < 6; ++i) st.o[hb * 3 + (i >> 1)] = mfma32(va[i], pf[i & 1], st.o[hb * 3 + (i >> 1)]);
    }
  }
}
DI float mask_bit(unsigned w, int bit, float p) { int m; asm("v_bfe_i32 %0, %1, %2, 1" : "=v"(m) : "v"(w), "n"(bit)); return __uint_as_float(__float_as_uint(p) & (unsigned)m); }
template <int NDT, class KP, class VP, class WP, class MK>
DI void att_range(AttState<NDT>& st, const bf16x8 (&qf)[4], int k0, int k1, const KP& kp, const VP& vp, const WP& wp, const MK& mk) {
  if (NDT == 2) {
    Frags<NDT> f0, f1, f2;
    att_load<NDT>(f0, kp(k0), vp(k0)); f0.w = wp(k0);
    f1 = f0; f2 = f0;
    if (k0 + 1 <= k1) { att_load<NDT>(f1, kp(k0 + 1), vp(k0 + 1)); f1.w = wp(k0 + 1); }
#pragma unroll 1
    for (int kt = k0; kt <= k1; kt += 3) {
      if (kt + 2 <= k1) { att_load<NDT>(f2, kp(kt + 2), vp(kt + 2)); f2.w = wp(kt + 2); }
      att_compute<NDT>(st, qf, f0, vp(kt), mk(kt, f0.w));
      if (kt + 1 > k1) break;
      if (kt + 3 <= k1) { att_load<NDT>(f0, kp(kt + 3), vp(kt + 3)); f0.w = wp(kt + 3); }
      att_compute<NDT>(st, qf, f1, vp(kt + 1), mk(kt + 1, f1.w));
      if (kt + 2 > k1) break;
      if (kt + 4 <= k1) { att_load<NDT>(f1, kp(kt + 4), vp(kt + 4)); f1.w = wp(kt + 4); }
      att_compute<NDT>(st, qf, f2, vp(kt + 2), mk(kt + 2, f2.w));
    }
  } else {
#pragma unroll 1
    for (int kt = k0; kt <= k1; ++kt) {
      Frags<NDT> cur;
      att_load<NDT>(cur, kp(kt), vp(kt)); cur.w = wp(kt);
      asm volatile("" : "+v"(cur.k[0]), "+v"(cur.k[1]), "+v"(cur.k[2]), "+v"(cur.k[3]));
      att_compute<NDT>(st, qf, cur, vp(kt), mk(kt, cur.w));
    }
  }
}

template <int NDT> DI void att_store(AttState<NDT>& st, u16* orow, int hf) {
  const float lt = red32_sum(st.l);
  const float inv = 1.f / lt;
#pragma unroll
  for (int d = 0; d < NDT; ++d)
#pragma unroll
    for (int g = 0; g < 4; ++g) {
      uint2 v = make_uint2(pk2(st.o[d][4 * g] * inv, st.o[d][4 * g + 1] * inv), pk2(st.o[d][4 * g + 2] * inv, st.o[d][4 * g + 3] * inv));
      *reinterpret_cast<uint2*>(orow + d * 32 + 8 * g + 4 * hf) = v;
    }
}

DI void load_q(bf16x8 (&qf)[4], const u16* qrow, int hf) {
#pragma unroll
  for (int c = 0; c < 4; ++c) qf[c] = ld8(qrow + c * 16 + 8 * hf);
}

DI void mem_att_unit(char* ws, int layer, int kind, int u, int lane) {
  const int qt = u & 127, bh = u >> 7, b = bh >> 2, hm = bh & 3;
  const int ql = lane & 31, hf = lane >> 5, tq = qt * 32 + ql;
  const u16* QM = reinterpret_cast<const u16*>(ws + OFF_BIG + (kind == 1 ? BO_QM_B : BO_QM_AC));
  const u16* MK = reinterpret_cast<const u16*>(ws + OFF_MK + layer * SZ_MK);
  const u16* MVT = reinterpret_cast<const u16*>(ws + OFF_MVT + layer * SZ_MK);
  bf16x8 qf[4]; load_q(qf, QM + ((size_t)bh * S + tq) * 64, hf);
  AttState<2> st; att_init(st);
  const int pk = pi_swap(ql);
  const u16* kb = MK + ((size_t)bh * 256 + pk) * 64 + 8 * hf;
  const u16* vb = MVT + ((size_t)bh * 8) * 2048 + ql * 32 + 8 * hf;
  int klast = 7; asm volatile("" : "+s"(klast));
  att_range<2>(st, qf, 0, klast,
               [kb](int kt) { return kb + kt * 2048; }, [vb](int kt) { return vb + kt * 2048; },
               [](int) { return 0u; }, [](int, unsigned) { return [](int, float p) { return p; }; });
  u16* mix = reinterpret_cast<u16*>(ws + OFF_MIX);
  att_store<2>(st, mix + (size_t)(b * S + tq) * 1024 + 768 + hm * 64, hf);
}

DI void dsa_att_unit(char* ws, int bh, int qt, int lane) {
  const int b = bh / 12, h = bh % 12;
  const int ql = lane & 31, hf = lane >> 5, tq = qt * 32 + ql;
  char* big = ws + OFF_BIG;
  const u16* Q = reinterpret_cast<const u16*>(big + BO_Q);
  const u16* K = reinterpret_cast<const u16*>(big + BO_K);
  const u16* VT = reinterpret_cast<const u16*>(big + BO_V);
  const unsigned* BM = reinterpret_cast<const unsigned*>(big + BO_BM) + (size_t)(b * S + tq) * 128;
  bf16x8 qf[4]; load_q(qf, Q + ((size_t)bh * S + tq) * 64, hf);
  AttState<2> st; att_init(st);
  const int pk = pi_swap(ql);
  const u16* kb = K + ((size_t)bh * S + pk) * 64 + 8 * hf;
  const u16* vb = VT + ((size_t)bh * 128) * 2048 + ql * 32 + 8 * hf;
  const int sh = 8 * hf;
  att_range<2>(st, qf, 0, qt,
               [kb](int kt) { return kb + kt * 2048; }, [vb](int kt) { return vb + kt * 2048; },
               [BM](int kt) { return ldg32(BM + kt); },
               [sh](int, unsigned w) { const unsigned ws_ = w >> sh; return [ws_](int r, float p) { return mask_bit(ws_, 16 * (r >> 3) + (r & 7), p); }; });
  u16* mix = reinterpret_cast<u16*>(ws + OFF_MIX);
  att_store<2>(st, mix + (size_t)(b * S + tq) * 1024 + h * 64, hf);
}

DI void moba_att_unit(char* ws, int bh, int qt, int lane) {
  const int b = bh / 12, h = bh % 12;
  const int ql = lane & 31, hf = lane >> 5, tq = qt * 32 + ql;
  char* big = ws + OFF_BIG;
  const u16* Q = reinterpret_cast<const u16*>(big + BO_Q);
  const u16* K = reinterpret_cast<const u16*>(big + BO_K);
  const u16* VT = reinterpret_cast<const u16*>(big + BO_V);
  const float* KM = reinterpret_cast<const float*>(ws + OFF_KMEAN) + (size_t)bh * 16 * 64;
  const u16* qrow = Q + ((size_t)bh * S + tq) * 64;
  bf16x8 qf[4]; load_q(qf, qrow, hf);
  const int own = qt >> 3;
  unsigned selmask = 0u;
  {
    float b0 = -3e38f, b1 = -3e38f, b2 = -3e38f; int i0 = -1, i1 = -1, i2 = -1;
    for (int n = 0; n < own; ++n) {
      float g = 0.f;
      for (int d8 = 0; d8 < 8; ++d8) {
        const u32x4 qq = *reinterpret_cast<const u32x4*>(qrow + d8 * 8);
        const float4 ka = *reinterpret_cast<const float4*>(KM + n * 64 + d8 * 8);
        const float4 kb = *reinterpret_cast<const float4*>(KM + n * 64 + d8 * 8 + 4);
        g += __uint_as_float(qq[0] << 16) * ka.x + __uint_as_float(qq[0] & 0xffff0000u) * ka.y
           + __uint_as_float(qq[1] << 16) * ka.z + __uint_as_float(qq[1] & 0xffff0000u) * ka.w
           + __uint_as_float(qq[2] << 16) * kb.x + __uint_as_float(qq[2] & 0xffff0000u) * kb.y
           + __uint_as_float(qq[3] << 16) * kb.z + __uint_as_float(qq[3] & 0xffff0000u) * kb.w;
      }
      if (g > b0) { b2 = b1; i2 = i1; b1 = b0; i1 = i0; b0 = g; i0 = n; }
      else if (g > b1) { b2 = b1; i2 = i1; b1 = g; i1 = n; }
      else if (g > b2) { b2 = g; i2 = n; }
    }
    if (i0 >= 0) selmask |= 1u << i0;
    if (i1 >= 0) selmask |= 1u << i1;
    if (i2 >= 0) selmask |= 1u << i2;
  }
  AttState<2> st; att_init(st);
  const int pk = pi_swap(ql);
  const u16* kb = K + ((size_t)bh * S + pk) * 64 + 8 * hf;
  const u16* vb = VT + ((size_t)bh * 128) * 2048 + ql * 32 + 8 * hf;
  for (int n = 0; n < own; ++n) {
    const unsigned minew = ((selmask >> n) & 1u) ? 0xffffffffu : 0u;
    if (!__any(minew != 0u)) continue;
    att_range<2>(st, qf, n * 8, n * 8 + 7,
                 [kb](int kt) { return kb + kt * 2048; }, [vb](int kt) { return vb + kt * 2048; },
                 [minew](int) { return minew; }, [](int, unsigned w) { return [w](int, float p) { return w != 0u ? p : 0.f; }; });
  }
  att_range<2>(st, qf, own * 8, qt,
               [kb](int kt) { return kb + kt * 2048; }, [vb](int kt) { return vb + kt * 2048; },
               [](int) { return 0u; },
               [hf, tq](int kt, unsigned) { const int dq = tq - (kt * 32 + 8 * hf); return [dq](int r, float p) { return 16 * (r >> 3) + (r & 7) <= dq ? p : 0.f; }; });
  u16* mix = reinterpret_cast<u16*>(ws + OFF_MIX);
  att_store<2>(st, mix + (size_t)(b * S + tq) * 1024 + h * 64, hf);
}

template <bool DSA>
DI void blk_att_unit(char* ws, char* smem, int wid, int lane, int bh, int Qb) {
  typedef __attribute__((address_space(3))) unsigned char* lds_p;
  typedef __attribute__((address_space(3))) unsigned* lds_u32p;
  constexpr int D = 6, R = 8, SLOT = 10240;
  lds_p lds = (lds_p)smem;
  const int b = bh / 12, h = bh % 12;
  const int ql = lane & 31, hf = lane >> 5, qt = Qb * 8 + wid, tq = qt * 32 + ql, nkt = Qb * 8 + 8;
  char* big = ws + OFF_BIG;
  const u16* Q = reinterpret_cast<const u16*>(big + BO_Q);
  const u16* K = reinterpret_cast<const u16*>(big + BO_K);
  const u16* VT = reinterpret_cast<const u16*>(big + BO_V);
  const u16* qrow = Q + ((size_t)bh * S + tq) * 64;
  bf16x8 qf[4]; load_q(qf, qrow, hf);
  unsigned selmask = 0u;
  if (!DSA) {
    const u16* KMB = reinterpret_cast<const u16*>(ws + OFF_KMEANB) + (size_t)bh * 16 * 64 + 8 * hf;
    f32x16 ga, gb;
#pragma unroll
    for (int r = 0; r < 16; ++r) { ga[r] = 0.f; gb[r] = 0.f; }
    bf16x8 ka[4], kb[4];
#pragma unroll
    for (int c = 0; c < 4; ++c) { ka[c] = ld8(KMB + (ql & 15) * 64 + c * 16); kb[c] = ld8(KMB + ((ql & 15) ^ 4) * 64 + c * 16); }
    asm volatile("" : "+v"(ka[0]), "+v"(ka[1]), "+v"(ka[2]), "+v"(ka[3]), "+v"(kb[0]), "+v"(kb[1]), "+v"(kb[2]), "+v"(kb[3]));
#pragma unroll
    for (int c = 0; c < 4; ++c) { ga = mfma32(ka[c], qf[c], ga); gb = mfma32(kb[c], qf[c], gb); }
    float b0 = -3e38f, b1 = -3e38f, b2 = -3e38f; int i0 = -1, i1 = -1, i2 = -1;
#pragma unroll
    for (int r = 0; r < 8; ++r) {
#pragma unroll
      for (int t = 0; t < 2; ++t) {
        const int n = ((r & 3) + 8 * (r >> 2) + 4 * hf) ^ (4 * t);
        const float g = (n < Qb) ? (t == 0 ? ga[r] : gb[r]) : -3e38f;
        const bool c0 = g > b0, c1 = g > b1, c2 = g > b2;
        const float nb2 = c1 ? b1 : (c2 ? g : b2); const int ni2 = c1 ? i1 : (c2 ? n : i2);
        const float nb1 = c0 ? b0 : (c1 ? g : b1); const int ni1 = c0 ? i0 : (c1 ? n : i1);
        const float nb0 = c0 ? g : b0;             const int ni0 = c0 ? n : i0;
        b0 = nb0; b1 = nb1; b2 = nb2; i0 = ni0; i1 = ni1; i2 = ni2;
      }
    }
    if (b0 > -1e38f) selmask |= 1u << i0;
    if (b1 > -1e38f) selmask |= 1u << i1;
    if (b2 > -1e38f) selmask |= 1u << i2;
  }
  const char* src;
  {
    const int p = (wid & 3) * 64 + lane;
    if (wid < 4) { const int r = p >> 3, lc = (p & 7) ^ ((r >> 1) & 7); src = reinterpret_cast<const char*>(K + ((size_t)bh * S + r) * 64 + lc * 8); }
    else { const int d = p >> 2, lc = (p & 3) ^ ((d >> 2) & 3); src = reinterpret_cast<const char*>(VT + (size_t)bh * 128 * 2048 + d * 32 + lc * 8); }
  }
  const char* msrc = big + BO_BM + ((size_t)(b * S + Qb * 256 + ((wid & 3) * 64 + lane)) * 128) * 4;
  const unsigned ldsw = (unsigned)wid * 1024u, ldsm = 8192u + (unsigned)wid * 256u;
#define BA_ISSUE(kt_) do { const unsigned _sb = (unsigned)(((kt_) & (R - 1)) * SLOT); \
    __builtin_amdgcn_global_load_lds((const unsigned*)(src + (size_t)(kt_) * 4096), (lds_u32p)(lds + _sb + ldsw), 16, 0, 0); \
    if (DSA) __builtin_amdgcn_global_load_lds((const unsigned*)(msrc + (size_t)(kt_) * 4), (lds_u32p)(lds + _sb + ldsm), 4, 0, 0); } while (0)
#define BA_WAIT(n) asm volatile("s_waitcnt vmcnt(" #n ")" ::: "memory")
  int koff[4], voff[4];
  {
    const int kr = pi_swap(ql);
#pragma unroll
    for (int c = 0; c < 4; ++c) koff[c] = kr * 128 + (((2 * c + hf) ^ ((kr >> 1) & 7)) << 4);
#pragma unroll
    for (int dt = 0; dt < 2; ++dt)
#pragma unroll
      for (int c = 0; c < 2; ++c) { const int d = dt * 32 + ql; voff[dt * 2 + c] = 4096 + d * 64 + (((2 * c + hf) ^ ((d >> 2) & 3)) << 4); }
  }
  const int moff = 8192 + (wid * 32 + ql) * 4;
  AttState<2> st; att_init(st);
  asm volatile("" :: "v"(qf[0]), "v"(qf[1]), "v"(qf[2]), "v"(qf[3]));
  __builtin_amdgcn_s_barrier();
#pragma unroll
  for (int i = 0; i < D; ++i) BA_ISSUE(i);
  for (int kt = 0; kt < nkt; ++kt) {
    if (kt + D < nkt) BA_ISSUE(kt + D);
    int rem = nkt - 1 - kt; rem = rem > D ? D : rem;
    if (DSA) {
      switch (rem) { case 6: BA_WAIT(12); break; case 5: BA_WAIT(10); break; case 4: BA_WAIT(8); break; case 3: BA_WAIT(6); break;
                     case 2: BA_WAIT(4); break; case 1: BA_WAIT(2); break; default: BA_WAIT(0); break; }
    } else {
      switch (rem) { case 6: BA_WAIT(6); break; case 5: BA_WAIT(5); break; case 4: BA_WAIT(4); break; case 3: BA_WAIT(3); break;
                     case 2: BA_WAIT(2); break; case 1: BA_WAIT(1); break; default: BA_WAIT(0); break; }
    }
    __builtin_amdgcn_s_barrier();
    if (kt > qt) continue;
    unsigned wmask = 0xffffffffu;
    if (!DSA && kt < Qb * 8) {
      wmask = ((selmask >> (kt >> 3)) & 1u) ? 0xffffffffu : 0u;
      if (!__any(wmask != 0u)) continue;
    }
    lds_p img = lds + (kt & (R - 1)) * SLOT;
    Frags<2> f;
#pragma unroll
    for (int c = 0; c < 4; ++c) f.k[c] = *(const __attribute__((address_space(3))) bf16x8*)(img + koff[c]);
#pragma unroll
    for (int c = 0; c < 4; ++c) f.v[c] = *(const __attribute__((address_space(3))) bf16x8*)(img + voff[c]);
    if (DSA) {
      const unsigned w_ = (*(const __attribute__((address_space(3))) unsigned*)(img + moff)) >> (8 * hf);
      att_compute<2>(st, qf, f, nullptr, [w_](int r, float p) { return mask_bit(w_, 16 * (r >> 3) + (r & 7), p); });
    } else if (kt < Qb * 8) {
      att_compute<2>(st, qf, f, nullptr, [wmask](int, float p) { return wmask != 0u ? p : 0.f; });
    } else {
      const int dq = tq - (kt * 32 + 8 * hf);
      att_compute<2>(st, qf, f, nullptr, [dq](int r, float p) { return 16 * (r >> 3) + (r & 7) <= dq ? p : 0.f; });
    }
  }
#undef BA_ISSUE
#undef BA_WAIT
  u16* mix = reinterpret_cast<u16*>(ws + OFF_MIX);
  att_store<2>(st, mix + (size_t)(b * S + tq) * 1024 + h * 64, hf);
}

DI void dil_att_unit(char* ws, int u, int lane) {
  const int r16 = u & 15, T0 = (u >> 4) & 7, bhh = u >> 7, b = bhh >> 2, hh = bhh & 3;
  const int ql = lane & 31, hf = lane >> 5;
  const int tq = T0 * 512 + 16 * ql + r16;
  char* big = ws + OFF_BIG;
  const u16* Q = reinterpret_cast<const u16*>(big + BO_Q);
  const u16* K = reinterpret_cast<const u16*>(big + BO_K);
  AttState<6> st; att_init(st);
  const int pk = pi_swap(ql);
  for (int g = 0; g < 3; ++g) {
    const int sh = 2 * g, dil = 1 << sh, r = r16 & (dil - 1);
    const int bh = b * 12 + 4 * g + hh;
    bf16x8 qf[4];
    load_q(qf, Q + ((size_t)bh * S + tq) * 64, hf);
    const int jq = tq >> sh;
    const int jmin = (T0 * 512 + r16) >> sh, jmax = (T0 * 512 + 496 + r16) >> sh;
    int k0 = jmin - 128; k0 = k0 < 0 ? 0 : k0 >> 5;
    const u16* Vg = reinterpret_cast<const u16*>(big + BO_V + (size_t)g * SZ_QKV) + ((size_t)(bhh * dil + r) * (128 >> sh)) * 6144 + ql * 32 + 8 * hf;
    const u16* Kg = K + ((size_t)bh * S + r) * 64 + 8 * hf;
    att_range<6>(st, qf, k0, jmax >> 5,
                 [Kg, pk, sh](int jt) { return Kg + ((size_t)((jt * 32 + pk) << sh)) * 64; },
                 [Vg](int jt) { return Vg + (size_t)jt * 6144; },
                 [](int) { return 0u; },
                 [hf, jq](int jt, unsigned) { const int dq = jq - (jt * 32 + 8 * hf); return [dq](int rr, float p) { return (unsigned)(dq - (16 * (rr >> 3) + (rr & 7))) <= 128u ? p : 0.f; }; });
  }
  u16* mix = reinterpret_cast<u16*>(ws + OFF_MIX);
  att_store<6>(st, mix + (size_t)(b * S + tq) * 1024 + hh * 192, hf);
}

DI void ki_prep_phase(const Ctx& cx, char* ws, const float* g, const float* bta) {
  const int lane = cx.tid & 63, gw = cx.bid * WPB + __builtin_amdgcn_readfirstlane(cx.tid >> 6), nw = cx.nb * WPB;
  const float* raw = reinterpret_cast<const float*>(ws + OFF_BIG + BO_KIRAW);
  u16* kib = reinterpret_cast<u16*>(ws + OFF_BIG + BO_KIB);
  const float* cs = reinterpret_cast<const float*>(ws + OFF_COS);
  const float* sn = reinterpret_cast<const float*>(ws + OFF_SIN);
  const float gg = g[lane], bb = bta[lane];
  constexpr int RB = 4;
  for (int r0 = gw * RB; r0 < T; r0 += nw * RB) {
    float v[RB], c[RB], s[RB];
#pragma unroll
    for (int k = 0; k < RB; ++k) {
      v[k] = raw[(size_t)(r0 + k) * 64 + lane];
      c[k] = cs[(r0 + k) * 8 + (lane & 7)]; s[k] = sn[(r0 + k) * 8 + (lane & 7)];
    }
    float mu[RB], d[RB], rs[RB];
#pragma unroll
    for (int k = 0; k < RB; ++k) mu[k] = wave_sum(v[k]) * (1.f / 64.f);
#pragma unroll
    for (int k = 0; k < RB; ++k) { d[k] = v[k] - mu[k]; rs[k] = rsqrtf(wave_sum(d[k] * d[k]) * (1.f / 64.f) + LN_EPS); }
#pragma unroll
    for (int k = 0; k < RB; ++k) {
      float y = d[k] * rs[k] * gg + bb;
      const float py = sx<8>(y);
      if (lane < 16) y = lane < 8 ? y * c[k] - py * s[k] : y * c[k] + py * s[k];
      kib[(size_t)(r0 + k) * 64 + rope_pos(lane)] = f2bf(y);
    }
  }
}

DI float relu1(float x) { return __builtin_amdgcn_fmed3f(x, 0.f, 3.0e38f); }
DI unsigned sortable(float f) { unsigned u = __float_as_uint(f); u = (u & 0x80000000u) ? ~u : (u | 0x80000000u); return u & ~((1u << SEL_LOW_BIT) - 1u); }

DI int wave_total(int v) {
  v += __builtin_amdgcn_update_dpp(0, v, 0x111, 0xf, 0xf, true);
  v += __builtin_amdgcn_update_dpp(0, v, 0x112, 0xf, 0xf, true);
  v += __builtin_amdgcn_update_dpp(0, v, 0x114, 0xf, 0xf, true);
  v += __builtin_amdgcn_update_dpp(0, v, 0x118, 0xf, 0xf, true);
  v += __builtin_amdgcn_update_dpp(0, v, 0x142, 0xa, 0xf, true);
  v += __builtin_amdgcn_update_dpp(0, v, 0x143, 0xc, 0xf, true);
  return __builtin_amdgcn_readlane(v, 63);
}

DI unsigned long long select256(const unsigned (&u)[64], int lane) {
  unsigned th = 0u;
  int g = 0;
  for (int bit = 31; bit >= SEL_LOW_BIT; --bit) {
    const unsigned c = th | (1u << bit);
    int cnt = 0;
#pragma unroll
    for (int r = 0; r < 64; r += 8)
      asm("v_cmp_le_u32 vcc, %1, %2\n\tv_addc_co_u32 %0, vcc, 0, %0, vcc\n\t"
          "v_cmp_le_u32 vcc, %1, %3\n\tv_addc_co_u32 %0, vcc, 0, %0, vcc\n\t"
          "v_cmp_le_u32 vcc, %1, %4\n\tv_addc_co_u32 %0, vcc, 0, %0, vcc\n\t"
          "v_cmp_le_u32 vcc, %1, %5\n\tv_addc_co_u32 %0, vcc, 0, %0, vcc\n\t"
          "v_cmp_le_u32 vcc, %1, %6\n\tv_addc_co_u32 %0, vcc, 0, %0, vcc\n\t"
          "v_cmp_le_u32 vcc, %1, %7\n\tv_addc_co_u32 %0, vcc, 0, %0, vcc\n\t"
          "v_cmp_le_u32 vcc, %1, %8\n\tv_addc_co_u32 %0, vcc, 0, %0, vcc\n\t"
          "v_cmp_le_u32 vcc, %1, %9\n\tv_addc_co_u32 %0, vcc, 0, %0, vcc"
          : "+v"(cnt) : "s"(c), "v"(u[r]), "v"(u[r + 1]), "v"(u[r + 2]), "v"(u[r + 3]), "v"(u[r + 4]), "v"(u[r + 5]), "v"(u[r + 6]), "v"(u[r + 7]) : "vcc");
    const int n = wave_total(cnt);
    if (n == 256) { th = c - 1u; g = 256; break; }
    if (n > 256) th = c; else g = n;
  }
  int need = th == 0u ? 0 : 256 - g;
  int mlo = 0, mhi = 0;
#pragma unroll
  for (int r = 0; r < 64; ++r) {
    const unsigned long long gt = __ballot(u[r] > th), eq = __ballot(u[r] == th);
    unsigned long long tk = 0ull;
    if (need > 0 && eq != 0ull) {
      const int pre = __builtin_amdgcn_mbcnt_hi((unsigned)(eq >> 32), __builtin_amdgcn_mbcnt_lo((unsigned)eq, 0u));
      tk = __ballot(u[r] == th && pre < need);
      need -= __popcll(tk);
    }
    const unsigned long long mv = gt | tk;
    asm volatile("s_nop 3\n\tv_writelane_b32 %0, %2, %4\n\tv_writelane_b32 %1, %3, %4" : "+v"(mlo), "+v"(mhi) : "s"((unsigned)mv), "s"((unsigned)(mv >> 32)), "n"(r));
  }
  return ((unsigned long long)(unsigned)mhi << 32) | (unsigned)mlo;
}

DI void dsa_select_block(char* ws, char* smem, int wid, int lane, int b, int t0, int gwave) {
  typedef __attribute__((address_space(3))) unsigned char* lds_p;
  lds_p lds = (lds_p)smem;
  char* big = ws + OFF_BIG;
  const u16* QI = reinterpret_cast<const u16*>(big + BO_QI);
  const char* kbase = big + BO_KIB + (size_t)b * S * 128;
  const float* WI = reinterpret_cast<const float*>(big + BO_WI);
  unsigned long long* BM = reinterpret_cast<unsigned long long*>(big + BO_BM);
  unsigned* scr = reinterpret_cast<unsigned*>(big + BO_SCR) + (size_t)gwave * 4096 + lane;
  const int tA = t0 + 2 * wid, nch = ((t0 + 15) >> 8) + 1;
  const int row = lane & 15, kq = lane >> 4, tid = wid * 64 + lane;
  const u16* qip = QI + ((size_t)(b * S + tA + (row >> 3)) * 8 + (row & 7)) * 64 + kq * 8;
  const bf16x8 qa0 = ld8(qip), qa1 = ld8(qip + 32);
  const float4 w = *reinterpret_cast<const float4*>(WI + (size_t)(b * S + tA + (kq >> 1)) * 8 + (kq & 1) * 4);
  unsigned soff[4];
#pragma unroll
  for (int i = 0; i < 4; ++i) { const int p = i * 512 + tid, r = p >> 3, lc = (p & 7) ^ ((r >> 1) & 7); soff[i] = (unsigned)(r * 128 + lc * 16); }
  const unsigned ldsw = (unsigned)wid * 1024u;
#define SEL_ISSUE(c, slot) do { _Pragma("unroll") for (int _i = 0; _i < 4; ++_i) \
    __builtin_amdgcn_global_load_lds((const unsigned*)(kbase + (size_t)(c) * 32768 + soff[_i]), (__attribute__((address_space(3))) unsigned*)(lds + (slot) * 32768 + _i * 8192 + ldsw), 16, 0, 0); } while (0)
#define SEL_WAIT(n) asm volatile("s_waitcnt vmcnt(" #n ")" ::: "memory")
  int boff[2];
#pragma unroll
  for (int kk = 0; kk < 2; ++kk) boff[kk] = row * 128 + (((kk * 4 + kq) ^ ((row >> 1) & 7)) << 4);
  asm volatile("" :: "v"(qa0), "v"(qa1), "v"(w.x), "v"(w.y), "v"(w.z), "v"(w.w));
  __builtin_amdgcn_s_barrier();
  SEL_ISSUE(0, 0);
  if (nch > 1) SEL_ISSUE(1, 1);
  unsigned u[64];
#pragma unroll
  for (int c = 0; c < 16; ++c) {
    if (c < nch) {
      if (c + 2 < nch) { SEL_ISSUE(c + 2, (c + 2) & 3); SEL_WAIT(8); }
      else if (c + 1 < nch) SEL_WAIT(4);
      else SEL_WAIT(0);
      __builtin_amdgcn_s_barrier();
      lds_p img = lds + (c & 3) * 32768;
#pragma unroll
      for (int rr = 0; rr < 4; ++rr) {
        const int r = c * 4 + rr;
        float sa[4], sb[4];
        bf16x8 kb0[4], kb1[4];
#pragma unroll
        for (int tt = 0; tt < 4; ++tt) {
          const int tile = rr * 4 + tt;
          kb0[tt] = *(const __attribute__((address_space(3))) bf16x8*)(img + tile * 2048 + boff[0]);
          kb1[tt] = *(const __attribute__((address_space(3))) bf16x8*)(img + tile * 2048 + boff[1]);
        }
        f32x4 cc[4];
#pragma unroll
        for (int tt = 0; tt < 4; ++tt) cc[tt] = mfma16(qa0, kb0[tt], f32x4{0.f, 0.f, 0.f, 0.f});
#pragma unroll
        for (int tt = 0; tt < 4; ++tt) cc[tt] = mfma16(qa1, kb1[tt], cc[tt]);
        float pp[4], ps[4];
#pragma unroll
        for (int tt = 0; tt < 4; ++tt) pp[tt] = w.x * relu1(cc[tt][0]) + w.y * relu1(cc[tt][1]) + w.z * relu1(cc[tt][2]) + w.w * relu1(cc[tt][3]);
#pragma unroll
        for (int tt = 0; tt < 4; ++tt) ps[tt] = sx<16>(pp[tt]);
#pragma unroll
        for (int tt = 0; tt < 4; ++tt) {
          const float pt = pp[tt] + ps[tt];
          const int iv = __builtin_bit_cast(int, pt); int iw = iv; asm volatile("" : "+v"(iw));
          auto sw = __builtin_amdgcn_permlane32_swap(iv, iw, false, false);
          sa[tt] = __builtin_bit_cast(float, (int)sw[0]); sb[tt] = __builtin_bit_cast(float, (int)sw[1]);
        }
        const float scA = kq == 0 ? sa[0] : kq == 1 ? sa[1] : kq == 2 ? sa[2] : sa[3];
        const float scB = kq == 0 ? sb[0] : kq == 1 ? sb[1] : kq == 2 ? sb[2] : sb[3];
        const int key = r * 64 + lane;
        u[r] = key <= tA ? sortable(scA) : 0u;
        stg4(scr + r * 64, key <= tA + 1 ? sortable(scB) : 0u);
      }
    } else {
#pragma unroll
      for (int rr = 0; rr < 4; ++rr) { u[c * 4 + rr] = 0u; stg4(scr + (c * 4 + rr) * 64, 0u); }
    }
  }
#undef SEL_ISSUE
#undef SEL_WAIT
  const unsigned long long mA = select256(u, lane);
  stg8(BM + (size_t)(b * S + tA) * 64 + lane, make_uint2((unsigned)mA, (unsigned)(mA >> 32)));
#pragma unroll
  for (int r = 0; r < 64; ++r) u[r] = ldg32(scr + r * 64);
  const unsigned long long mB = select256(u, lane);
  stg8(BM + (size_t)(b * S + tA + 1) * 64 + lane, make_uint2((unsigned)mB, (unsigned)(mB >> 32)));
}

DI void kmean_phase(const Ctx& cx, char* ws) {
  const int lane = cx.tid & 63, gw = cx.bid * WPB + __builtin_amdgcn_readfirstlane(cx.tid >> 6), nw = cx.nb * WPB;
  const u16* K = reinterpret_cast<const u16*>(ws + OFF_BIG + BO_K);
  float* KM = reinterpret_cast<float*>(ws + OFF_KMEAN);
  for (int u = gw; u < NB * 12 * 16; u += nw) {
    const int bh = u >> 4, blk = u & 15;
    const u16* kp = K + ((size_t)bh * S + blk * 256) * 64 + lane * 8;
    float acc[8];
#pragma unroll
    for (int j = 0; j < 8; ++j) acc[j] = 0.f;
#pragma unroll 8
    for (int i = 0; i < 32; ++i) {
      const u32x4 v = __builtin_bit_cast(u32x4, ld8(kp + i * 512));
#pragma unroll
      for (int j = 0; j < 4; ++j) { acc[2 * j] += __uint_as_float(v[j] << 16); acc[2 * j + 1] += __uint_as_float(v[j] & 0xffff0000u); }
    }
#pragma unroll
    for (int j = 0; j < 8; ++j) { float a = acc[j]; a += sx<8>(a); a += sx<16>(a); a = red32_sum(a); acc[j] = a * (1.f / 256.f); }
    if (lane < 8) {
      float* dst = KM + (size_t)u * 64 + lane * 8;
      *reinterpret_cast<float4*>(dst) = make_float4(acc[0], acc[1], acc[2], acc[3]);
      *reinterpret_cast<float4*>(dst + 4) = make_float4(acc[4], acc[5], acc[6], acc[7]);
      *reinterpret_cast<uint4*>(reinterpret_cast<u16*>(ws + OFF_KMEANB) + (size_t)u * 64 + lane * 8) =
          make_uint4(pk2(acc[0], acc[1]), pk2(acc[2], acc[3]), pk2(acc[4], acc[5]), pk2(acc[6], acc[7]));
    }
  }
}

DI void grid_barrier(unsigned* cnt, unsigned target, int tid) {
  asm volatile("s_waitcnt vmcnt(0)" ::: "memory");
  __syncthreads();
  if (tid == 0) {
    __builtin_amdgcn_fence(__ATOMIC_RELEASE, "agent");
    asm volatile("s_waitcnt vmcnt(0)" ::: "memory");
    __hip_atomic_fetch_add(cnt, 1u, __ATOMIC_RELAXED, __HIP_MEMORY_SCOPE_AGENT);
    while (__hip_atomic_load(cnt, __ATOMIC_RELAXED, __HIP_MEMORY_SCOPE_AGENT) < target) __builtin_amdgcn_s_sleep(1);
    __builtin_amdgcn_fence(__ATOMIC_ACQUIRE, "agent");
    asm volatile("s_waitcnt vmcnt(0)" ::: "memory");
  }
  __syncthreads();
}

#define XB_TMO      128
#define XB_XCNT(j)  (256  + 64 * (j))
#define XB_XSUB(j)  (1280 + 64 * (j))
#define XB_XGEN(j)  (2304 + 64 * (j))
#define XB_TOP      3328
#define XB_TOPGEN   3392
#define XB_SPIN_CAP (1u << 20)
DI unsigned xb_ld(unsigned* p) { return __hip_atomic_load(p, __ATOMIC_RELAXED, __HIP_MEMORY_SCOPE_AGENT); }
DI unsigned xb_add(unsigned* p, unsigned v) { return __hip_atomic_fetch_add(p, v, __ATOMIC_RELAXED, __HIP_MEMORY_SCOPE_AGENT); }
DI unsigned xb_xcc_id() { return (unsigned)__builtin_amdgcn_s_getreg((3 << 11) | 20) & 0xFu; }
#define XB_SPIN(cond, bar) do { unsigned _sp = 0; while (cond) { __builtin_amdgcn_s_sleep(1); \
    if ((++_sp & 255u) == 0u) { if (xb_ld(&(bar)[XB_TMO])) break; if (_sp > XB_SPIN_CAP) { atomicAdd(&(bar)[XB_TMO], 1u); break; } } } } while (0)
typedef volatile __attribute__((address_space(3))) unsigned* xb_lds_p;
DI void xcd_barrier_complete(unsigned* bar, unsigned x, unsigned G, unsigned& nloc, unsigned& nx) {
  unsigned sum, cnt, mine, sp = 0u;
  for (;;) {
    sum = 0u; cnt = 0u; mine = 0u;
#pragma unroll
    for (unsigned j = 0; j < 16; ++j) { const unsigned c = xb_ld(&bar[XB_XCNT(j)]); sum += c; cnt += (c > 0u) ? 1u : 0u; mine = (j == x) ? c : mine; }
    if (sum == G) break;
    __builtin_amdgcn_s_sleep(1);
    if ((++sp & 255u) == 0u) { if (xb_ld(&bar[XB_TMO])) break; if (sp > XB_SPIN_CAP) { atomicAdd(&bar[XB_TMO], 1u); break; } }
  }
  nloc = mine > 0u ? mine : 1u; nx = cnt > 0u ? cnt : 1u;
}
DI void xcd_barrier(unsigned* bar, unsigned x, xb_lds_p st, unsigned G, int tid) {
  asm volatile("s_waitcnt vmcnt(0)" ::: "memory");
  __syncthreads();
  if (tid == 0) {
    __builtin_amdgcn_s_waitcnt(0);
    unsigned nloc = st[0], nx = st[1];
    if (nloc == 0u) { xcd_barrier_complete(bar, x, G, nloc, nx); st[0] = nloc; st[1] = nx; }
    const unsigned old = xb_add(&bar[XB_XSUB(x)], 1u);
    const unsigned gen = old / nloc;
    if (old + 1u == (gen + 1u) * nloc) {
      __builtin_amdgcn_fence(__ATOMIC_RELEASE, "agent");
      asm volatile("s_waitcnt vmcnt(0)" ::: "memory");
      const unsigned og = xb_add(&bar[XB_TOP], 1u);
      const unsigned tg = og / nx;
      if (og + 1u == (tg + 1u) * nx) xb_add(&bar[XB_TOPGEN], 1u);
      else XB_SPIN(xb_ld(&bar[XB_TOPGEN]) == tg, bar);
      __builtin_amdgcn_fence(__ATOMIC_ACQUIRE, "agent");
      xb_add(&bar[XB_XGEN(x)], 1u);
      asm volatile("s_waitcnt vmcnt(0)" ::: "memory");
    } else {
      XB_SPIN(xb_ld(&bar[XB_XGEN(x)]) == gen, bar);
      __builtin_amdgcn_fence(__ATOMIC_ACQUIRE, "agent");
      asm volatile("s_waitcnt vmcnt(0)" ::: "memory");
    }
  }
  __syncthreads();
}

template <class Epi>
DI void run_gemm(const Ctx& cx, char* smem, const u16* A, const u16* Bt, int M, int N, int K, int crot, const Epi& epi) {
  pg8::StaticOrder so; so.init(M, N, cx.nb, (cx.bid + crot) % cx.nb);
  pg8::gemm_phase(cx.tid, (PG8_LAS unsigned char*)smem, pg8::Gemm{A, Bt, M, N, K}, so, epi);
}

__global__ void __launch_bounds__(NTHR, 2) fwd_kernel(Params p) {
  extern __shared__ __attribute__((aligned(16))) char smem[];
  cg::grid_group grid = cg::this_grid();
  bool first = true;
  const int wave_id = __builtin_amdgcn_readfirstlane(threadIdx.x >> 6);
  xb_lds_p xb_st = (xb_lds_p)(smem + LDS_BYTES);
  unsigned* xb_bar = reinterpret_cast<unsigned*>(p.ws + OFF_BAR);
  const unsigned xb_x = xb_xcc_id();
  if (threadIdx.x == 0) { xb_st[0] = 0u; xb_st[1] = 0u; (void)xb_add(&xb_bar[XB_XCNT(xb_x)], 1u); }
  __syncthreads();
  if (p.ph_lo == 0) {
    Ctx cx; cx.tid = threadIdx.x; cx.bid = blockIdx.x; cx.nb = gridDim.x;
    if (EN & 1) phase0(cx, p, p.ws, smem);
    if (XP0) phase0(cx, p, p.ws, smem);
    for (int i = 0; i < XSYNC; ++i) grid.sync();
    first = false;
  }
  bool rep_done = false;
  int nbar = 0;
  for (int ph = p.ph_lo < 1 ? 1 : p.ph_lo; ph < p.ph_hi; ++ph) {
    const int layer = (ph - 1) / 9, slot = (ph - 1) % 9;
    if (REP) { if (((REP >> slot) & 1) && ((REPL >> layer) & 1) && !rep_done) { rep_done = true; --ph; } else rep_done = false; }
    const int kind = layer % 3, jl = layer / 3;
    if ((slot == 1 && kind == 1) || (slot == 2 && kind != 0)) continue;
    if (!first) {
      if (nbar == 0) grid.sync();
      else xcd_barrier(reinterpret_cast<unsigned*>(p.ws + OFF_BAR), xb_x, xb_st, gridDim.x, (int)threadIdx.x);
      ++nbar;
    }
    first = false;
    typedef const Params __attribute__((address_space(4)))* KArgs;
    KArgs pp = (KArgs)__builtin_amdgcn_kernarg_segment_ptr();
    asm volatile("" : "+s"(pp));
    char* ws = pp->ws; float* outp = pp->out;
    Ctx cx; cx.bid = blockIdx.x; cx.nb = gridDim.x;
    int wid = wave_id;
    asm volatile("" : "+s"(ws), "+s"(outp), "+s"(wid), "+s"(cx.bid), "+s"(cx.nb));
    unsigned ones = ~0u; asm volatile("" : "+s"(ones));
    const int lane = __builtin_amdgcn_mbcnt_hi(ones, __builtin_amdgcn_mbcnt_lo(ones, 0u));
    cx.tid = wid * 64 + lane;
    const int gw = cx.bid * WPB + wid, nw = cx.nb * WPB;
    if (slot == 0 && (EN & 2)) {
      const int nmain = kind == 0 ? NMAIN_A : NMAIN_BC;
      run_gemm(cx, smem, reinterpret_cast<const u16*>(ws + OFF_XB), reinterpret_cast<const u16*>(ws + win_off(layer)), T, nmain, 1024, 0, EpiInProj{ws, kind});
      run_gemm(cx, smem, reinterpret_cast<const u16*>(ws + win_off(layer)) + (size_t)nmain * 1024, reinterpret_cast<const u16*>(ws + OFF_XB), 768, T, 1024, kind == 0 ? 0 : cx.nb / 2, EpiVt{ws, kind});
      if (layer == 0 && (EN & 2048))
        run_gemm(cx, smem, reinterpret_cast<const u16*>(ws + OFF_MEMN), reinterpret_cast<const u16*>(ws + OFF_WMKV), NB * NMEM, 4 * 512, 1024, cx.nb / 2, EpiMemKV{ws});
    } else if (slot == 1 && (EN & 4)) {
      if (kind == 0) ki_prep_phase(cx, ws, pp->idx_g + jl * 64, pp->idx_b + jl * 64);
      else kmean_phase(cx, ws);
    } else if (slot == 2 && (EN & 8)) {
      for (int v = cx.bid; v < NB * (S / 16); v += cx.nb) {
        const int b = v >> 8, idx = v & 255, j = (b & 1) ? 255 - idx : idx;
        dsa_select_block(ws, smem, wid, lane, b, j * 16, gw);
      }
    } else if (slot == 3) {
      if (EN & 128) for (int u = gw; u < NB * 4 * 128; u += nw) mem_att_unit(ws, layer, kind, u, lane);
      if (kind == 1 && (EN & 16)) {
        for (int u = gw; u < NB * 4 * 8 * 16; u += nw) dil_att_unit(ws, u, lane);
      } else {
        for (int k = 0; k * cx.nb < NB * 12 * 16; ++k) {
          const int v = k * cx.nb + ((k & 1) ? cx.nb - 1 - cx.bid : cx.bid);
          if (v >= NB * 12 * 16) continue;
          const int Qb = 15 - v / 96, bh = v % 96;
          if (kind == 0) { if (EN & 32) blk_att_unit<true>(ws, smem, wid, lane, bh, Qb); }
          else { if (EN & 64) blk_att_unit<false>(ws, smem, wid, lane, bh, Qb); }
        }
      }
    } else if (slot == 4 && (EN & 256)) {
      run_gemm(cx, smem, reinterpret_cast<const u16*>(ws + OFF_MIX), reinterpret_cast<const u16*>(ws + OFF_WOUT + layer * SZ_WOUT), T, 1024, 1024, 0, EpiResid{layer == 0 ? pp->x : outp, outp, layer == 0 ? nullptr : reinterpret_cast<const float2*>(ws + OFF_STAT), pp->ln2g + (layer - 1) * 1024, pp->ln2b + (layer - 1) * 1024});
    } else if (slot == 5) {
      ln_phase(cx, outp, pp->ln1g + layer * 1024, pp->ln1b + layer * 1024, reinterpret_cast<u16*>(ws + OFF_XB), reinterpret_cast<float2*>(ws + OFF_STAT), false);
    } else if (slot == 6 && (EN & 512)) {
      run_gemm(cx, smem, reinterpret_cast<const u16*>(ws + OFF_XB), reinterpret_cast<const u16*>(ws + OFF_WGU + layer * SZ_WGU), T, 2 * DFF, 1024, 0, EpiSwiGLU{reinterpret_cast<u16*>(ws + OFF_BIG + BO_H)});
    } else if (slot == 7 && (EN & 1024)) {
      run_gemm(cx, smem, reinterpret_cast<const u16*>(ws + OFF_BIG + BO_H), reinterpret_cast<const u16*>(ws + OFF_WDN + layer * SZ_WDN), T, 1024, DFF, 0, EpiResid{outp, outp, reinterpret_cast<const float2*>(ws + OFF_STAT), pp->ln1g + layer * 1024, pp->ln1b + layer * 1024});
    } else {
      ln_phase(cx, outp, pp->ln2g + layer * 1024, pp->ln2b + layer * 1024, reinterpret_cast<u16*>(ws + OFF_XB), reinterpret_cast<float2*>(ws + OFF_STAT), layer == DEPTH - 1);
    }
  }
}

extern "C" void kernel_launch(void* const* d_in, const int* in_sizes, int n_in, void* d_out, int out_size,
                              void* d_ws, size_t ws_size, hipStream_t stream) {
  static int grid_blocks = 0;
  if (!grid_blocks) {
    int dev = 0, cus = 0, per_cu = 0;
    (void)hipGetDevice(&dev);
    (void)hipDeviceGetAttribute(&cus, hipDeviceAttributeMultiprocessorCount, dev);
    if (hipFuncSetAttribute((const void*)fwd_kernel, hipFuncAttributeMaxDynamicSharedMemorySize, LDS_TOTAL) != hipSuccess)
      fprintf(stderr, "hipFuncSetAttribute(max dynamic LDS) failed\n");
    (void)hipOccupancyMaxActiveBlocksPerMultiprocessor(&per_cu, fwd_kernel, NTHR, LDS_TOTAL);
    if (per_cu < 1) fprintf(stderr, "occupancy query reports %d blocks per CU\n", per_cu);
    grid_blocks = cus;
  }
  if (ws_size < WS_NEED) fprintf(stderr, "workspace too small: %zu < %zu\n", ws_size, (size_t)WS_NEED);
  Params p{};
  p.x = (const float*)d_in[0]; p.mem = (const float*)d_in[1]; p.pos = (const int*)d_in[2];
  p.mem_g = (const float*)d_in[3]; p.mem_b = (const float*)d_in[4];
  p.w_in_a = (const float*)d_in[5]; p.idx_g = (const float*)d_in[6]; p.idx_b = (const float*)d_in[7];
  p.w_in_b = (const float*)d_in[8]; p.w_in_c = (const float*)d_in[9];
  p.w_mkv = (const float*)d_in[10]; p.w_out = (const float*)d_in[11];
  p.ln1g = (const float*)d_in[12]; p.ln1b = (const float*)d_in[13];
  p.w_gu = (const float*)d_in[14]; p.w_dn = (const float*)d_in[15];
  p.ln2g = (const float*)d_in[16]; p.ln2b = (const float*)d_in[17];
  p.out = (float*)d_out; p.ws = (char*)d_ws;
  for (int i = 0; i < 8; ++i) p.inv_freq[i] = (float)pow(500000.0, -(double)i / 8.0);
  const int NPH = 1 + DEPTH * 9;
#if SINGLE_LAUNCH
  (void)hipMemsetAsync((char*)d_ws + OFF_BAR, 0, (size_t)XCD_BAR_WORDS * 4, stream);
  p.ph_lo = 0; p.ph_hi = NPH;
  void* args[] = {&p};
  hipError_t e = hipLaunchCooperativeKernel((void*)fwd_kernel, dim3(grid_blocks), dim3(NTHR), args, LDS_TOTAL, stream);
  if (e != hipSuccess) fprintf(stderr, "cooperative launch failed: %s (grid %d)\n", hipGetErrorString(e), grid_blocks);
#else
  for (int ph = 0; ph < NPH; ++ph) {
    if (ph > 0) {
      const int layer = (ph - 1) / 9, slot = (ph - 1) % 9, kind = layer % 3;
      if ((slot == 1 && kind == 1) || (slot == 2 && kind != 0)) continue;
    }
    p.ph_lo = ph; p.ph_hi = ph + 1;
    hipLaunchKernelGGL(fwd_kernel, dim3(grid_blocks), dim3(NTHR), LDS_TOTAL, stream, p);
  }
#endif
}
```
